# Optimizing an MI355X kernel written in HIP

```python
import jax, jax.numpy as jnp
from jax import lax
import numpy as np

D_MODEL = 2048
BATCH = 2
SEQ = 8192
DEPTH = 1

N_ATTN_HEADS = 8
HEAD_DIM = 128
ATTN_WIDTH = N_ATTN_HEADS * HEAD_DIM
CONV_GROUPS = 8
CONV_WIDTH = CONV_GROUPS * 128
CONV_K = 3
MOBA_BLOCK = 256
MOBA_TOPK = 3
Q_CHUNK = 32
ROPE_THETA = 500000.0
ROPE_DIM = HEAD_DIM // 4
N_MEM = 256
N_XATTN_HEADS = 4
XATTN_WIDTH = N_XATTN_HEADS * HEAD_DIM
D_FF = 4 * D_MODEL
NORM_EPS = 1e-6
IN_PROJ_WIDTH = 3 * ATTN_WIDTH + 3 * CONV_WIDTH + 2 * D_MODEL

kernel_name = "hybrid_moba_shortconv_gated_block"


def rms_norm(x, g):
    xf = x.astype(jnp.float32)
    y = xf * lax.rsqrt(jnp.mean(xf * xf, axis=-1, keepdims=True) + NORM_EPS)
    return (y * g.astype(jnp.float32)).astype(x.dtype)


def partial_rope(t, pos):
    half = ROPE_DIM // 2
    inv_freq = ROPE_THETA ** (-jnp.arange(half, dtype=jnp.float32) / half)
    ang = pos.astype(jnp.float32)[:, None] * inv_freq[None, :]
    cos, sin = jnp.cos(ang), jnp.sin(ang)
    tr = t[..., :ROPE_DIM].astype(jnp.float32)
    t1, t2 = tr[..., :half], tr[..., half:]
    rot = jnp.concatenate([t1 * cos - t2 * sin, t2 * cos + t1 * sin], axis=-1).astype(t.dtype)
    return jnp.concatenate([rot, t[..., ROPE_DIM:]], axis=-1)


def moba_attention(q, k, v):
    B, H, S, Dh = q.shape
    nb = -(-S // MOBA_BLOCK)
    s_pad = nb * MOBA_BLOCK
    n_ch = s_pad // Q_CHUNK
    padw = ((0, 0), (0, 0), (0, s_pad - S), (0, 0))
    q, k, v = (jnp.pad(t, padw) for t in (q, k, v))
    kb = k.reshape(B, H, nb, MOBA_BLOCK, Dh)
    vb = v.reshape(B, H, nb, MOBA_BLOCK, Dh)
    k_mean = jnp.mean(kb.astype(jnp.float32), axis=3)
    gate = jnp.einsum('bhsd,bhnd->bhsn', q.astype(jnp.float32), k_mean)
    q_blk = jnp.arange(s_pad) // MOBA_BLOCK
    fully_past = jnp.arange(nb)[None, :] < q_blk[:, None]
    gate = jnp.where(fully_past, gate, -jnp.inf)
    top_val, top_idx = lax.top_k(gate, min(MOBA_TOPK, nb))
    own = jnp.broadcast_to(q_blk[:, None], (B, H, s_pad, 1)).astype(top_idx.dtype)
    blk_idx = jnp.concatenate([top_idx, own], axis=-1)
    blk_ok = jnp.concatenate([jnp.isfinite(top_val), jnp.ones((B, H, s_pad, 1), dtype=bool)], axis=-1)

    def to_chunks(t):
        return jnp.moveaxis(t.reshape((B, H, n_ch, Q_CHUNK) + t.shape[3:]), 2, 0)

    qpos = jnp.arange(s_pad).reshape(n_ch, Q_CHUNK)
    offs = jnp.arange(MOBA_BLOCK)
    scale = HEAD_DIM ** -0.5
    gather = jax.vmap(jax.vmap(lambda tb, ib: tb[ib]))

    def attend_chunk(args):
        qc, idx, ok, qp = args
        kg = gather(kb, idx)
        vg = gather(vb, idx)
        s = jnp.einsum('bhqd,bhqnkd->bhqnk', qc, kg).astype(jnp.float32) * scale
        kpos = idx[..., None] * MOBA_BLOCK + offs
        mask = ok[..., None] & (kpos <= qp[:, None, None])
        s = jnp.where(mask, s, -jnp.inf)
        p = jax.nn.softmax(s.reshape(B, H, Q_CHUNK, -1), axis=-1).reshape(s.shape)
        return jnp.einsum('bhqnk,bhqnkd->bhqd', p.astype(vg.dtype), vg)

    out = lax.map(attend_chunk, (to_chunks(q), to_chunks(blk_idx), to_chunks(blk_ok), qpos))
    return jnp.moveaxis(out, 0, 2).reshape(B, H, s_pad, Dh)[:, :, :S]


def short_conv(u, w):
    S = u.shape[1]
    up = jnp.pad(u, ((0, 0), (CONV_K - 1, 0), (0, 0)))
    y = up[:, 0:S, :] * w[0]
    for j in range(1, CONV_K):
        y = y + up[:, j:j + S, :] * w[j]
    return y


def split_in_proj(proj):
    widths = [ATTN_WIDTH] * 3 + [CONV_WIDTH] * 3 + [D_MODEL, D_MODEL]
    cuts, acc = [], 0
    for w in widths[:-1]:
        acc += w
        cuts.append(acc)
    return jnp.split(proj, cuts, axis=-1)


def heads(t, n_heads):
    B, S, _ = t.shape
    return t.reshape(B, S, n_heads, HEAD_DIM).transpose(0, 2, 1, 3)


def merge_heads(t):
    B, H, S, Dh = t.shape
    return t.transpose(0, 2, 1, 3).reshape(B, S, H * Dh)


def hybrid_layer(x, mem, norm_mix, w_in, conv_w, w_attn_out, w_conv_out, w_mix_out,
                 norm_xattn, norm_mem, wq_x, wkv_x, wo_x, norm_mlp, w_up, w_down):
    B, S, _ = x.shape
    pos = jnp.arange(S)
    h = rms_norm(x, norm_mix)
    q, k, v, cx, cb, cc, ga, gc = split_in_proj(h @ w_in)
    q = partial_rope(heads(q, N_ATTN_HEADS), pos)
    k = partial_rope(heads(k, N_ATTN_HEADS), pos)
    y_attn = merge_heads(moba_attention(q, k, heads(v, N_ATTN_HEADS))) @ w_attn_out
    y_conv = (cb * short_conv(cc * cx, conv_w)) @ w_conv_out
    merged = jax.nn.sigmoid(ga) * y_attn + jax.nn.sigmoid(gc) * y_conv
    x = x + merged @ w_mix_out
    hq = heads(rms_norm(x, norm_xattn) @ wq_x, N_XATTN_HEADS)
    mk, mv = jnp.split(rms_norm(mem, norm_mem) @ wkv_x, 2, axis=-1)
    mk, mv = heads(mk, N_XATTN_HEADS), heads(mv, N_XATTN_HEADS)
    s = jnp.einsum('bhsd,bhmd->bhsm', hq, mk).astype(jnp.float32) * (HEAD_DIM ** -0.5)
    p = jax.nn.softmax(s, axis=-1).astype(mv.dtype)
    x = x + merge_heads(jnp.einsum('bhsm,bhmd->bhsd', p, mv)) @ wo_x
    u = jax.nn.relu(rms_norm(x, norm_mlp) @ w_up)
    return x + (u * u) @ w_down


def setup_inputs(seed: int = 0) -> dict:
    key = jax.random.key(seed)
    ks = jax.random.split(key, 20)

    def dense(k, shape, fan_in):
        return jax.random.normal(k, shape, jnp.float32) * (fan_in ** -0.5)

    def gain(k, shape):
        return 1.0 + 0.01 * jax.random.normal(k, shape, jnp.float32)

    L, D = DEPTH, D_MODEL
    return {
        "x": jax.random.normal(ks[0], (BATCH, SEQ, D), jnp.float32),
        "mem": jax.random.normal(ks[1], (BATCH, N_MEM, D), jnp.float32),
        "norm_mix": gain(ks[2], (L, D)),
        "w_in": dense(ks[3], (L, D, IN_PROJ_WIDTH), D),
        "conv_w": dense(ks[4], (L, CONV_K, CONV_WIDTH), CONV_K),
        "w_attn_out": dense(ks[5], (L, ATTN_WIDTH, D), ATTN_WIDTH),
        "w_conv_out": dense(ks[6], (L, CONV_WIDTH, D), CONV_WIDTH),
        "w_mix_out": dense(ks[7], (L, D, D), D),
        "norm_xattn": gain(ks[8], (L, D)),
        "norm_mem": gain(ks[9], (L, D)),
        "wq_x": dense(ks[10], (L, D, XATTN_WIDTH), D),
        "wkv_x": dense(ks[11], (L, D, 2 * XATTN_WIDTH), D),
        "wo_x": dense(ks[12], (L, XATTN_WIDTH, D), XATTN_WIDTH),
        "norm_mlp": gain(ks[13], (L, D)),
        "w_up": dense(ks[14], (L, D, D_FF), D),
        "w_down": dense(ks[15], (L, D_FF, D), D_FF),
        "norm_final": gain(ks[16], (D,)),
    }


def reference(x, mem, norm_mix, w_in, conv_w, w_attn_out, w_conv_out, w_mix_out,
              norm_xattn, norm_mem, wq_x, wkv_x, wo_x, norm_mlp, w_up, w_down, norm_final):
    for l in range(DEPTH):
        x = hybrid_layer(x, mem, norm_mix[l], w_in[l], conv_w[l], w_attn_out[l], w_conv_out[l],
                         w_mix_out[l], norm_xattn[l], norm_mem[l], wq_x[l], wkv_x[l], wo_x[l],
                         norm_mlp[l], w_up[l], w_down[l])
    return rms_norm(x, norm_final)
```

```cpp
#include <hip/hip_runtime.h>
#include <cstdio>
#include <cstdint>
namespace pg8 {
#define PG8_LAS __attribute__((address_space(3)))
typedef unsigned short bf16_t;
typedef short bf16x8 __attribute__((ext_vector_type(8)));
typedef float f32x4 __attribute__((ext_vector_type(4)));
typedef unsigned u32x4 __attribute__((ext_vector_type(4)));
constexpr int BM = 256, BK = 64, HALF = 128, HTB = HALF * BK * 2  , STAGE_BYTES = 8 * HTB, NXCD = 8, WGM = 8;

__host__ __device__ __forceinline__ int lds_byte(int r, int c) { const int st = (r >> 4) * 2 + (c >> 5), rr = r & 15, cc = c & 31, ob = rr * 64 + cc * 2; return st * 1024 + (ob ^ (((ob >> 9) & 1) << 5)); }
__host__ __device__ __forceinline__ void stage_rc(int b, int& R, int& C) { const int st = b / 1024, sb = b % 1024, swz = sb ^ (((sb >> 9) & 1) << 5); R = (st >> 1) * 16 + swz / 64; C = (st & 1) * 32 + (swz % 64) / 2; }
__host__ __device__ __forceinline__ int perm32(int rho) { const int n = rho >> 4, i = rho & 15; return 8 * (i >> 2) + 4 * n + (i & 3); }

struct Unit { int pm, pn; };
struct Gemm { const bf16_t* A; const bf16_t* Bt; int M, N, K; };

struct StaticOrder {
    int nM, nN, nwg, G, c;
    __host__ __device__ void init(int M, int N, int G_, int c_) { nM = M / BM; nN = N / BM; nwg = nM * nN; G = G_; c = c_; }
    __host__ __device__ bool next(int i, Unit& u) const {
        const long L = (long)i * G + c; if (L >= nwg) return false;
        int wgid = (int)L; { const int q = nwg / NXCD, r = nwg % NXCD, xcd = wgid % NXCD, off = wgid / NXCD; wgid = (xcd < r ? xcd * (q + 1) : r * (q + 1) + (xcd - r) * q) + off; }
        const int nig = WGM * nN, gid = wgid / nig, fm = gid * WGM, gsz = (nM - fm) < WGM ? (nM - fm) : WGM;
        u.pm = fm + ((wgid % nig) % gsz); u.pn = (wgid % nig) / gsz; return true;
    }
    __device__ __forceinline__ void a_ready(const Unit&) const {}
    __device__ __forceinline__ void done(const Unit&) const {}
};


__device__ __forceinline__ unsigned cvt_pk_bf16(float lo, float hi) { unsigned r; asm volatile("v_cvt_pk_bf16_f32 %0, %1, %2" : "=v"(r) : "v"(lo), "v"(hi)); return r; }
typedef unsigned u32x2 __attribute__((ext_vector_type(2)));

struct EpiBf16G {
    static constexpr bool PERM = true, AFTER_DRAIN = false;
    bf16_t* g0; bf16_t* g1; int tsplit; size_t gstride; int gcols; int ldc;
    __device__ __forceinline__ void operator()(const f32x4 (&acc)[2][2][4][2], const Unit& u, int wr, int wc, int fr, int fq) const {
        const int row0 = u.pm * BM + wr * 64 + fr; int colt = u.pn * BM; const int t = colt / gcols; colt -= t * gcols;
        bf16_t* base = (t < tsplit) ? g0 + (size_t)t * gstride : g1 + (size_t)(t - tsplit) * gstride;
        const int col0 = colt + wc * 32 + 8 * fq;
#pragma unroll
        for (int ai = 0; ai < 2; ++ai)
#pragma unroll
            for (int m = 0; m < 4; ++m) { bf16_t* rowp = base + (size_t)(row0 + ai * HALF + m * 16) * ldc + col0;
#pragma unroll
                for (int bj = 0; bj < 2; ++bj) { const f32x4 v0 = acc[ai][bj][m][0], v1 = acc[ai][bj][m][1];
                    u32x4 w; w.x = cvt_pk_bf16(v0[0], v0[1]); w.y = cvt_pk_bf16(v0[2], v0[3]); w.z = cvt_pk_bf16(v1[0], v1[1]); w.w = cvt_pk_bf16(v1[2], v1[3]);
                    *(u32x4*)(rowp + bj * HALF) = w; } }
    }
};
struct EpiResid {
    static constexpr bool PERM = false, AFTER_DRAIN = false;
    const float* base; float* out; bf16_t* outb; int ldc;
    __device__ __forceinline__ void operator()(const f32x4 (&acc)[2][2][4][2], const Unit& u, int wr, int wc, int fr, int fq) const {
        const int row0 = u.pm * BM + wr * 64 + fr, col0 = u.pn * BM + wc * 32 + 4 * fq;
#pragma unroll
        for (int ai = 0; ai < 2; ++ai)
#pragma unroll
            for (int m = 0; m < 4; ++m) { const size_t off = (size_t)(row0 + ai * HALF + m * 16) * ldc + col0;
#pragma unroll
                for (int bj = 0; bj < 2; ++bj)
#pragma unroll
                    for (int n = 0; n < 2; ++n) { const f32x4 o = *(const f32x4*)(base + off + bj * HALF + n * 16) + acc[ai][bj][m][n];
                        *(f32x4*)(out + off + bj * HALF + n * 16) = o;
                        if (outb) { u32x2 w; w.x = cvt_pk_bf16(o[0], o[1]); w.y = cvt_pk_bf16(o[2], o[3]); *(u32x2*)(outb + off + bj * HALF + n * 16) = w; } }
                if (m & 1) asm volatile("" ::: "memory"); }
    }
};
struct EpiUp {
    static constexpr bool PERM = true, AFTER_DRAIN = false;
    bf16_t* O; int ldc; const float* rs;
    __device__ __forceinline__ void operator()(const f32x4 (&acc)[2][2][4][2], const Unit& u, int wr, int wc, int fr, int fq) const {
        const int row0 = u.pm * BM + wr * 64 + fr, col0 = u.pn * BM + wc * 32 + 8 * fq;
#pragma unroll
        for (int ai = 0; ai < 2; ++ai)
#pragma unroll
            for (int m = 0; m < 4; ++m) { const int r = row0 + ai * HALF + m * 16; const float s = rs[r]; bf16_t* rowp = O + (size_t)r * ldc + col0;
#pragma unroll
                for (int bj = 0; bj < 2; ++bj) { f32x4 v0 = acc[ai][bj][m][0] * s, v1 = acc[ai][bj][m][1] * s;
#pragma unroll
                    for (int e = 0; e < 4; ++e) { v0[e] = fmaxf(v0[e], 0.f); v1[e] = fmaxf(v1[e], 0.f); }
                    v0 = v0 * v0; v1 = v1 * v1;
                    u32x4 w; w.x = cvt_pk_bf16(v0[0], v0[1]); w.y = cvt_pk_bf16(v0[2], v0[3]); w.z = cvt_pk_bf16(v1[0], v1[1]); w.w = cvt_pk_bf16(v1[2], v1[3]);
                    *(u32x4*)(rowp + bj * HALF) = w; } }
    }
};

template <class Epi, class Sched, bool ALIGN_EPI = false, bool SP2 = false>
__device__ __forceinline__ void gemm_phase(PG8_LAS unsigned char* lds, const Gemm g, const Sched& S, const Epi& E) {
    const int tid = threadIdx.x, wid = __builtin_amdgcn_readfirstlane(tid >> 6), lane = tid & 63, wr = wid >> 2, wc = wid & 3, fr = lane & 15, fq = lane >> 4;
    const int K = g.K, nt = K / BK;
    unsigned voffA[2], voffB[2];
#pragma unroll
    for (int i = 0; i < 2; ++i) { int R, C; stage_rc(tid * 16 + i * 8192, R, C); const int Rb = Epi::PERM ? ((R & ~31) + perm32(R & 31)) : R;
        voffA[i] = (unsigned)(R * K + C) * 2u; voffB[i] = (unsigned)(Rb * K + C) * 2u; }
    const size_t kstep = (size_t)(BK * 2);
    const size_t hstep = (size_t)HALF * K * 2;
    const size_t tstep = 2 * hstep;
    const unsigned ldsw = (unsigned)wid * 1024u;
    const int aoff = lds_byte(wr * 64 + fr, fq * 8), boff = lds_byte(wc * 32 + fr, fq * 8);
#define PG8_SA(b, h) (((b) * 2 + (h)) * HTB)
#define PG8_SB(b, h) ((4 + (b) * 2 + (h)) * HTB)
#define PG8_STAGE(bufoff, gbase, voff) do { _Pragma("unroll") for (int _i = 0; _i < 2; ++_i) \
        __builtin_amdgcn_global_load_lds((const unsigned*)((const char*)(gbase) + (voff)[_i]), (PG8_LAS unsigned*)(lds + (bufoff) + ldsw + _i * 8192), 16, 0, 0); } while (0)
#define PG8_LDA(dst, b, h) do { _Pragma("unroll") for (int m = 0; m < 4; ++m) _Pragma("unroll") for (int k = 0; k < 2; ++k) dst[m][k] = *(const PG8_LAS bf16x8*)(lds + PG8_SA(b, h) + aoff + m * 2048 + k * 1024); } while (0)
#define PG8_LDB(dst, b, h) do { _Pragma("unroll") for (int n = 0; n < 2; ++n) _Pragma("unroll") for (int k = 0; k < 2; ++k) dst[n][k] = *(const PG8_LAS bf16x8*)(lds + PG8_SB(b, h) + boff + n * 2048 + k * 1024); } while (0)
#define PG8_MMA(ai, bj, At, Bt) do { __builtin_amdgcn_s_setprio(1); _Pragma("unroll") for (int m = 0; m < 4; ++m) _Pragma("unroll") for (int n = 0; n < 2; ++n) _Pragma("unroll") for (int k = 0; k < 2; ++k) \
        acc[ai][bj][m][n] = __builtin_amdgcn_mfma_f32_16x16x32_bf16(Bt[n][k], At[m][k], acc[ai][bj][m][n], 0, 0, 0); __builtin_amdgcn_s_setprio(0); } while (0)
#define PG8_WAIT_V(n) asm volatile("s_waitcnt vmcnt(" #n ")" ::: "memory")
#define PG8_WAIT_L(n) asm volatile("s_waitcnt lgkmcnt(" #n ")" ::: "memory")
#define PG8_BAR __builtin_amdgcn_s_barrier()
#define PG8_SCHED __builtin_amdgcn_sched_barrier(0)
    Unit cur, nxt; int ui = 0;
    if (!S.next(0, cur)) return;
    f32x4 acc[2][2][4][2];
#pragma unroll
    for (int a = 0; a < 2; ++a)
#pragma unroll
        for (int b = 0; b < 2; ++b)
#pragma unroll
            for (int m = 0; m < 4; ++m)
#pragma unroll
                for (int n = 0; n < 2; ++n) acc[a][b][m][n] = (f32x4){0.f, 0.f, 0.f, 0.f};
    bf16x8 At[4][2], B0[2][2], B1[2][2];
    const char* cA = (const char*)g.A + (size_t)cur.pm * tstep; const char* cB = (const char*)g.Bt + (size_t)cur.pn * tstep;
    S.a_ready(cur);
    if constexpr (SP2) {
        PG8_STAGE(PG8_SB(0, 0), cB, voffB); PG8_STAGE(PG8_SB(0, 1), cB + hstep, voffB); PG8_STAGE(PG8_SA(0, 0), cA, voffA); PG8_STAGE(PG8_SA(0, 1), cA + hstep, voffA);
        if (wr == 1) PG8_BAR;
        PG8_WAIT_V(2); PG8_BAR;
        PG8_STAGE(PG8_SB(1, 0), cB + kstep, voffB); PG8_STAGE(PG8_SA(1, 0), cA + kstep, voffA); PG8_STAGE(PG8_SB(1, 1), cB + hstep + kstep, voffB);
        PG8_WAIT_V(6); PG8_BAR;
    } else {
        PG8_STAGE(PG8_SB(0, 0), cB, voffB); PG8_STAGE(PG8_SA(0, 0), cA, voffA); PG8_STAGE(PG8_SB(0, 1), cB + hstep, voffB); PG8_STAGE(PG8_SA(0, 1), cA + hstep, voffA);
        if (wr == 1) PG8_BAR;
        PG8_WAIT_V(4); PG8_BAR;
        PG8_STAGE(PG8_SB(1, 0), cB + kstep, voffB); PG8_STAGE(PG8_SA(1, 0), cA + kstep, voffA); PG8_STAGE(PG8_SB(1, 1), cB + hstep + kstep, voffB);
        PG8_WAIT_V(6); PG8_BAR;
    }
    for (;;) {
        const bool has_next = S.next(ui + 1, nxt);
        const char* nA = has_next ? (const char*)g.A + (size_t)nxt.pm * tstep : cA; const char* nB = has_next ? (const char*)g.Bt + (size_t)nxt.pn * tstep : cB;
        for (int t = 0; t < nt; t += 2) {
            const bool last = (t == nt - 2);
            const char* a1 = cA + (size_t)(t + 1) * kstep;
            const char* a2 = last ? nA : cA + (size_t)(t + 2) * kstep; const char* b2 = last ? nB : cB + (size_t)(t + 2) * kstep;
            const char* a3 = a2 + kstep; const char* b3 = b2 + kstep;
            if (last && has_next) S.a_ready(nxt);
            if constexpr (SP2) {
            PG8_LDB(B0, 0, 0); PG8_LDB(B1, 0, 1); PG8_SCHED; PG8_LDA(At, 0, 0); PG8_STAGE(PG8_SA(1, 1), a1 + hstep, voffA);
            PG8_WAIT_V(8); PG8_WAIT_L(0); PG8_BAR; PG8_MMA(0, 0, At, B0); PG8_MMA(0, 1, At, B1); PG8_BAR; PG8_SCHED;
            PG8_LDA(At, 0, 1); PG8_STAGE(PG8_SB(0, 0), b2, voffB); PG8_STAGE(PG8_SB(0, 1), b2 + hstep, voffB); PG8_STAGE(PG8_SA(0, 0), a2, voffA);
            PG8_WAIT_V(8); PG8_WAIT_L(0); PG8_BAR; PG8_MMA(1, 0, At, B0); PG8_MMA(1, 1, At, B1); PG8_BAR; PG8_SCHED;
            PG8_LDB(B0, 1, 0); PG8_LDB(B1, 1, 1); PG8_SCHED; PG8_LDA(At, 1, 0); PG8_STAGE(PG8_SA(0, 1), a2 + hstep, voffA);
            PG8_WAIT_V(8); PG8_WAIT_L(0); PG8_BAR; PG8_MMA(0, 0, At, B0); PG8_MMA(0, 1, At, B1); PG8_BAR; PG8_SCHED;
            PG8_LDA(At, 1, 1); PG8_STAGE(PG8_SB(1, 0), b3, voffB); PG8_STAGE(PG8_SB(1, 1), b3 + hstep, voffB); PG8_STAGE(PG8_SA(1, 0), a3, voffA);
            PG8_WAIT_V(8); PG8_WAIT_L(0); PG8_BAR; PG8_MMA(1, 0, At, B0); PG8_MMA(1, 1, At, B1); PG8_BAR; PG8_SCHED;
            } else {
            PG8_LDB(B0, 0, 0); PG8_SCHED; PG8_LDA(At, 0, 0); PG8_STAGE(PG8_SA(1, 1), a1 + hstep, voffA);
            PG8_WAIT_L(8); PG8_BAR; PG8_WAIT_L(0); PG8_MMA(0, 0, At, B0); PG8_BAR; PG8_SCHED;
            PG8_LDB(B1, 0, 1); PG8_STAGE(PG8_SB(0, 0), b2, voffB);
            PG8_BAR; PG8_WAIT_L(0); PG8_MMA(0, 1, At, B1); PG8_BAR;
            PG8_LDA(At, 0, 1); PG8_STAGE(PG8_SA(0, 0), a2, voffA);
            PG8_BAR; PG8_WAIT_L(0); PG8_MMA(1, 0, At, B0); PG8_BAR; PG8_SCHED;
            PG8_STAGE(PG8_SB(0, 1), b2 + hstep, voffB);
            PG8_WAIT_V(6); PG8_BAR; PG8_MMA(1, 1, At, B1); PG8_BAR;
            PG8_LDB(B0, 1, 0); PG8_SCHED; PG8_LDA(At, 1, 0); PG8_STAGE(PG8_SA(0, 1), a2 + hstep, voffA);
            PG8_WAIT_L(8); PG8_BAR; PG8_WAIT_L(0); PG8_MMA(0, 0, At, B0); PG8_BAR; PG8_SCHED;
            PG8_LDB(B1, 1, 1); PG8_STAGE(PG8_SB(1, 0), b3, voffB);
            PG8_BAR; PG8_WAIT_L(0); PG8_MMA(0, 1, At, B1); PG8_BAR;
            PG8_LDA(At, 1, 1); PG8_STAGE(PG8_SA(1, 0), a3, voffA);
            PG8_BAR; PG8_WAIT_L(0); PG8_MMA(1, 0, At, B0); PG8_BAR; PG8_SCHED;
            PG8_STAGE(PG8_SB(1, 1), b3 + hstep, voffB);
            PG8_WAIT_V(6); PG8_BAR; PG8_MMA(1, 1, At, B1); PG8_BAR;
            }
        }
        if constexpr (ALIGN_EPI) { if (wr == 0) PG8_BAR; }
        if constexpr (!Epi::AFTER_DRAIN) { E(acc, cur, wr, wc, fr, fq); S.done(cur); }
        if (!has_next) break;
#pragma unroll
        for (int a = 0; a < 2; ++a)
#pragma unroll
            for (int b = 0; b < 2; ++b)
#pragma unroll
                for (int m = 0; m < 4; ++m)
#pragma unroll
                    for (int n = 0; n < 2; ++n) acc[a][b][m][n] = (f32x4){0.f, 0.f, 0.f, 0.f};
        cur = nxt; cA = nA; cB = nB; ++ui;
        if constexpr (ALIGN_EPI) { if (wr == 1) PG8_BAR; }
    }
    PG8_WAIT_V(0);
    if constexpr (!ALIGN_EPI) { if (wr == 0) PG8_BAR; }
    PG8_BAR;
    if constexpr (Epi::AFTER_DRAIN) { E.fused(acc, cur, wr, wc, fr, fq, lds, wid, lane); S.done(cur); }
#undef PG8_SA
#undef PG8_SB
#undef PG8_STAGE
#undef PG8_LDA
#undef PG8_LDB
#undef PG8_MMA
#undef PG8_WAIT_V
#undef PG8_WAIT_L
#undef PG8_BAR
#undef PG8_SCHED
}
}
#define GAS __attribute__((address_space(1)))
#define LAS __attribute__((address_space(3)))
typedef unsigned short bf16;
typedef unsigned v4u __attribute__((ext_vector_type(4)));
typedef float f32x4 __attribute__((ext_vector_type(4)));
typedef short bf16x8 __attribute__((ext_vector_type(8)));
typedef GAS unsigned gu32;
typedef GAS unsigned long long gu64;
#define RLX_AGENT __ATOMIC_RELAXED, __HIP_MEMORY_SCOPE_AGENT
#define LDS_WAIT() asm volatile("s_waitcnt lgkmcnt(0)" ::: "memory")
#define VM_WAIT() asm volatile("s_waitcnt vmcnt(0)" ::: "memory")
__device__ __forceinline__ unsigned long long rt() { return __builtin_amdgcn_s_memrealtime(); }
__device__ __forceinline__ unsigned f2bf(float f) { unsigned u = __builtin_bit_cast(unsigned, f); return (u + 0x7fffu + ((u >> 16) & 1u)) >> 16; }
__device__ __forceinline__ unsigned pk2(float lo, float hi) { return f2bf(lo) | (f2bf(hi) << 16); }

#define XB_TMO      128
#define XB_XCNT(j)  (256  + 64 * (j))
#define XB_XSUB(j)  (1280 + 64 * (j))
#define XB_XGEN(j)  (2304 + 64 * (j))
#define XB_TOP      3328
#define XB_TOPGEN   3392
#define XCD_BAR_WORDS 3456
#define XB_SPIN_CAP (1u << 18)

__device__ __forceinline__ unsigned xb_ld(unsigned* p)              { return __hip_atomic_load(p, __ATOMIC_RELAXED, __HIP_MEMORY_SCOPE_AGENT); }
__device__ __forceinline__ unsigned xb_add(unsigned* p, unsigned v) { return __hip_atomic_fetch_add(p, v, __ATOMIC_RELAXED, __HIP_MEMORY_SCOPE_AGENT); }
__device__ __forceinline__ unsigned xb_xcc_id() { return (unsigned)__builtin_amdgcn_s_getreg((3 << 11) | 20) & 0xFu; }
#define XB_SPIN(cond, bar) do { unsigned _sp = 0; while (cond) { __builtin_amdgcn_s_sleep(1); \
    if ((++_sp & 255u) == 0u) { if (xb_ld(&(bar)[XB_TMO])) break; if (_sp > XB_SPIN_CAP) { atomicAdd(&(bar)[XB_TMO], 1u); break; } } } } while (0)

struct XcdBarrier {
    unsigned* bar; unsigned x;
    volatile LAS unsigned* st;
};

__device__ __forceinline__ XcdBarrier xcd_barrier_post(unsigned* bar, volatile LAS unsigned* st) {
    XcdBarrier b; b.bar = bar; b.x = xb_xcc_id(); b.st = st;
    if (threadIdx.x == 0) (void)xb_add(&bar[XB_XCNT(b.x)], 1u);
    return b;
}
__device__ __forceinline__ void xcd_barrier_complete(unsigned* bar, unsigned x, unsigned& nloc, unsigned& nx) {
    const unsigned G = gridDim.x * gridDim.y * gridDim.z;
    unsigned sum, cnt, mine, sp = 0u;
    for (;;) {
        sum = 0u; cnt = 0u; mine = 0u;
#pragma unroll
        for (unsigned j = 0; j < 16; ++j) { const unsigned c = xb_ld(&bar[XB_XCNT(j)]); sum += c; cnt += (c > 0u) ? 1u : 0u; mine = (j == x) ? c : mine; }
        if (sum == G) break;
        __builtin_amdgcn_s_sleep(1);
        if ((++sp & 255u) == 0u) { if (xb_ld(&bar[XB_TMO])) break; if (sp > XB_SPIN_CAP) { atomicAdd(&bar[XB_TMO], 1u); break; } }
    }
    nloc = mine > 0u ? mine : 1u; nx = cnt > 0u ? cnt : 1u;
}

__device__ __forceinline__ void xcd_barrier(const XcdBarrier& b) {
    asm volatile("s_waitcnt vmcnt(0)" ::: "memory");
    __syncthreads();
    if (threadIdx.x == 0) {
        unsigned* bar = b.bar;
        __builtin_amdgcn_s_waitcnt(0);
        unsigned nloc = b.st[0], nx = b.st[1];
        if (nloc == 0u) { xcd_barrier_complete(bar, b.x, nloc, nx); b.st[0] = nloc; b.st[1] = nx; }
        const unsigned old = xb_add(&bar[XB_XSUB(b.x)], 1u);
        const unsigned gen = old / nloc;
        if (old + 1u == (gen + 1u) * nloc) {
            __builtin_amdgcn_fence(__ATOMIC_RELEASE, "agent");
            asm volatile("s_waitcnt vmcnt(0)" ::: "memory");
            const unsigned og = xb_add(&bar[XB_TOP], 1u);
            const unsigned tg = og / nx;
            if (og + 1u == (tg + 1u) * nx) xb_add(&bar[XB_TOPGEN], 1u);
            else XB_SPIN(xb_ld(&bar[XB_TOPGEN]) == tg, bar);
            __builtin_amdgcn_fence(__ATOMIC_ACQUIRE, "agent");
            xb_add(&bar[XB_XGEN(b.x)], 1u);
            asm volatile("s_waitcnt vmcnt(0)" ::: "memory");
        } else {
            XB_SPIN(xb_ld(&bar[XB_XGEN(b.x)]) == gen, bar);
            __builtin_amdgcn_fence(__ATOMIC_ACQUIRE, "agent");
            asm volatile("s_waitcnt vmcnt(0)" ::: "memory");
        }
    }
    __syncthreads();
}

constexpr int NWAVES = 8;
#ifndef MK_PER_PHASE
#define MK_PER_PHASE 0
#endif
constexpr int N_PHASES = 15;

constexpr int NB = 2, SEQ = 8192, DM = 2048, M = NB * SEQ;
constexpr int NH = 8, HD = 128, AW = NH * HD, CWID = 1024, NPROJ = 3 * AW + 3 * CWID + 2 * DM;
constexpr int NMEM = 256, XH = 4, XW = XH * HD, DFF = 4 * DM;
constexpr int MBLK = 256, NBLK = SEQ / MBLK, TOPK = 3;
constexpr float EPS = 1e-6f;
constexpr float ATT_SCALE = 0.08838834764831845f;

constexpr size_t MiB = 1u << 20;
constexpr size_t WS_CTL = 0, CTL_ZERO_BYTES = 1 * MiB;
constexpr size_t WS_ROPE = 2 * MiB;
constexpr size_t WS_KMEAN = 3 * MiB;
constexpr size_t WS_R2 = 3 * MiB + 512 * 1024;
constexpr size_t WS_R3 = WS_R2 + 64 * 1024;
constexpr size_t WS_MEMN = 4 * MiB;
constexpr size_t WS_MKV = 6 * MiB;
constexpr size_t WS_WIN = 8 * MiB;
constexpr size_t WS_WA = 48 * MiB, WS_WC = 52 * MiB;
constexpr size_t WS_WM = 56 * MiB;
constexpr size_t WS_WQ = 64 * MiB;
constexpr size_t WS_WKV = 66 * MiB;
constexpr size_t WS_WO = 70 * MiB;
constexpr size_t WS_WUP = 72 * MiB;
constexpr size_t WS_WD = 104 * MiB;
constexpr size_t WS_XB = 136 * MiB;
constexpr size_t WS_G = 200 * MiB;
constexpr size_t GRP = 32 * MiB;
constexpr size_t WS_YA = 200 * MiB, WS_YC = 264 * MiB;
constexpr size_t WS_MERGED = 328 * MiB;
constexpr size_t WS_HQ = 200 * MiB, WS_XO = 216 * MiB;
constexpr size_t WS_UP = 232 * MiB;
constexpr size_t WS_END = 488 * MiB;
constexpr size_t DO_AO = 0, DO_CO = 32 * MiB, DO_GC = 64 * MiB;
constexpr int CW_TMO = 0, CW_CODE = 1, CW_BAR = 4096;

constexpr int RING_OFF = 0, RING_BYTES = 131072;
constexpr int LDSCTL_OFF = RING_BYTES, MISC_OFF = LDSCTL_OFF + 320;
constexpr int LDS_BYTES = 147456;

__device__ __forceinline__ float bf2f(unsigned short b) { return __uint_as_float((unsigned)b << 16); }
__device__ __forceinline__ float bflo(unsigned w) { return __uint_as_float(w << 16); }
__device__ __forceinline__ float bfhi(unsigned w) { return __uint_as_float(w & 0xffff0000u); }
__device__ __forceinline__ float wave_sum(float v) {
#pragma unroll
    for (int o = 1; o < 64; o <<= 1) v += __shfl_xor(v, o);
    return v;
}
__device__ __forceinline__ float wave_max(float v) {
#pragma unroll
    for (int o = 1; o < 64; o <<= 1) v = fmaxf(v, __shfl_xor(v, o));
    return v;
}

__device__ __forceinline__ void p0_transpose_item(const float* W, int K, int N, bf16* WT, int ldk, int koff, int row_off, const float* gk, LAS float* scr, int item, int lane) {
    const int nblk = N / 32, kb = item / nblk, nb = item % nblk, k0 = 64 * kb, n0 = 32 * nb;
#pragma unroll 8
    for (int i = 0; i < 32; ++i) { const int kk = 2 * i + (lane >> 5); float w = W[(size_t)(k0 + kk) * N + n0 + (lane & 31)]; if (gk) w *= gk[k0 + kk]; scr[kk * 33 + (lane & 31)] = w; }
    LDS_WAIT(); asm volatile("" ::: "memory");
    const int c = lane & 7;
#pragma unroll
    for (int j = 0; j < 4; ++j) { const int n = (lane >> 3) + 8 * j; const LAS float* s = scr + (8 * c) * 33 + n;
        v4u o; o.x = pk2(s[0 * 33], s[1 * 33]); o.y = pk2(s[2 * 33], s[3 * 33]); o.z = pk2(s[4 * 33], s[5 * 33]); o.w = pk2(s[6 * 33], s[7 * 33]);
        *(GAS v4u*)(WT + (size_t)(row_off + n0 + n) * ldk + koff + k0 + 8 * c) = o; }
    LDS_WAIT(); asm volatile("" ::: "memory");
}
__device__ __forceinline__ void rms_row_to_bf16(const float* xrow, const float* g, bf16* orow, int lane) {
    const GAS f32x4* xr = (const GAS f32x4*)xrow + lane; const GAS f32x4* gr = (const GAS f32x4*)g + lane;
    f32x4 v[8]; float s = 0.f;
#pragma unroll
    for (int j = 0; j < 8; ++j) { v[j] = xr[64 * j]; s += (v[j].x * v[j].x + v[j].y * v[j].y) + (v[j].z * v[j].z + v[j].w * v[j].w); }
    const float rstd = 1.f / sqrtf(wave_sum(s) * (1.f / DM) + EPS);
    GAS unsigned long long* o8 = (GAS unsigned long long*)orow + lane;
#pragma unroll
    for (int j = 0; j < 8; ++j) { const f32x4 gg = gr[64 * j];
        o8[64 * j] = (unsigned long long)pk2(v[j].x * rstd * gg.x, v[j].y * rstd * gg.y) | ((unsigned long long)pk2(v[j].z * rstd * gg.z, v[j].w * rstd * gg.w) << 32); }
}
__device__ __forceinline__ float row_rstd(const float* xrow, int lane) {
    const GAS f32x4* xr = (const GAS f32x4*)xrow + lane; float s = 0.f;
#pragma unroll
    for (int j = 0; j < 8; ++j) { const f32x4 v = xr[64 * j]; s += (v.x * v.x + v.y * v.y) + (v.z * v.z + v.w * v.w); }
    return 1.f / sqrtf(wave_sum(s) * (1.f / DM) + EPS);
}

__device__ const float ROPE_INV_FREQ[16] = {1.f, 0.440366596f, 0.193922743f, 0.0853971019f, 0.0376060307f, 0.016560439f, 0.00729266461f, 0.00321144587f, 0.00141421356f, 0.000622772379f, 0.000274248188f, 0.000120769735f, 5.3182961e-05f, 2.34199997e-05f, 1.03133862e-05f, 4.54167048e-06f};
struct Args { const float* in[17]; float* out; unsigned char* ws; int ph_lo, ph_hi, li, pad; };

__device__ __forceinline__ void naive_moba_item(int b, int h, int i, const bf16* QP, const bf16* KP, const bf16* VP, const float2* ROPE, const float* KMEAN, bf16* AO, int lane) {
    const size_t t = (size_t)b * SEQ + i; const int qb = i >> 8;
    float q[128];
    { const v4u* qp = (const v4u*)(QP + t * AW + h * HD);
#pragma unroll
      for (int c = 0; c < 16; ++c) { const v4u w = qp[c]; q[8 * c + 0] = bflo(w.x); q[8 * c + 1] = bfhi(w.x); q[8 * c + 2] = bflo(w.y); q[8 * c + 3] = bfhi(w.y); q[8 * c + 4] = bflo(w.z); q[8 * c + 5] = bfhi(w.z); q[8 * c + 6] = bflo(w.w); q[8 * c + 7] = bfhi(w.w); } }
#pragma unroll
    for (int d = 0; d < 16; ++d) { const float2 cs = ROPE[i * 16 + d]; const float q1 = q[d], q2 = q[d + 16]; q[d] = q1 * cs.x - q2 * cs.y; q[d + 16] = q2 * cs.x + q1 * cs.y; }
    float g = -INFINITY;
    if (lane < qb) { const f32x4* km = (const f32x4*)(KMEAN + ((size_t)(b * NH + h) * NBLK + lane) * HD); float a = 0.f;
#pragma unroll
        for (int c = 0; c < 32; ++c) { const f32x4 k4 = km[c]; a += q[4 * c] * k4.x + q[4 * c + 1] * k4.y + q[4 * c + 2] * k4.z + q[4 * c + 3] * k4.w; }
        g = a; }
    unsigned selmask = 0u;
#pragma unroll
    for (int k = 0; k < TOPK; ++k) { const float mx = wave_max(g);
        if (mx != -INFINITY) { const unsigned long long bal = __ballot(g == mx); const int idx = __ffsll((long long)bal) - 1; selmask |= 1u << idx; if (lane == idx) g = -INFINITY; } }
    selmask |= 1u << qb;
    float s[4][4]; int blk[4]; bool valid[4];
#pragma unroll
    for (int c = 0; c < 4; ++c) { valid[c] = selmask != 0u; blk[c] = valid[c] ? (__ffs((int)selmask) - 1) : 0; selmask &= selmask - 1u; }
    float mloc = -INFINITY;
#pragma unroll
    for (int c = 0; c < 4; ++c)
#pragma unroll
        for (int r = 0; r < 4; ++r) { const int key = blk[c] * MBLK + lane + 64 * r; float sc = -INFINITY;
            if (valid[c] && key <= i) { const v4u* kp = (const v4u*)(KP + ((size_t)b * SEQ + key) * AW + h * HD); float kk[32]; float a = 0.f;
#pragma unroll
                for (int cc = 0; cc < 4; ++cc) { const v4u w = kp[cc]; kk[8 * cc + 0] = bflo(w.x); kk[8 * cc + 1] = bfhi(w.x); kk[8 * cc + 2] = bflo(w.y); kk[8 * cc + 3] = bfhi(w.y); kk[8 * cc + 4] = bflo(w.z); kk[8 * cc + 5] = bfhi(w.z); kk[8 * cc + 6] = bflo(w.w); kk[8 * cc + 7] = bfhi(w.w); }
#pragma unroll
                for (int d = 0; d < 16; ++d) { const float2 cs = ROPE[key * 16 + d]; const float k1 = kk[d], k2 = kk[d + 16]; a += q[d] * (k1 * cs.x - k2 * cs.y) + q[d + 16] * (k2 * cs.x + k1 * cs.y); }
#pragma unroll
                for (int cc = 4; cc < 16; ++cc) { const v4u w = kp[cc]; a += q[8 * cc + 0] * bflo(w.x) + q[8 * cc + 1] * bfhi(w.x) + q[8 * cc + 2] * bflo(w.y) + q[8 * cc + 3] * bfhi(w.y) + q[8 * cc + 4] * bflo(w.z) + q[8 * cc + 5] * bfhi(w.z) + q[8 * cc + 6] * bflo(w.w) + q[8 * cc + 7] * bfhi(w.w); }
                sc = a * ATT_SCALE; }
            s[c][r] = sc; mloc = fmaxf(mloc, sc); }
    const float mx = wave_max(mloc); float lsum = 0.f;
#pragma unroll
    for (int c = 0; c < 4; ++c)
#pragma unroll
        for (int r = 0; r < 4; ++r) { s[c][r] = __expf(s[c][r] - mx); lsum += s[c][r]; }
    const float l = wave_sum(lsum);
    float o0 = 0.f, o1 = 0.f;
#pragma unroll
    for (int c = 0; c < 4; ++c) { if (!valid[c]) continue;
#pragma unroll
        for (int r = 0; r < 4; ++r) { const bf16* vp = VP + ((size_t)b * SEQ + blk[c] * MBLK + 64 * r) * AW + h * HD + 2 * lane;
            for (int src = 0; src < 64; ++src) { const float p = __shfl(s[c][r], src); const unsigned w = *(const unsigned*)(vp + (size_t)src * AW); o0 += p * bflo(w); o1 += p * bfhi(w); } } }
    const float rl = 1.f / l;
    *(unsigned*)(AO + t * AW + h * HD + 2 * lane) = pk2(o0 * rl, o1 * rl);
}
__device__ __forceinline__ void naive_xattn_item(int b, int h, int i, const bf16* HQ, const float* R2, const bf16* MKV, bf16* XO, int lane) {
    const size_t t = (size_t)b * SEQ + i; const float qs = R2[t] * ATT_SCALE;
    float q[128];
    { const v4u* qp = (const v4u*)(HQ + t * XW + h * HD);
#pragma unroll
      for (int c = 0; c < 16; ++c) { const v4u w = qp[c]; q[8 * c + 0] = bflo(w.x) * qs; q[8 * c + 1] = bfhi(w.x) * qs; q[8 * c + 2] = bflo(w.y) * qs; q[8 * c + 3] = bfhi(w.y) * qs; q[8 * c + 4] = bflo(w.z) * qs; q[8 * c + 5] = bfhi(w.z) * qs; q[8 * c + 6] = bflo(w.w) * qs; q[8 * c + 7] = bfhi(w.w) * qs; } }
    float s[4]; float mloc = -INFINITY;
#pragma unroll
    for (int r = 0; r < 4; ++r) { const int key = lane + 64 * r; const v4u* kp = (const v4u*)(MKV + ((size_t)b * NMEM + key) * (2 * XW) + h * HD); float a = 0.f;
#pragma unroll
        for (int cc = 0; cc < 16; ++cc) { const v4u w = kp[cc]; a += q[8 * cc + 0] * bflo(w.x) + q[8 * cc + 1] * bfhi(w.x) + q[8 * cc + 2] * bflo(w.y) + q[8 * cc + 3] * bfhi(w.y) + q[8 * cc + 4] * bflo(w.z) + q[8 * cc + 5] * bfhi(w.z) + q[8 * cc + 6] * bflo(w.w) + q[8 * cc + 7] * bfhi(w.w); }
        s[r] = a; mloc = fmaxf(mloc, a); }
    const float mx = wave_max(mloc); float lsum = 0.f;
#pragma unroll
    for (int r = 0; r < 4; ++r) { s[r] = __expf(s[r] - mx); lsum += s[r]; }
    const float l = wave_sum(lsum);
    float o0 = 0.f, o1 = 0.f;
#pragma unroll
    for (int r = 0; r < 4; ++r) { const bf16* vp = MKV + ((size_t)b * NMEM + 64 * r) * (2 * XW) + XW + h * HD + 2 * lane;
        for (int src = 0; src < 64; ++src) { const float p = __shfl(s[r], src); const unsigned w = *(const unsigned*)(vp + (size_t)src * (2 * XW)); o0 += p * bflo(w); o1 += p * bfhi(w); } }
    const float rl = 1.f / l;
    *(unsigned*)(XO + t * XW + h * HD + 2 * lane) = pk2(o0 * rl, o1 * rl);
}

__global__ void __launch_bounds__(NWAVES * 64, 2) mk_fwd(Args args) {
    extern __shared__ __attribute__((aligned(16))) unsigned char lds[];
    LAS unsigned char* const ldsp = (LAS unsigned char*)lds;
    volatile LAS unsigned* const MISC = (volatile LAS unsigned*)(ldsp + MISC_OFF);
    const int tid = threadIdx.x, lane = tid & 63, wave = __builtin_amdgcn_readfirstlane(tid >> 6);
    const int G = gridDim.x; const int bx = blockIdx.x; const int vcu = (G % 8 == 0) ? (bx % 8) * (G / 8) + bx / 8 : bx;
    unsigned char* const ws = args.ws;
    gu32* const ctl = (gu32*)(ws + WS_CTL);
    for (int u = tid; u < (LDS_BYTES - LDSCTL_OFF) / 4; u += NWAVES * 64) ((LAS unsigned*)(ldsp + LDSCTL_OFF))[u] = 0u;
    __syncthreads();
    XcdBarrier bar; bar.bar = (unsigned*)(ctl + CW_BAR); bar.x = 0; bar.st = nullptr;
    if (!MK_PER_PHASE) bar = xcd_barrier_post((unsigned*)(ctl + CW_BAR), MISC + 8);
    const int lo = args.ph_lo, hi = args.ph_hi;
#define IN(k) (lo <= (k) && (k) < hi)
#define SEAM(k) do { if (IN(k) && IN((k) + 1)) xcd_barrier(bar); } while (0)
    const int gw = vcu * NWAVES + wave, NGW = G * NWAVES;
    const int gt = vcu * (NWAVES * 64) + tid, NGT = G * NWAVES * 64;

    const float* x = args.in[0]; const float* mem = args.in[1]; const float* norm_mix = args.in[2]; const float* w_in = args.in[3]; const float* conv_w = args.in[4];
    const float* w_attn_out = args.in[5]; const float* w_conv_out = args.in[6]; const float* w_mix_out = args.in[7]; const float* norm_xattn = args.in[8]; const float* norm_mem = args.in[9];
    const float* wq_x = args.in[10]; const float* wkv_x = args.in[11]; const float* wo_x = args.in[12]; const float* norm_mlp = args.in[13]; const float* w_up = args.in[14]; const float* w_down = args.in[15];
    const float* norm_final = args.in[16];
    float* const out = args.out; unsigned char* const outb = (unsigned char*)args.out;
    float2* const ROPE = (float2*)(ws + WS_ROPE); float* const KMEAN = (float*)(ws + WS_KMEAN); float* const R2 = (float*)(ws + WS_R2); float* const R3 = (float*)(ws + WS_R3);
    bf16* const MEMN = (bf16*)(ws + WS_MEMN); bf16* const MKV = (bf16*)(ws + WS_MKV);
    bf16* const WIN = (bf16*)(ws + WS_WIN); bf16* const WA = (bf16*)(ws + WS_WA); bf16* const WC = (bf16*)(ws + WS_WC); bf16* const WM = (bf16*)(ws + WS_WM);
    bf16* const WQ = (bf16*)(ws + WS_WQ); bf16* const WKV = (bf16*)(ws + WS_WKV); bf16* const WO = (bf16*)(ws + WS_WO); bf16* const WUP = (bf16*)(ws + WS_WUP); bf16* const WD = (bf16*)(ws + WS_WD);
    bf16* const XB = (bf16*)(ws + WS_XB);
    bf16* const QP = (bf16*)(ws + WS_G), * const KP = (bf16*)(ws + WS_G + GRP), * const VP = (bf16*)(ws + WS_G + 2 * GRP), * const CX = (bf16*)(ws + WS_G + 3 * GRP);
    bf16* const CB = (bf16*)(ws + WS_G + 4 * GRP), * const CC = (bf16*)(ws + WS_G + 5 * GRP), * const GA = (bf16*)(ws + WS_G + 6 * GRP)  ;
    bf16* const GC = (bf16*)(outb + DO_GC); bf16* const AO = (bf16*)(outb + DO_AO); bf16* const CO = (bf16*)(outb + DO_CO);
    bf16* const YA = (bf16*)(ws + WS_YA); bf16* const YC = (bf16*)(ws + WS_YC); bf16* const MERGED = (bf16*)(ws + WS_MERGED);
    bf16* const HQ = (bf16*)(ws + WS_HQ); bf16* const XO = (bf16*)(ws + WS_XO); bf16* const UP = (bf16*)(ws + WS_UP);

    if (IN(0)) {
        LAS float* scr = (LAS float*)(ldsp + RING_OFF + wave * 16384);
        constexpr int I_IN = (DM / 64) * (NPROJ / 32), I_A = (AW / 64) * (DM / 32), I_C = I_A, I_M = (DM / 64) * (DM / 32), I_Q = (DM / 64) * (XW / 32), I_KV = (DM / 64) * (2 * XW / 32),
                      I_O = (XW / 64) * (DM / 32), I_UP = (DM / 64) * (DFF / 32), I_D = (DFF / 64) * (DM / 32);
        constexpr int NITEMS = I_IN + I_A + I_C + I_M + I_Q + I_KV + I_O + I_UP + I_D;
        for (int it = gw; it < NITEMS; it += NGW) {
            int r = it;
            if (r < I_IN) { p0_transpose_item(w_in, DM, NPROJ, WIN, DM, 0, 0, nullptr, scr, r, lane); continue; } r -= I_IN;
            if (r < I_A) { p0_transpose_item(w_attn_out, AW, DM, WA, AW, 0, 0, nullptr, scr, r, lane); continue; } r -= I_A;
            if (r < I_C) { p0_transpose_item(w_conv_out, CWID, DM, WC, CWID, 0, 0, nullptr, scr, r, lane); continue; } r -= I_C;
            if (r < I_M) { p0_transpose_item(w_mix_out, DM, DM, WM, DM, 0, 0, nullptr, scr, r, lane); continue; } r -= I_M;
            if (r < I_Q) { p0_transpose_item(wq_x, DM, XW, WQ, DM, 0, 0, norm_xattn, scr, r, lane); continue; } r -= I_Q;
            if (r < I_KV) { p0_transpose_item(wkv_x, DM, 2 * XW, WKV, DM, 0, 0, nullptr, scr, r, lane); continue; } r -= I_KV;
            if (r < I_O) { p0_transpose_item(wo_x, XW, DM, WO, XW, 0, 0, nullptr, scr, r, lane); continue; } r -= I_O;
            if (r < I_UP) { p0_transpose_item(w_up, DM, DFF, WUP, DM, 0, 0, norm_mlp, scr, r, lane); continue; } r -= I_UP;
            p0_transpose_item(w_down, DFF, DM, WD, DFF, 0, 0, nullptr, scr, r, lane);
        }
        for (int m = gw; m < M; m += NGW) rms_row_to_bf16(x + (size_t)m * DM, norm_mix, XB + (size_t)m * DM, lane);
        for (int m = gw; m < NB * NMEM; m += NGW) rms_row_to_bf16(mem + (size_t)m * DM, norm_mem, MEMN + (size_t)m * DM, lane);
        for (int e = gt; e < SEQ * 16; e += NGT) { const int pos = e >> 4, j = e & 15;
            const float inv_freq = ROPE_INV_FREQ[j]; const float ang = (float)pos * inv_freq;
            const double turns = (double)ang * 0.15915494309189535; const float fr = (float)(turns - rint(turns));
            ROPE[e] = make_float2(__builtin_amdgcn_cosf(fr), __builtin_amdgcn_sinf(fr)); }
    }
    SEAM(0);
    if (IN(1)) {
        { pg8::Gemm g{XB, WIN, M, NPROJ, DM}; pg8::StaticOrder S; S.init(M, NPROJ, G, bx);
          pg8::EpiBf16G E{QP, GC, 8, (size_t)M * 1024, 1024, 1024};
          pg8::gemm_phase<pg8::EpiBf16G, pg8::StaticOrder, true, true>(ldsp + RING_OFF, g, S, E); }
        { pg8::Gemm g{MEMN, WKV, NB * NMEM, 2 * XW, DM}; pg8::StaticOrder S; S.init(NB * NMEM, 2 * XW, G, bx);
          pg8::EpiBf16G E{MKV, MKV, 1 << 30, 0, 1 << 30, 2 * XW};
          pg8::gemm_phase<pg8::EpiBf16G, pg8::StaticOrder, true, true>(ldsp + RING_OFF, g, S, E); }
    }
    SEAM(1);
    if (IN(2)) {
        for (int e = gt; e < NB * NH * NBLK * HD; e += NGT) { const int d = e & 127, n = (e >> 7) & 31, h = (e >> 12) & 7, b = e >> 15; float a = 0.f;
            for (int j = 0; j < MBLK; ++j) { const int pos = n * MBLK + j; const bf16* kp = KP + ((size_t)b * SEQ + pos) * AW + h * HD; float v;
                if (d < 16) { const float2 cs = ROPE[pos * 16 + d]; v = bf2f(kp[d]) * cs.x - bf2f(kp[d + 16]) * cs.y; }
                else if (d < 32) { const float2 cs = ROPE[pos * 16 + d - 16]; v = bf2f(kp[d]) * cs.x + bf2f(kp[d - 16]) * cs.y; }
                else v = bf2f(kp[d]);
                a += v; }
            KMEAN[e] = a * (1.f / MBLK); }
    }
    SEAM(2);
    if (IN(3)) {
        for (int it = gw; it < NB * NH * SEQ; it += NGW) { const int i = it & (SEQ - 1), h = (it >> 13) & 7, b = it >> 16; naive_moba_item(b, h, i, QP, KP, VP, ROPE, KMEAN, AO, lane); }
        for (int e = gt; e < M * (CWID / 2); e += NGT) { const int c2 = e & 511; const int t = e >> 9; const int s = t & (SEQ - 1); const int c = 2 * c2;
            const unsigned x0 = *(const unsigned*)(CX + (size_t)t * CWID + c), c0 = *(const unsigned*)(CC + (size_t)t * CWID + c);
            float y0 = conv_w[2 * CWID + c] * (bflo(x0) * bflo(c0)), y1 = conv_w[2 * CWID + c + 1] * (bfhi(x0) * bfhi(c0));
            if (s >= 1) { const unsigned x1 = *(const unsigned*)(CX + (size_t)(t - 1) * CWID + c), c1 = *(const unsigned*)(CC + (size_t)(t - 1) * CWID + c);
                y0 += conv_w[CWID + c] * (bflo(x1) * bflo(c1)); y1 += conv_w[CWID + c + 1] * (bfhi(x1) * bfhi(c1)); }
            if (s >= 2) { const unsigned x2 = *(const unsigned*)(CX + (size_t)(t - 2) * CWID + c), c2v = *(const unsigned*)(CC + (size_t)(t - 2) * CWID + c);
                y0 += conv_w[c] * (bflo(x2) * bflo(c2v)); y1 += conv_w[c + 1] * (bfhi(x2) * bfhi(c2v)); }
            const unsigned b0 = *(const unsigned*)(CB + (size_t)t * CWID + c);
            *(unsigned*)(CO + (size_t)t * CWID + c) = pk2(bflo(b0) * y0, bfhi(b0) * y1); }
    }
    SEAM(3);
    if (IN(4)) {
        { pg8::Gemm g{AO, WA, M, DM, AW}; pg8::StaticOrder S; S.init(M, DM, G, bx); pg8::EpiBf16G E{YA, YA, 1 << 30, 0, 1 << 30, DM};
          pg8::gemm_phase<pg8::EpiBf16G, pg8::StaticOrder, true, true>(ldsp + RING_OFF, g, S, E); }
        { pg8::Gemm g{CO, WC, M, DM, CWID}; pg8::StaticOrder S; S.init(M, DM, G, bx); pg8::EpiBf16G E{YC, YC, 1 << 30, 0, 1 << 30, DM};
          pg8::gemm_phase<pg8::EpiBf16G, pg8::StaticOrder, true, true>(ldsp + RING_OFF, g, S, E); }
    }
    SEAM(4);
    if (IN(5)) {
        for (int e = gt; e < M * (DM / 2); e += NGT) { const int c2 = e & 1023; const int t = e >> 10; const int c = 2 * c2; const int gi = c >> 10, cc = c & 1023;
            const unsigned a = *(const unsigned*)(GA + (size_t)gi * M * 1024 + (size_t)t * 1024 + cc), cg = *(const unsigned*)(GC + (size_t)gi * M * 1024 + (size_t)t * 1024 + cc);
            const unsigned ya = *(const unsigned*)(YA + (size_t)t * DM + c), yc = *(const unsigned*)(YC + (size_t)t * DM + c);
            const float s0 = 1.f / (1.f + __expf(-bflo(a))), s1 = 1.f / (1.f + __expf(-bfhi(a))), u0 = 1.f / (1.f + __expf(-bflo(cg))), u1 = 1.f / (1.f + __expf(-bfhi(cg)));
            *(unsigned*)(MERGED + (size_t)t * DM + c) = pk2(s0 * bflo(ya) + u0 * bflo(yc), s1 * bfhi(ya) + u1 * bfhi(yc)); }
    }
    SEAM(5);
    if (IN(6)) {
        pg8::Gemm g{MERGED, WM, M, DM, DM}; pg8::StaticOrder S; S.init(M, DM, G, bx); pg8::EpiResid E{x, out, XB, DM};
        pg8::gemm_phase<pg8::EpiResid, pg8::StaticOrder, true, true>(ldsp + RING_OFF, g, S, E);
    }
    SEAM(6);
    if (IN(7)) { for (int m = gw; m < M; m += NGW) { const float r = row_rstd(out + (size_t)m * DM, lane); if (lane == 0) R2[m] = r; } }
    SEAM(7);
    if (IN(8)) {
        pg8::Gemm g{XB, WQ, M, XW, DM}; pg8::StaticOrder S; S.init(M, XW, G, bx); pg8::EpiBf16G E{HQ, HQ, 1 << 30, 0, 1 << 30, XW};
        pg8::gemm_phase<pg8::EpiBf16G, pg8::StaticOrder, true, true>(ldsp + RING_OFF, g, S, E);
    }
    SEAM(8);
    if (IN(9)) { for (int it = gw; it < NB * XH * SEQ; it += NGW) { const int i = it & (SEQ - 1), h = (it >> 13) & 3, b = it >> 15; naive_xattn_item(b, h, i, HQ, R2, MKV, XO, lane); } }
    SEAM(9);
    if (IN(10)) {
        pg8::Gemm g{XO, WO, M, DM, XW}; pg8::StaticOrder S; S.init(M, DM, G, bx); pg8::EpiResid E{out, out, XB, DM};
        pg8::gemm_phase<pg8::EpiResid, pg8::StaticOrder, true, true>(ldsp + RING_OFF, g, S, E);
    }
    SEAM(10);
    if (IN(11)) { for (int m = gw; m < M; m += NGW) { const float r = row_rstd(out + (size_t)m * DM, lane); if (lane == 0) R3[m] = r; } }
    SEAM(11);
    if (IN(12)) {
        pg8::Gemm g{XB, WUP, M, DFF, DM}; pg8::StaticOrder S; S.init(M, DFF, G, bx); pg8::EpiUp E{UP, DFF, R3};
        pg8::gemm_phase<pg8::EpiUp, pg8::StaticOrder, true, true>(ldsp + RING_OFF, g, S, E);
    }
    SEAM(12);
    if (IN(13)) {
        pg8::Gemm g{UP, WD, M, DM, DFF}; pg8::StaticOrder S; S.init(M, DM, G, bx); pg8::EpiResid E{out, out, nullptr, DM};
        pg8::gemm_phase<pg8::EpiResid, pg8::StaticOrder, true, true>(ldsp + RING_OFF, g, S, E);
    }
    SEAM(13);
    if (IN(14)) {
        for (int m = gw; m < M; m += NGW) { GAS f32x4* xr = (GAS f32x4*)(out + (size_t)m * DM) + lane; const GAS f32x4* gr = (const GAS f32x4*)norm_final + lane; f32x4 v[8]; float s = 0.f;
#pragma unroll
            for (int j = 0; j < 8; ++j) { v[j] = xr[64 * j]; s += (v[j].x * v[j].x + v[j].y * v[j].y) + (v[j].z * v[j].z + v[j].w * v[j].w); }
            const float rstd = 1.f / sqrtf(wave_sum(s) * (1.f / DM) + EPS);
#pragma unroll
            for (int j = 0; j < 8; ++j) { const f32x4 gg = gr[64 * j]; xr[64 * j] = (f32x4){v[j].x * rstd * gg.x, v[j].y * rstd * gg.y, v[j].z * rstd * gg.z, v[j].w * rstd * gg.w}; } }
    }
#undef IN
#undef SEAM
}

extern "C" void kernel_launch(void* const* d_in, const int* in_sizes, int n_in, void* d_out, int out_size, void* d_ws, size_t ws_size, hipStream_t stream) {
    static int grid = 0;
    if (grid == 0) {
        if (n_in != 17 || in_sizes[0] != M * DM || out_size != M * DM || ws_size < WS_END) { fprintf(stderr, "kernel_launch: unexpected shapes: n_in %d in0 %d out %d ws %zu (need %zu)\n", n_in, n_in > 0 ? in_sizes[0] : -1, out_size, ws_size, (size_t)WS_END); grid = -1; return; }
        int dev = 0, cus = 0, per_cu = 0;
        if (hipGetDevice(&dev) != hipSuccess || hipDeviceGetAttribute(&cus, hipDeviceAttributeMultiprocessorCount, dev) != hipSuccess) { fprintf(stderr, "kernel_launch: device query failed\n"); grid = -1; return; }
        if (hipFuncSetAttribute((const void*)mk_fwd, hipFuncAttributeMaxDynamicSharedMemorySize, LDS_BYTES) != hipSuccess) { fprintf(stderr, "kernel_launch: hipFuncSetAttribute failed\n"); grid = -1; return; }
        if (hipOccupancyMaxActiveBlocksPerMultiprocessor(&per_cu, (const void*)mk_fwd, NWAVES * 64, LDS_BYTES) != hipSuccess || per_cu < 1) fprintf(stderr, "kernel_launch: note: occupancy query reports %d workgroups per CU\n", per_cu);
        (void)hipGetLastError();
        grid = cus;
    }
    if (grid < 0) return;
    if (hipMemsetAsync((char*)d_ws + WS_CTL, 0, CTL_ZERO_BYTES, stream) != hipSuccess) { fprintf(stderr, "kernel_launch: hipMemsetAsync failed\n"); return; }
    Args a{};
    for (int i = 0; i < 17; ++i) a.in[i] = (const float*)d_in[i];
    a.out = (float*)d_out; a.ws = (unsigned char*)d_ws;
#if MK_PER_PHASE
    for (int p = 0; p < N_PHASES; ++p) { a.ph_lo = p; a.ph_hi = p + 1; a.li = p; hipLaunchKernelGGL(mk_fwd, dim3(grid), dim3(NWAVES * 64), LDS_BYTES, stream, a); }
#else
    a.ph_lo = 0; a.ph_hi = N_PHASES; a.li = 0;
    hipLaunchKernelGGL(mk_fwd, dim3(grid), dim3(NWAVES * 64), LDS_BYTES, stream, a);
#endif
    const hipError_t le = hipPeekAtLastError();
    if (le != hipSuccess) fprintf(stderr, "kernel_launch: launch failed: %s\n", hipGetErrorName(le));
}
```

```cpp
#include <hip/hip_runtime.h>
#include <cstdio>
#include <cstdint>
namespace pg8 {
#define PG8_LAS __attribute__((address_space(3)))
typedef unsigned short bf16_t;
typedef short bf16x8 __attribute__((ext_vector_type(8)));
typedef float f32x4 __attribute__((ext_vector_type(4)));
typedef unsigned u32x4 __attribute__((ext_vector_type(4)));
constexpr int BM = 256, BK = 64, HALF = 128, HTB = HALF * BK * 2  , STAGE_BYTES = 8 * HTB, NXCD = 8, WGM = 8;

__host__ __device__ __forceinline__ int lds_byte(int r, int c) { const int st = (r >> 4) * 2 + (c >> 5), rr = r & 15, cc = c & 31, ob = rr * 64 + cc * 2; return st * 1024 + (ob ^ (((ob >> 9) & 1) << 5)); }
__host__ __device__ __forceinline__ void stage_rc(int b, int& R, int& C) { const int st = b / 1024, sb = b % 1024, swz = sb ^ (((sb >> 9) & 1) << 5); R = (st >> 1) * 16 + swz / 64; C = (st & 1) * 32 + (swz % 64) / 2; }
__host__ __device__ __forceinline__ int perm32(int rho) { const int n = rho >> 4, i = rho & 15; return 8 * (i >> 2) + 4 * n + (i & 3); }

struct Unit { int pm, pn; };
struct Gemm { const bf16_t* A; const bf16_t* Bt; int M, N, K; };

struct StaticOrder {
    int nM, nN, nwg, G, c;
    __host__ __device__ void init(int M, int N, int G_, int c_) { nM = M / BM; nN = N / BM; nwg = nM * nN; G = G_; c = c_; }
    __host__ __device__ bool next(int i, Unit& u) const {
        const long L = (long)i * G + c; if (L >= nwg) return false;
        int wgid = (int)L; { const int q = nwg / NXCD, r = nwg % NXCD, xcd = wgid % NXCD, off = wgid / NXCD; wgid = (xcd < r ? xcd * (q + 1) : r * (q + 1) + (xcd - r) * q) + off; }
        const int nig = WGM * nN, gid = wgid / nig, fm = gid * WGM, gsz = (nM - fm) < WGM ? (nM - fm) : WGM;
        u.pm = fm + ((wgid % nig) % gsz); u.pn = (wgid % nig) / gsz; return true;
    }
    __device__ __forceinline__ void a_ready(const Unit&) const {}
    __device__ __forceinline__ void done(const Unit&) const {}
};


__device__ __forceinline__ unsigned cvt_pk_bf16(float lo, float hi) { unsigned r; asm volatile("v_cvt_pk_bf16_f32 %0, %1, %2" : "=v"(r) : "v"(lo), "v"(hi)); return r; }
typedef unsigned u32x2 __attribute__((ext_vector_type(2)));

struct EpiBf16G {
    static constexpr bool PERM = true, AFTER_DRAIN = false;
    bf16_t* g0; bf16_t* g1; int tsplit; size_t gstride; int gcols; int ldc; const float* rs;
    __device__ __forceinline__ void operator()(const f32x4 (&acc)[2][2][4][2], const Unit& u, int wr, int wc, int fr, int fq) const {
        const int row0 = u.pm * BM + wr * 64 + fr; int colt = u.pn * BM; const int t = colt / gcols; colt -= t * gcols;
        bf16_t* base = (t < tsplit) ? g0 + (size_t)t * gstride : g1 + (size_t)(t - tsplit) * gstride;
        const int col0 = colt + wc * 32 + 8 * fq;
#pragma unroll
        for (int ai = 0; ai < 2; ++ai)
#pragma unroll
            for (int m = 0; m < 4; ++m) { bf16_t* rowp = base + (size_t)(row0 + ai * HALF + m * 16) * ldc + col0; const float s = rs ? rs[row0 + ai * HALF + m * 16] : 1.f;
#pragma unroll
                for (int bj = 0; bj < 2; ++bj) { const f32x4 v0 = acc[ai][bj][m][0] * s, v1 = acc[ai][bj][m][1] * s;
                    u32x4 w; w.x = cvt_pk_bf16(v0[0], v0[1]); w.y = cvt_pk_bf16(v0[2], v0[3]); w.z = cvt_pk_bf16(v1[0], v1[1]); w.w = cvt_pk_bf16(v1[2], v1[3]);
                    *(u32x4*)(rowp + bj * HALF) = w; } }
    }
};
struct EpiResid {
    static constexpr bool PERM = false, AFTER_DRAIN = false;
    const float* base; float* out; bf16_t* outb; int ldc;
    __device__ __forceinline__ void operator()(const f32x4 (&acc)[2][2][4][2], const Unit& u, int wr, int wc, int fr, int fq) const {
        const int row0 = u.pm * BM + wr * 64 + fr, col0 = u.pn * BM + wc * 32 + 4 * fq;
#pragma unroll
        for (int ai = 0; ai < 2; ++ai)
#pragma unroll
            for (int m = 0; m < 4; ++m) { const size_t off = (size_t)(row0 + ai * HALF + m * 16) * ldc + col0;
#pragma unroll
                for (int bj = 0; bj < 2; ++bj)
#pragma unroll
                    for (int n = 0; n < 2; ++n) { const f32x4 o = *(const f32x4*)(base + off + bj * HALF + n * 16) + acc[ai][bj][m][n];
                        *(f32x4*)(out + off + bj * HALF + n * 16) = o;
                        if (outb) { u32x2 w; w.x = cvt_pk_bf16(o[0], o[1]); w.y = cvt_pk_bf16(o[2], o[3]); *(u32x2*)(outb + off + bj * HALF + n * 16) = w; } }
                if (m & 1) asm volatile("" ::: "memory"); }
    }
};
struct EpiUp {
    static constexpr bool PERM = true, AFTER_DRAIN = false;
    bf16_t* O; int ldc; const float* rs;
    __device__ __forceinline__ void operator()(const f32x4 (&acc)[2][2][4][2], const Unit& u, int wr, int wc, int fr, int fq) const {
        const int row0 = u.pm * BM + wr * 64 + fr, col0 = u.pn * BM + wc * 32 + 8 * fq;
#pragma unroll
        for (int ai = 0; ai < 2; ++ai)
#pragma unroll
            for (int m = 0; m < 4; ++m) { const int r = row0 + ai * HALF + m * 16; const float s = rs[r]; bf16_t* rowp = O + (size_t)r * ldc + col0;
#pragma unroll
                for (int bj = 0; bj < 2; ++bj) { f32x4 v0 = acc[ai][bj][m][0] * s, v1 = acc[ai][bj][m][1] * s;
#pragma unroll
                    for (int e = 0; e < 4; ++e) { v0[e] = fmaxf(v0[e], 0.f); v1[e] = fmaxf(v1[e], 0.f); }
                    v0 = v0 * v0; v1 = v1 * v1;
                    u32x4 w; w.x = cvt_pk_bf16(v0[0], v0[1]); w.y = cvt_pk_bf16(v0[2], v0[3]); w.z = cvt_pk_bf16(v1[0], v1[1]); w.w = cvt_pk_bf16(v1[2], v1[3]);
                    *(u32x4*)(rowp + bj * HALF) = w; } }
    }
};

template <class Epi, class Sched, bool ALIGN_EPI = false, bool SP2 = false>
__device__ __forceinline__ void gemm_phase(PG8_LAS unsigned char* lds, const Gemm g, const Sched& S, const Epi& E) {
    const int tid = threadIdx.x, wid = __builtin_amdgcn_readfirstlane(tid >> 6), lane = tid & 63, wr = wid >> 2, wc = wid & 3, fr = lane & 15, fq = lane >> 4;
    const int K = g.K, nt = K / BK;
    unsigned voffA[2], voffB[2];
#pragma unroll
    for (int i = 0; i < 2; ++i) { int R, C; stage_rc(tid * 16 + i * 8192, R, C); const int Rb = Epi::PERM ? ((R & ~31) + perm32(R & 31)) : R;
        voffA[i] = (unsigned)(R * K + C) * 2u; voffB[i] = (unsigned)(Rb * K + C) * 2u; }
    const size_t kstep = (size_t)(BK * 2);
    const size_t hstep = (size_t)HALF * K * 2;
    const size_t tstep = 2 * hstep;
    const unsigned ldsw = (unsigned)wid * 1024u;
    const int aoff = lds_byte(wr * 64 + fr, fq * 8), boff = lds_byte(wc * 32 + fr, fq * 8);
#define PG8_SA(b, h) (((b) * 2 + (h)) * HTB)
#define PG8_SB(b, h) ((4 + (b) * 2 + (h)) * HTB)
#define PG8_STAGE(bufoff, gbase, voff) do { _Pragma("unroll") for (int _i = 0; _i < 2; ++_i) \
        __builtin_amdgcn_global_load_lds((const unsigned*)((const char*)(gbase) + (voff)[_i]), (PG8_LAS unsigned*)(lds + (bufoff) + ldsw + _i * 8192), 16, 0, 0); } while (0)
#define PG8_LDA(dst, b, h) do { _Pragma("unroll") for (int m = 0; m < 4; ++m) _Pragma("unroll") for (int k = 0; k < 2; ++k) dst[m][k] = *(const PG8_LAS bf16x8*)(lds + PG8_SA(b, h) + aoff + m * 2048 + k * 1024); } while (0)
#define PG8_LDB(dst, b, h) do { _Pragma("unroll") for (int n = 0; n < 2; ++n) _Pragma("unroll") for (int k = 0; k < 2; ++k) dst[n][k] = *(const PG8_LAS bf16x8*)(lds + PG8_SB(b, h) + boff + n * 2048 + k * 1024); } while (0)
#define PG8_MMA(ai, bj, At, Bt) do { __builtin_amdgcn_s_setprio(1); _Pragma("unroll") for (int m = 0; m < 4; ++m) _Pragma("unroll") for (int n = 0; n < 2; ++n) _Pragma("unroll") for (int k = 0; k < 2; ++k) \
        acc[ai][bj][m][n] = __builtin_amdgcn_mfma_f32_16x16x32_bf16(Bt[n][k], At[m][k], acc[ai][bj][m][n], 0, 0, 0); __builtin_amdgcn_s_setprio(0); } while (0)
#define PG8_WAIT_V(n) asm volatile("s_waitcnt vmcnt(" #n ")" ::: "memory")
#define PG8_WAIT_L(n) asm volatile("s_waitcnt lgkmcnt(" #n ")" ::: "memory")
#define PG8_BAR __builtin_amdgcn_s_barrier()
#define PG8_SCHED __builtin_amdgcn_sched_barrier(0)
    Unit cur, nxt; int ui = 0;
    if (!S.next(0, cur)) return;
    f32x4 acc[2][2][4][2];
#pragma unroll
    for (int a = 0; a < 2; ++a)
#pragma unroll
        for (int b = 0; b < 2; ++b)
#pragma unroll
            for (int m = 0; m < 4; ++m)
#pragma unroll
                for (int n = 0; n < 2; ++n) acc[a][b][m][n] = (f32x4){0.f, 0.f, 0.f, 0.f};
    bf16x8 At[4][2], B0[2][2], B1[2][2];
    const char* cA = (const char*)g.A + (size_t)cur.pm * tstep; const char* cB = (const char*)g.Bt + (size_t)cur.pn * tstep;
    S.a_ready(cur);
    if constexpr (SP2) {
        PG8_STAGE(PG8_SB(0, 0), cB, voffB); PG8_STAGE(PG8_SB(0, 1), cB + hstep, voffB); PG8_STAGE(PG8_SA(0, 0), cA, voffA); PG8_STAGE(PG8_SA(0, 1), cA + hstep, voffA);
        if (wr == 1) PG8_BAR;
        PG8_WAIT_V(2); PG8_BAR;
        PG8_STAGE(PG8_SB(1, 0), cB + kstep, voffB); PG8_STAGE(PG8_SA(1, 0), cA + kstep, voffA); PG8_STAGE(PG8_SB(1, 1), cB + hstep + kstep, voffB);
        PG8_WAIT_V(6); PG8_BAR;
    } else {
        PG8_STAGE(PG8_SB(0, 0), cB, voffB); PG8_STAGE(PG8_SA(0, 0), cA, voffA); PG8_STAGE(PG8_SB(0, 1), cB + hstep, voffB); PG8_STAGE(PG8_SA(0, 1), cA + hstep, voffA);
        if (wr == 1) PG8_BAR;
        PG8_WAIT_V(4); PG8_BAR;
        PG8_STAGE(PG8_SB(1, 0), cB + kstep, voffB); PG8_STAGE(PG8_SA(1, 0), cA + kstep, voffA); PG8_STAGE(PG8_SB(1, 1), cB + hstep + kstep, voffB);
        PG8_WAIT_V(6); PG8_BAR;
    }
    for (;;) {
        const bool has_next = S.next(ui + 1, nxt);
        const char* nA = has_next ? (const char*)g.A + (size_t)nxt.pm * tstep : cA; const char* nB = has_next ? (const char*)g.Bt + (size_t)nxt.pn * tstep : cB;
        for (int t = 0; t < nt; t += 2) {
            const bool last = (t == nt - 2);
            const char* a1 = cA + (size_t)(t + 1) * kstep;
            const char* a2 = last ? nA : cA + (size_t)(t + 2) * kstep; const char* b2 = last ? nB : cB + (size_t)(t + 2) * kstep;
            const char* a3 = a2 + kstep; const char* b3 = b2 + kstep;
            if (last && has_next) S.a_ready(nxt);
            if constexpr (SP2) {
            PG8_LDB(B0, 0, 0); PG8_LDB(B1, 0, 1); PG8_SCHED; PG8_LDA(At, 0, 0); PG8_STAGE(PG8_SA(1, 1), a1 + hstep, voffA);
            PG8_WAIT_V(8); PG8_WAIT_L(0); PG8_BAR; PG8_MMA(0, 0, At, B0); PG8_MMA(0, 1, At, B1); PG8_BAR; PG8_SCHED;
            PG8_LDA(At, 0, 1); PG8_STAGE(PG8_SB(0, 0), b2, voffB); PG8_STAGE(PG8_SB(0, 1), b2 + hstep, voffB); PG8_STAGE(PG8_SA(0, 0), a2, voffA);
            PG8_WAIT_V(8); PG8_WAIT_L(0); PG8_BAR; PG8_MMA(1, 0, At, B0); PG8_MMA(1, 1, At, B1); PG8_BAR; PG8_SCHED;
            PG8_LDB(B0, 1, 0); PG8_LDB(B1, 1, 1); PG8_SCHED; PG8_LDA(At, 1, 0); PG8_STAGE(PG8_SA(0, 1), a2 + hstep, voffA);
            PG8_WAIT_V(8); PG8_WAIT_L(0); PG8_BAR; PG8_MMA(0, 0, At, B0); PG8_MMA(0, 1, At, B1); PG8_BAR; PG8_SCHED;
            PG8_LDA(At, 1, 1); PG8_STAGE(PG8_SB(1, 0), b3, voffB); PG8_STAGE(PG8_SB(1, 1), b3 + hstep, voffB); PG8_STAGE(PG8_SA(1, 0), a3, voffA);
            PG8_WAIT_V(8); PG8_WAIT_L(0); PG8_BAR; PG8_MMA(1, 0, At, B0); PG8_MMA(1, 1, At, B1); PG8_BAR; PG8_SCHED;
            } else {
            PG8_LDB(B0, 0, 0); PG8_SCHED; PG8_LDA(At, 0, 0); PG8_STAGE(PG8_SA(1, 1), a1 + hstep, voffA);
            PG8_WAIT_L(8); PG8_BAR; PG8_WAIT_L(0); PG8_MMA(0, 0, At, B0); PG8_BAR; PG8_SCHED;
            PG8_LDB(B1, 0, 1); PG8_STAGE(PG8_SB(0, 0), b2, voffB);
            PG8_BAR; PG8_WAIT_L(0); PG8_MMA(0, 1, At, B1); PG8_BAR;
            PG8_LDA(At, 0, 1); PG8_STAGE(PG8_SA(0, 0), a2, voffA);
            PG8_BAR; PG8_WAIT_L(0); PG8_MMA(1, 0, At, B0); PG8_BAR; PG8_SCHED;
            PG8_STAGE(PG8_SB(0, 1), b2 + hstep, voffB);
            PG8_WAIT_V(6); PG8_BAR; PG8_MMA(1, 1, At, B1); PG8_BAR;
            PG8_LDB(B0, 1, 0); PG8_SCHED; PG8_LDA(At, 1, 0); PG8_STAGE(PG8_SA(0, 1), a2 + hstep, voffA);
            PG8_WAIT_L(8); PG8_BAR; PG8_WAIT_L(0); PG8_MMA(0, 0, At, B0); PG8_BAR; PG8_SCHED;
            PG8_LDB(B1, 1, 1); PG8_STAGE(PG8_SB(1, 0), b3, voffB);
            PG8_BAR; PG8_WAIT_L(0); PG8_MMA(0, 1, At, B1); PG8_BAR;
            PG8_LDA(At, 1, 1); PG8_STAGE(PG8_SA(1, 0), a3, voffA);
            PG8_BAR; PG8_WAIT_L(0); PG8_MMA(1, 0, At, B0); PG8_BAR; PG8_SCHED;
            PG8_STAGE(PG8_SB(1, 1), b3 + hstep, voffB);
            PG8_WAIT_V(6); PG8_BAR; PG8_MMA(1, 1, At, B1); PG8_BAR;
            }
        }
        if constexpr (ALIGN_EPI) { if (wr == 0) PG8_BAR; }
        if constexpr (!Epi::AFTER_DRAIN) { E(acc, cur, wr, wc, fr, fq); S.done(cur); }
        if (!has_next) break;
#pragma unroll
        for (int a = 0; a < 2; ++a)
#pragma unroll
            for (int b = 0; b < 2; ++b)
#pragma unroll
                for (int m = 0; m < 4; ++m)
#pragma unroll
                    for (int n = 0; n < 2; ++n) acc[a][b][m][n] = (f32x4){0.f, 0.f, 0.f, 0.f};
        cur = nxt; cA = nA; cB = nB; ++ui;
        if constexpr (ALIGN_EPI) { if (wr == 1) PG8_BAR; }
    }
    PG8_WAIT_V(0);
    if constexpr (!ALIGN_EPI) { if (wr == 0) PG8_BAR; }
    PG8_BAR;
    if constexpr (Epi::AFTER_DRAIN) { E.fused(acc, cur, wr, wc, fr, fq, lds, wid, lane); S.done(cur); }
#undef PG8_SA
#undef PG8_SB
#undef PG8_STAGE
#undef PG8_LDA
#undef PG8_LDB
#undef PG8_MMA
#undef PG8_WAIT_V
#undef PG8_WAIT_L
#undef PG8_BAR
#undef PG8_SCHED
}
}
#define GAS __attribute__((address_space(1)))
#define LAS __attribute__((address_space(3)))
typedef unsigned short bf16;
typedef unsigned v4u __attribute__((ext_vector_type(4)));
typedef float f32x4 __attribute__((ext_vector_type(4)));
typedef short bf16x8 __attribute__((ext_vector_type(8)));
typedef GAS unsigned gu32;
typedef GAS unsigned long long gu64;
#define RLX_AGENT __ATOMIC_RELAXED, __HIP_MEMORY_SCOPE_AGENT
#define LDS_WAIT() asm volatile("s_waitcnt lgkmcnt(0)" ::: "memory")
#define VM_WAIT() asm volatile("s_waitcnt vmcnt(0)" ::: "memory")
__device__ __forceinline__ unsigned long long rt() { return __builtin_amdgcn_s_memrealtime(); }
__device__ __forceinline__ unsigned f2bf(float f) { unsigned u = __builtin_bit_cast(unsigned, f); return (u + 0x7fffu + ((u >> 16) & 1u)) >> 16; }
__device__ __forceinline__ unsigned pk2(float lo, float hi) { return f2bf(lo) | (f2bf(hi) << 16); }

#define XB_TMO      128
#define XB_XCNT(j)  (256  + 64 * (j))
#define XB_XSUB(j)  (1280 + 64 * (j))
#define XB_XGEN(j)  (2304 + 64 * (j))
#define XB_TOP      3328
#define XB_TOPGEN   3392
#define XCD_BAR_WORDS 3456
#define XB_SPIN_CAP (1u << 18)

__device__ __forceinline__ unsigned xb_ld(unsigned* p)              { return __hip_atomic_load(p, __ATOMIC_RELAXED, __HIP_MEMORY_SCOPE_AGENT); }
__device__ __forceinline__ unsigned xb_add(unsigned* p, unsigned v) { return __hip_atomic_fetch_add(p, v, __ATOMIC_RELAXED, __HIP_MEMORY_SCOPE_AGENT); }
__device__ __forceinline__ unsigned xb_xcc_id() { return (unsigned)__builtin_amdgcn_s_getreg((3 << 11) | 20) & 0xFu; }
#define XB_SPIN(cond, bar) do { unsigned _sp = 0; while (cond) { __builtin_amdgcn_s_sleep(1); \
    if ((++_sp & 255u) == 0u) { if (xb_ld(&(bar)[XB_TMO])) break; if (_sp > XB_SPIN_CAP) { atomicAdd(&(bar)[XB_TMO], 1u); break; } } } } while (0)

struct XcdBarrier {
    unsigned* bar; unsigned x;
    volatile LAS unsigned* st;
};

__device__ __forceinline__ XcdBarrier xcd_barrier_post(unsigned* bar, volatile LAS unsigned* st) {
    XcdBarrier b; b.bar = bar; b.x = xb_xcc_id(); b.st = st;
    if (threadIdx.x == 0) (void)xb_add(&bar[XB_XCNT(b.x)], 1u);
    return b;
}
__device__ __forceinline__ void xcd_barrier_complete(unsigned* bar, unsigned x, unsigned& nloc, unsigned& nx) {
    const unsigned G = gridDim.x * gridDim.y * gridDim.z;
    unsigned sum, cnt, mine, sp = 0u;
    for (;;) {
        sum = 0u; cnt = 0u; mine = 0u;
#pragma unroll
        for (unsigned j = 0; j < 16; ++j) { const unsigned c = xb_ld(&bar[XB_XCNT(j)]); sum += c; cnt += (c > 0u) ? 1u : 0u; mine = (j == x) ? c : mine; }
        if (sum == G) break;
        __builtin_amdgcn_s_sleep(1);
        if ((++sp & 255u) == 0u) { if (xb_ld(&bar[XB_TMO])) break; if (sp > XB_SPIN_CAP) { atomicAdd(&bar[XB_TMO], 1u); break; } }
    }
    nloc = mine > 0u ? mine : 1u; nx = cnt > 0u ? cnt : 1u;
}

__device__ __forceinline__ void xcd_barrier(const XcdBarrier& b) {
    asm volatile("s_waitcnt vmcnt(0)" ::: "memory");
    __syncthreads();
    if (threadIdx.x == 0) {
        unsigned* bar = b.bar;
        __builtin_amdgcn_s_waitcnt(0);
        unsigned nloc = b.st[0], nx = b.st[1];
        if (nloc == 0u) { xcd_barrier_complete(bar, b.x, nloc, nx); b.st[0] = nloc; b.st[1] = nx; }
        const unsigned old = xb_add(&bar[XB_XSUB(b.x)], 1u);
        const unsigned gen = old / nloc;
        if (old + 1u == (gen + 1u) * nloc) {
            __builtin_amdgcn_fence(__ATOMIC_RELEASE, "agent");
            asm volatile("s_waitcnt vmcnt(0)" ::: "memory");
            const unsigned og = xb_add(&bar[XB_TOP], 1u);
            const unsigned tg = og / nx;
            if (og + 1u == (tg + 1u) * nx) xb_add(&bar[XB_TOPGEN], 1u);
            else XB_SPIN(xb_ld(&bar[XB_TOPGEN]) == tg, bar);
            __builtin_amdgcn_fence(__ATOMIC_ACQUIRE, "agent");
            xb_add(&bar[XB_XGEN(b.x)], 1u);
            asm volatile("s_waitcnt vmcnt(0)" ::: "memory");
        } else {
            XB_SPIN(xb_ld(&bar[XB_XGEN(b.x)]) == gen, bar);
            __builtin_amdgcn_fence(__ATOMIC_ACQUIRE, "agent");
            asm volatile("s_waitcnt vmcnt(0)" ::: "memory");
        }
    }
    __syncthreads();
}

namespace att {
typedef short bf16x8 __attribute__((ext_vector_type(8)));
typedef short s16x4 __attribute__((ext_vector_type(4)));
typedef float f32x16 __attribute__((ext_vector_type(16)));
typedef float f32x4 __attribute__((ext_vector_type(4)));
typedef unsigned u32x4 __attribute__((ext_vector_type(4)));
typedef unsigned short bf16;
constexpr int D = 128, NW = 8, QBLK = 32, KVBLK = 64, QB = NW * QBLK;
constexpr int SHM_V = KVBLK * D * 2, SHM_K = KVBLK * D * 2;
constexpr int LDS_SEL = 2 * SHM_V + 2 * SHM_K + NW * 64 * 4;
constexpr int LDS_BYTES = LDS_SEL + 2 * QB * 4;
constexpr float SCALE = 0.08838834764831845f, THR = 8.f;
#define KSWZ(row, colB) ((row) * 256 + ((colB) ^ (((row) & 7) << 4)))
#define SBAR() __builtin_amdgcn_sched_barrier(0)
__device__ __forceinline__ int v_st(int k, int c) { const int kk = (k & ~0xC) | ((k & 4) << 1) | ((k & 8) >> 1); return ((kk >> 3) * 4 + (c >> 5)) * 512 + ((kk & 7) * 32 + (c & 31)) * 2; }
__device__ __forceinline__ int v_rd_base(int lane) { return ((lane & 3) << 3) | (((lane >> 2) & 3) << 6) | (((lane >> 4) & 1) << 5) | (((lane >> 5) & 1) << 8); }
constexpr int v_rd_off(int d0, int ks, int half) { return d0 * 512 + ks * 4096 + half * 2048; }
__device__ __forceinline__ int crow(int r, int hi) { return (r & 3) + 8 * (r >> 2) + 4 * hi; }
__device__ __forceinline__ unsigned cvtpk(float lo, float hi) { unsigned r; asm volatile("v_cvt_pk_bf16_f32 %0, %1, %2" : "=v"(r) : "v"(lo), "v"(hi)); return r; }
__device__ __forceinline__ bf16x8 load8(const bf16* p) { return *reinterpret_cast<const bf16x8*>(p); }
__device__ __forceinline__ void mask_causal(f32x16& p0, f32x16& p1, int dq) {
    const float NEG = -__builtin_inff();
#pragma unroll
    for (int r = 0; r < 16; ++r) { const int c = (r & 3) + 8 * (r >> 2); if (dq - c < 0) p0[r] = NEG; if (dq - c - 32 < 0) p1[r] = NEG; }
}
template <bool MOBA>
__device__ __forceinline__ void partialSM(f32x16& p0, f32x16& p1, float& m_reg, float& mn, float& alpha, bool rm) {
    float pmax = p0[0]; for (int r = 1; r < 16; ++r) pmax = fmaxf(pmax, p0[r]); for (int r = 0; r < 16; ++r) pmax = fmaxf(pmax, p1[r]);
    { auto rr = __builtin_amdgcn_permlane32_swap(__float_as_uint(pmax), __float_as_uint(pmax), false, false);
      pmax = fmaxf(__uint_as_float(rr[0]), __uint_as_float(rr[1])); }
    if (MOBA && rm) pmax = -__builtin_inff();
    constexpr float C2 = 1.4426950408889634f * SCALE;
    if (__builtin_expect(__all((pmax - m_reg) * SCALE <= THR), 1)) { mn = m_reg; alpha = 1.f; }
    else { mn = fmaxf(m_reg, pmax); alpha = __builtin_amdgcn_exp2f((m_reg - mn) * C2); m_reg = mn; }
    float mnL = -mn * C2; if (MOBA && rm) mnL = -__builtin_inff();
    for (int r = 0; r < 16; ++r) p0[r] = fmaf(p0[r], C2, mnL); for (int r = 0; r < 16; ++r) p1[r] = fmaf(p1[r], C2, mnL);
    for (int r = 0; r < 16; ++r) p0[r] = __builtin_amdgcn_exp2f(p0[r]);
}
__device__ __forceinline__ void finishSM(f32x16& p0, f32x16& p1, float alpha, float& l_reg, bf16x8& pa0, bf16x8& pa1, bf16x8& pa2, bf16x8& pa3) {
    for (int r = 0; r < 16; ++r) p1[r] = __builtin_amdgcn_exp2f(p1[r]);
    float ps = 0; for (int r = 0; r < 16; ++r) ps += p0[r]; for (int r = 0; r < 16; ++r) ps += p1[r];
    { auto rr = __builtin_amdgcn_permlane32_swap(__float_as_uint(ps), __float_as_uint(ps), false, false);
      ps = __uint_as_float(rr[0]) + __uint_as_float(rr[1]); }
    l_reg = l_reg * alpha + ps;
#define PK4(P, B_, OUT) do { unsigned a0 = cvtpk(P[B_+0], P[B_+1]), a1 = cvtpk(P[B_+2], P[B_+3]);                          \
        unsigned b0 = cvtpk(P[B_+4], P[B_+5]), b1 = cvtpk(P[B_+6], P[B_+7]);                                             \
        auto r0 = __builtin_amdgcn_permlane32_swap(a0, b0, false, false); auto r1 = __builtin_amdgcn_permlane32_swap(a1, b1, false, false); \
        u32x4 w = {r0[0], r1[0], r0[1], r1[1]}; OUT = *reinterpret_cast<bf16x8*>(&w); } while (0)
    PK4(p0, 0, pa0); PK4(p0, 8, pa1); PK4(p1, 0, pa2); PK4(p1, 8, pa3);
#undef PK4
}
template <int KB>
__device__ __forceinline__ void qkt(f32x16& p0, f32x16& p1, const char* K_lds, int r32, int hi, const bf16x8* qr) {
    p0 = f32x16{}; p1 = f32x16{};
    const char* kb[4];
#pragma unroll
    for (int dd = 0; dd < 4; ++dd) kb[dd] = K_lds + KB * SHM_K + KSWZ(r32, (dd * 16 + hi * 8) * 2);
#pragma unroll
    for (int d0 = 0; d0 < 8; ++d0) { const char* a = kb[d0 & 3] + (d0 >> 2) * 128;
        bf16x8 b0 = *reinterpret_cast<const bf16x8*>(a);
        bf16x8 b1 = *reinterpret_cast<const bf16x8*>(a + 32 * 256);
        p0 = __builtin_amdgcn_mfma_f32_32x32x16_bf16(b0, qr[d0], p0, 0, 0, 0);
        p1 = __builtin_amdgcn_mfma_f32_32x32x16_bf16(b1, qr[d0], p1, 0, 0, 0); }
}
template <int VB>
__device__ __forceinline__ void pv_tile(f32x16* o, int vb0, bf16x8 pa0, bf16x8 pa1, bf16x8 pa2, bf16x8 pa3) {
#define TRRD(dst, off) asm volatile("ds_read_b64_tr_b16 %0, %1 offset:%2" : "=&v"(dst) : "v"(vb0), "i"(off) : "memory")
#define PV_D0(d0) do { s16x4 l0, l1, l2, l3, h0, h1, h2, h3; constexpr int b_ = VB * SHM_V + v_rd_off(d0, 0, 0); \
        TRRD(l0, b_); TRRD(h0, b_ + 2048); TRRD(l1, b_ + 4096); TRRD(h1, b_ + 6144); TRRD(l2, b_ + 8192); TRRD(h2, b_ + 10240); TRRD(l3, b_ + 12288); TRRD(h3, b_ + 14336); \
        asm volatile("s_waitcnt lgkmcnt(0)" ::: "memory"); SBAR();   \
        o[d0] = __builtin_amdgcn_mfma_f32_32x32x16_bf16(pa0, (bf16x8){l0[0], l0[1], l0[2], l0[3], h0[0], h0[1], h0[2], h0[3]}, o[d0], 0, 0, 0);   \
        o[d0] = __builtin_amdgcn_mfma_f32_32x32x16_bf16(pa1, (bf16x8){l1[0], l1[1], l1[2], l1[3], h1[0], h1[1], h1[2], h1[3]}, o[d0], 0, 0, 0);   \
        o[d0] = __builtin_amdgcn_mfma_f32_32x32x16_bf16(pa2, (bf16x8){l2[0], l2[1], l2[2], l2[3], h2[0], h2[1], h2[2], h2[3]}, o[d0], 0, 0, 0);   \
        o[d0] = __builtin_amdgcn_mfma_f32_32x32x16_bf16(pa3, (bf16x8){l3[0], l3[1], l3[2], l3[3], h3[0], h3[1], h3[2], h3[3]}, o[d0], 0, 0, 0); } while (0)
    PV_D0(0); PV_D0(1); PV_D0(2); PV_D0(3);
#undef PV_D0
#undef TRRD
}
template <int QS>
__device__ __forceinline__ void moba_gate(int tid, const bf16* Q, const float* KM, int qb, unsigned* selw) {
    const int wid = __builtin_amdgcn_readfirstlane(tid >> 6), lane = tid & 63, r32 = lane & 31, hi = lane >> 5;
    bf16x8 qr[8];
#pragma unroll
    for (int d0 = 0; d0 < 8; ++d0) qr[d0] = load8(Q + (size_t)(wid * QBLK + r32) * QS + d0 * 16 + hi * 8);
    unsigned sel = 0u;
    {
        f32x16 g = {};
        const float* km = KM + (size_t)r32 * D + hi * 8;
#pragma unroll
        for (int d0 = 0; d0 < 8; ++d0) { const f32x4 a = *(const f32x4*)(km + d0 * 16), b = *(const f32x4*)(km + d0 * 16 + 4);
            u32x4 wh = {cvtpk(a[0], a[1]), cvtpk(a[2], a[3]), cvtpk(b[0], b[1]), cvtpk(b[2], b[3])};
            const f32x4 al = {a[0] - __uint_as_float(wh[0] << 16), a[1] - __uint_as_float(wh[0] & 0xffff0000u), a[2] - __uint_as_float(wh[1] << 16), a[3] - __uint_as_float(wh[1] & 0xffff0000u)};
            const f32x4 bl = {b[0] - __uint_as_float(wh[2] << 16), b[1] - __uint_as_float(wh[2] & 0xffff0000u), b[2] - __uint_as_float(wh[3] << 16), b[3] - __uint_as_float(wh[3] & 0xffff0000u)};
            u32x4 wl = {cvtpk(al[0], al[1]), cvtpk(al[2], al[3]), cvtpk(bl[0], bl[1]), cvtpk(bl[2], bl[3])};
            g = __builtin_amdgcn_mfma_f32_32x32x16_bf16(*reinterpret_cast<bf16x8*>(&wh), qr[d0], g, 0, 0, 0);
            g = __builtin_amdgcn_mfma_f32_32x32x16_bf16(*reinterpret_cast<bf16x8*>(&wl), qr[d0], g, 0, 0, 0); }
        const int IMIN = (int)0x80000000;
        int key[16];
#pragma unroll
        for (int r = 0; r < 16; ++r) { const int n = crow(r, hi); const int bits = (int)__float_as_uint(g[r]); const int s = bits ^ ((bits >> 31) & 0x7fffffff);
            key[r] = (n < qb) ? ((s & ~31) | (31 - n)) : IMIN; }
        int m1 = IMIN, m2 = IMIN, m3 = IMIN;
#pragma unroll
        for (int r = 0; r < 16; ++r) m1 = max(m1, key[r]);
#pragma unroll
        for (int r = 0; r < 16; ++r) m2 = max(m2, key[r] < m1 ? key[r] : IMIN);
#pragma unroll
        for (int r = 0; r < 16; ++r) m3 = max(m3, key[r] < m2 ? key[r] : IMIN);
        int c6[6];
        { auto r1 = __builtin_amdgcn_permlane32_swap((unsigned)m1, (unsigned)m1, false, false); c6[0] = (int)r1[0]; c6[1] = (int)r1[1];
          auto r2 = __builtin_amdgcn_permlane32_swap((unsigned)m2, (unsigned)m2, false, false); c6[2] = (int)r2[0]; c6[3] = (int)r2[1];
          auto r3 = __builtin_amdgcn_permlane32_swap((unsigned)m3, (unsigned)m3, false, false); c6[4] = (int)r3[0]; c6[5] = (int)r3[1]; }
        int t1 = IMIN, t2 = IMIN, t3 = IMIN;
#pragma unroll
        for (int r = 0; r < 6; ++r) t1 = max(t1, c6[r]);
#pragma unroll
        for (int r = 0; r < 6; ++r) t2 = max(t2, c6[r] < t1 ? c6[r] : IMIN);
#pragma unroll
        for (int r = 0; r < 6; ++r) t3 = max(t3, c6[r] < t2 ? c6[r] : IMIN);
        if (t1 != IMIN) sel |= 1u << (31 - (t1 & 31));
        if (t2 != IMIN) sel |= 1u << (31 - (t2 & 31));
        if (t3 != IMIN) sel |= 1u << (31 - (t3 & 31));
    }
    if (hi == 0) selw[wid * QBLK + r32] = sel;
}
struct Seam { bf16x8 qr[8]; bf16x8 st_v0, st_v1, st_k0, st_k1; };
#define ROWP(p, k0, rr, str) ((p) + (size_t)((k0) + (rr)) * (str) + sc)
#define VMW() asm volatile("s_waitcnt vmcnt(0)" ::: "memory")
#define VMWN(n) asm volatile("s_waitcnt vmcnt(%0)" :: "i"(n) : "memory")
#define SLOAD_H(Kp, Vp, k0, str) do { S.st_v0 = load8(ROWP(Vp, k0, sr, str)); S.st_v1 = load8(ROWP(Vp, k0, 32 + sr, str));              \
                         S.st_k0 = load8(ROWP(Kp, k0, sr, str)); S.st_k1 = load8(ROWP(Kp, k0, 32 + sr, str)); } while (0)
#define SWRITE_HK(bf) do { *(bf16x8*)(K_lds + (bf) * SHM_K + kws) = S.st_k0; *(bf16x8*)(K_lds + (bf) * SHM_K + kws + 32 * 256) = S.st_k1; } while (0)
#define SWRITE_HV(bf) do { *(bf16x8*)(V_lds + (bf) * SHM_V + vst0) = S.st_v0; *(bf16x8*)(V_lds + (bf) * SHM_V + vst1) = S.st_v1; } while (0)
#define SWRITE_H(bf) do { SWRITE_HV(bf); SWRITE_HK(bf); } while (0)
template <int QS, int KVS, long VOFF>
__device__ __forceinline__ void attn_prime(int tid, const bf16* curQ, const bf16* curK, char* lds, Seam& S) {
    const int wid = __builtin_amdgcn_readfirstlane(tid >> 6), lane = tid & 63, r32 = lane & 31, hi = lane >> 5;
    const int sr = tid >> 4, sc = (tid & 15) * 8, kws = KSWZ(sr, sc * 2); char* K_lds = lds + 2 * SHM_V;
    for (int d0 = 0; d0 < 8; ++d0) S.qr[d0] = load8(curQ + (size_t)(wid * QBLK + r32) * QS + d0 * 16 + hi * 8);
    SLOAD_H(curK, curK + VOFF, 0, KVS); VMW(); SWRITE_HK(0);
    __syncthreads();
}
template <bool MOBA, int QS, int KVS, long VOFF, int OS>
__device__ __forceinline__ void attn_block(int tid, const bf16* curK, bf16* curO, int NT, int selofs, const bf16* nxtQ, const bf16* nxtK, char* lds, Seam& S) {
    const int wid = __builtin_amdgcn_readfirstlane(tid >> 6), lane = tid & 63, r32 = lane & 31, hi = lane >> 5;
    const int qlo = wid * QBLK, qm = qlo + r32 - 4 * hi;
    char* V_lds = lds; char* K_lds = lds + 2 * SHM_V;
    float* ws = (float*)(lds + 2 * SHM_V + 2 * SHM_K) + wid * 64; float* li_l = ws, * al_l = ws + 32;
    const int sr = tid >> 4, sc = (tid & 15) * 8, vst0 = v_st(sr, sc), vst1 = v_st(32 + sr, sc), kws = KSWZ(sr, sc * 2);
    const int vb0 = (int)(uintptr_t)V_lds + v_rd_base(lane);
    const bf16* Kh = curK; const bf16* Vh = curK + VOFF; constexpr int kvs = KVS;
    unsigned sel = 0u;
    if (MOBA) sel = ((const unsigned*)(lds + LDS_SEL))[selofs + wid * QBLK + r32];
    float m_reg = -1e30f, l_reg = 0; f32x16 o[4] = {};
#define RESC(a) do { if (__any((a) < 1.f)) { if (hi == 0) al_l[r32] = (a); asm volatile("s_waitcnt lgkmcnt(0)" ::: "memory");              \
                     for (int d_ = 0; d_ < 4; ++d_) for (int r = 0; r < 16; ++r) o[d_][r] *= al_l[crow(r, hi)]; } } while (0)
#define KBASE(t) ((t) * KVBLK)
#define MASKT(P0_, P1_, t) do { if (MOBA) { const int kb_ = ((t) - (NT - 4)) * KVBLK; if (kb_ >= 0 && kb_ + KVBLK - 1 > qlo) mask_causal(P0_, P1_, qm - kb_); } } while (0)
#define RMT(t) (MOBA && ((t) < NT - 4) && !((sel >> ((t) >> 2)) & 1u))
    const int NQL = 8;
#define SEAM_K0() do { VMWN(8); SWRITE_HK(0); SBAR(); } while (0)
    f32x16 pA0, pA1, pB0, pB1; float mnA, mnB, alA, alB; bf16x8 pa0, pa1, pa2, pa3;
    (void)NQL;
    SWRITE_HV(0); SBAR();
    if (NT > 1) SLOAD_H(Kh, Vh, KBASE(1), kvs);
    SBAR(); qkt<0>(pA0, pA1, K_lds, r32, hi, S.qr);
    MASKT(pA0, pA1, 0); partialSM<MOBA>(pA0, pA1, m_reg, mnA, alA, RMT(0));
    if (NT > 1) { VMW(); SWRITE_H(1); }
    __syncthreads();
#define HALF_STEP(PX0, PX1, mnX, alX, PY0, PY1, alY, t, KB, VB, SB) do {                                                      \
        SBAR(); qkt<KB>(PX0, PX1, K_lds, r32, hi, S.qr);                                             \
        finishSM(PY0, PY1, alY, l_reg, pa0, pa1, pa2, pa3); SBAR();                                                           \
        if ((t) + 1 < NT) { SLOAD_H(Kh, Vh, KBASE((t) + 1), kvs); SBAR(); }                                               \
        pv_tile<VB>(o, vb0, pa0, pa1, pa2, pa3); MASKT(PX0, PX1, (t)); partialSM<MOBA>(PX0, PX1, m_reg, mnX, alX, RMT(t));                                        \
        __syncthreads();                                                                                                      \
        if ((t) + 1 < NT) { VMW(); SWRITE_H(SB); }                                                                          \
        RESC(alX); __syncthreads(); } while (0)
    for (int t = 1; t + 1 < NT; t += 2) {
        HALF_STEP(pB0, pB1, mnB, alB, pA0, pA1, alA, t, 1, 0, 0);
        HALF_STEP(pA0, pA1, mnA, alA, pB0, pB1, alB, t + 1, 0, 1, 1);
    }
    const bool even = (NT & 1) == 0;
    if (even) { SBAR(); qkt<1>(pB0, pB1, K_lds, r32, hi, S.qr); SBAR(); }
    SLOAD_H(nxtK, nxtK + VOFF, 0, KVS); SBAR();
#pragma unroll
    for (int d0 = 0; d0 < 8; ++d0) S.qr[d0] = load8(nxtQ + (size_t)(wid * QBLK + r32) * QS + d0 * 16 + hi * 8);
    SBAR();
    finishSM(pA0, pA1, alA, l_reg, pa0, pa1, pa2, pa3); SBAR();
    pv_tile<0>(o, vb0, pa0, pa1, pa2, pa3);
    if (even) { MASKT(pB0, pB1, NT - 1); partialSM<MOBA>(pB0, pB1, m_reg, mnB, alB, RMT(NT - 1)); __syncthreads(); RESC(alB);
        finishSM(pB0, pB1, alB, l_reg, pa0, pa1, pa2, pa3); SBAR(); pv_tile<1>(o, vb0, pa0, pa1, pa2, pa3); }
    SBAR(); SEAM_K0();
    if (hi == 0) li_l[r32] = l_reg; asm volatile("s_waitcnt lgkmcnt(0)" ::: "memory");
    float rli[16];
#pragma unroll
    for (int r = 0; r < 16; ++r) rli[r] = __builtin_amdgcn_rcpf(li_l[crow(r, hi)]);
    bf16* Ow = curO + (size_t)(wid * QBLK) * OS;
#pragma unroll
    for (int r = 0; r < 16; ++r) { const int orow = crow(r, hi);
#pragma unroll
        for (int d0 = 0; d0 < 4; ++d0) { const float v = o[d0][r] * rli[r];
            const float vn = __shfl_xor(v, 1);
            if ((r32 & 1) == 0) *(unsigned*)(Ow + (size_t)orow * OS + d0 * 32 + r32) = cvtpk(v, vn); } }
    __syncthreads();
#undef RESC
#undef KBASE
#undef MASKT
#undef RMT
#undef SEAM_K0
#undef HALF_STEP
}
#undef ROWP
#undef VMW
#undef VMWN
#undef SLOAD_H
#undef SWRITE_HK
#undef SWRITE_HV
#undef SWRITE_H
#undef KSWZ
#undef SBAR
}

constexpr int NWAVES = 8;
#ifndef MK_PER_PHASE
#define MK_PER_PHASE 0
#endif
constexpr int N_PHASES = 16;

constexpr int NB = 2, SEQ = 8192, DM = 2048, M = NB * SEQ;
constexpr int NH = 8, HD = 128, AW = NH * HD, CWID = 1024, NPROJ = 3 * AW + 3 * CWID + 2 * DM;
constexpr int NMEM = 256, XH = 4, XW = XH * HD, DFF = 4 * DM;
constexpr int MBLK = 256, NBLK = SEQ / MBLK, TOPK = 3;
constexpr float EPS = 1e-6f;
constexpr float ATT_SCALE = 0.08838834764831845f;

constexpr size_t MiB = 1u << 20;
constexpr size_t WS_CTL = 0, CTL_ZERO_BYTES = 1 * MiB;
constexpr size_t WS_ROPE = 2 * MiB;
constexpr size_t WS_KMEAN = 3 * MiB;
constexpr size_t WS_R2 = 3 * MiB + 512 * 1024;
constexpr size_t WS_R3 = WS_R2 + 64 * 1024;
constexpr size_t WS_MEMN = 4 * MiB;
constexpr size_t WS_MKV = 6 * MiB;
constexpr size_t WS_WIN = 8 * MiB;
constexpr size_t WS_WA = 48 * MiB, WS_WC = 52 * MiB;
constexpr size_t WS_WM = 56 * MiB;
constexpr size_t WS_WQ = 64 * MiB;
constexpr size_t WS_WKV = 66 * MiB;
constexpr size_t WS_WO = 70 * MiB;
constexpr size_t WS_WUP = 72 * MiB;
constexpr size_t WS_WD = 104 * MiB;
constexpr size_t WS_XB = 136 * MiB;
constexpr size_t WS_G = 200 * MiB;
constexpr size_t GRP = 32 * MiB;
constexpr size_t WS_YA = 200 * MiB, WS_YC = 264 * MiB;
constexpr size_t WS_MERGED = 328 * MiB;
constexpr size_t WS_HQ = 200 * MiB, WS_XO = 216 * MiB;
constexpr size_t WS_UP = 232 * MiB;
constexpr size_t WS_END = 488 * MiB;
constexpr size_t DO_AO = 0, DO_CO = 32 * MiB, DO_GC = 64 * MiB;
constexpr int CW_TMO = 0, CW_CODE = 1, CW_BAR = 4096;

constexpr int RING_OFF = 0, RING_BYTES = 131072;
constexpr int LDSCTL_OFF = RING_BYTES, MISC_OFF = LDSCTL_OFF + 320;
constexpr int LDS_BYTES = 147456;

__device__ __forceinline__ float bf2f(unsigned short b) { return __uint_as_float((unsigned)b << 16); }
__device__ __forceinline__ float bflo(unsigned w) { return __uint_as_float(w << 16); }
__device__ __forceinline__ float bfhi(unsigned w) { return __uint_as_float(w & 0xffff0000u); }
__device__ __forceinline__ float wave_sum(float v) {
#pragma unroll
    for (int o = 1; o < 64; o <<= 1) v += __shfl_xor(v, o);
    return v;
}
__device__ __forceinline__ float wave_max(float v) {
#pragma unroll
    for (int o = 1; o < 64; o <<= 1) v = fmaxf(v, __shfl_xor(v, o));
    return v;
}

__device__ __forceinline__ void p0_transpose_item(const float* W, int K, int N, bf16* WT, int ldk, int koff, int row_off, const float* gk, LAS float* scr, int item, int lane) {
    const int nblk = N / 32, kb = item / nblk, nb = item % nblk, k0 = 64 * kb, n0 = 32 * nb;
#pragma unroll 8
    for (int i = 0; i < 32; ++i) { const int kk = 2 * i + (lane >> 5); float w = W[(size_t)(k0 + kk) * N + n0 + (lane & 31)]; if (gk) w *= gk[k0 + kk]; scr[kk * 33 + (lane & 31)] = w; }
    LDS_WAIT(); asm volatile("" ::: "memory");
    const int c = lane & 7;
#pragma unroll
    for (int j = 0; j < 4; ++j) { const int n = (lane >> 3) + 8 * j; const LAS float* s = scr + (8 * c) * 33 + n;
        v4u o; o.x = pk2(s[0 * 33], s[1 * 33]); o.y = pk2(s[2 * 33], s[3 * 33]); o.z = pk2(s[4 * 33], s[5 * 33]); o.w = pk2(s[6 * 33], s[7 * 33]);
        *(GAS v4u*)(WT + (size_t)(row_off + n0 + n) * ldk + koff + k0 + 8 * c) = o; }
    LDS_WAIT(); asm volatile("" ::: "memory");
}
__device__ __forceinline__ void rms_row_to_bf16(const float* xrow, const float* g, bf16* orow, int lane) {
    const GAS f32x4* xr = (const GAS f32x4*)xrow + lane; const GAS f32x4* gr = (const GAS f32x4*)g + lane;
    f32x4 v[8]; float s = 0.f;
#pragma unroll
    for (int j = 0; j < 8; ++j) { v[j] = xr[64 * j]; s += (v[j].x * v[j].x + v[j].y * v[j].y) + (v[j].z * v[j].z + v[j].w * v[j].w); }
    const float rstd = 1.f / sqrtf(wave_sum(s) * (1.f / DM) + EPS);
    GAS unsigned long long* o8 = (GAS unsigned long long*)orow + lane;
#pragma unroll
    for (int j = 0; j < 8; ++j) { const f32x4 gg = gr[64 * j];
        o8[64 * j] = (unsigned long long)pk2(v[j].x * rstd * gg.x, v[j].y * rstd * gg.y) | ((unsigned long long)pk2(v[j].z * rstd * gg.z, v[j].w * rstd * gg.w) << 32); }
}
__device__ __forceinline__ float row_rstd(const float* xrow, int lane) {
    const GAS f32x4* xr = (const GAS f32x4*)xrow + lane; float s = 0.f;
#pragma unroll
    for (int j = 0; j < 8; ++j) { const f32x4 v = xr[64 * j]; s += (v.x * v.x + v.y * v.y) + (v.z * v.z + v.w * v.w); }
    return 1.f / sqrtf(wave_sum(s) * (1.f / DM) + EPS);
}

__device__ const float ROPE_INV_FREQ[16] = {1.f, 0.440366596f, 0.193922743f, 0.0853971019f, 0.0376060307f, 0.016560439f, 0.00729266461f, 0.00321144587f, 0.00141421356f, 0.000622772379f, 0.000274248188f, 0.000120769735f, 5.3182961e-05f, 2.34199997e-05f, 1.03133862e-05f, 4.54167048e-06f};
struct Args { const float* in[17]; float* out; unsigned char* ws; int ph_lo, ph_hi, li, pad; };

__device__ __forceinline__ void naive_moba_item(int b, int h, int i, const bf16* QP, const bf16* KP, const bf16* VP, const float2* ROPE, const float* KMEAN, bf16* AO, int lane) {
    const size_t t = (size_t)b * SEQ + i; const int qb = i >> 8;
    float q[128];
    { const v4u* qp = (const v4u*)(QP + t * AW + h * HD);
#pragma unroll
      for (int c = 0; c < 16; ++c) { const v4u w = qp[c]; q[8 * c + 0] = bflo(w.x); q[8 * c + 1] = bfhi(w.x); q[8 * c + 2] = bflo(w.y); q[8 * c + 3] = bfhi(w.y); q[8 * c + 4] = bflo(w.z); q[8 * c + 5] = bfhi(w.z); q[8 * c + 6] = bflo(w.w); q[8 * c + 7] = bfhi(w.w); } }
#pragma unroll
    for (int d = 0; d < 16; ++d) { const float2 cs = ROPE[i * 16 + d]; const float q1 = q[d], q2 = q[d + 16]; q[d] = q1 * cs.x - q2 * cs.y; q[d + 16] = q2 * cs.x + q1 * cs.y; }
    float g = -INFINITY;
    if (lane < qb) { const f32x4* km = (const f32x4*)(KMEAN + ((size_t)(b * NH + h) * NBLK + lane) * HD); float a = 0.f;
#pragma unroll
        for (int c = 0; c < 32; ++c) { const f32x4 k4 = km[c]; a += q[4 * c] * k4.x + q[4 * c + 1] * k4.y + q[4 * c + 2] * k4.z + q[4 * c + 3] * k4.w; }
        g = a; }
    unsigned selmask = 0u;
#pragma unroll
    for (int k = 0; k < TOPK; ++k) { const float mx = wave_max(g);
        if (mx != -INFINITY) { const unsigned long long bal = __ballot(g == mx); const int idx = __ffsll((long long)bal) - 1; selmask |= 1u << idx; if (lane == idx) g = -INFINITY; } }
    selmask |= 1u << qb;
    float s[4][4]; int blk[4]; bool valid[4];
#pragma unroll
    for (int c = 0; c < 4; ++c) { valid[c] = selmask != 0u; blk[c] = valid[c] ? (__ffs((int)selmask) - 1) : 0; selmask &= selmask - 1u; }
    float mloc = -INFINITY;
#pragma unroll
    for (int c = 0; c < 4; ++c)
#pragma unroll
        for (int r = 0; r < 4; ++r) { const int key = blk[c] * MBLK + lane + 64 * r; float sc = -INFINITY;
            if (valid[c] && key <= i) { const v4u* kp = (const v4u*)(KP + ((size_t)b * SEQ + key) * AW + h * HD); float kk[32]; float a = 0.f;
#pragma unroll
                for (int cc = 0; cc < 4; ++cc) { const v4u w = kp[cc]; kk[8 * cc + 0] = bflo(w.x); kk[8 * cc + 1] = bfhi(w.x); kk[8 * cc + 2] = bflo(w.y); kk[8 * cc + 3] = bfhi(w.y); kk[8 * cc + 4] = bflo(w.z); kk[8 * cc + 5] = bfhi(w.z); kk[8 * cc + 6] = bflo(w.w); kk[8 * cc + 7] = bfhi(w.w); }
#pragma unroll
                for (int d = 0; d < 16; ++d) { const float2 cs = ROPE[key * 16 + d]; const float k1 = kk[d], k2 = kk[d + 16]; a += q[d] * (k1 * cs.x - k2 * cs.y) + q[d + 16] * (k2 * cs.x + k1 * cs.y); }
#pragma unroll
                for (int cc = 4; cc < 16; ++cc) { const v4u w = kp[cc]; a += q[8 * cc + 0] * bflo(w.x) + q[8 * cc + 1] * bfhi(w.x) + q[8 * cc + 2] * bflo(w.y) + q[8 * cc + 3] * bfhi(w.y) + q[8 * cc + 4] * bflo(w.z) + q[8 * cc + 5] * bfhi(w.z) + q[8 * cc + 6] * bflo(w.w) + q[8 * cc + 7] * bfhi(w.w); }
                sc = a * ATT_SCALE; }
            s[c][r] = sc; mloc = fmaxf(mloc, sc); }
    const float mx = wave_max(mloc); float lsum = 0.f;
#pragma unroll
    for (int c = 0; c < 4; ++c)
#pragma unroll
        for (int r = 0; r < 4; ++r) { s[c][r] = __expf(s[c][r] - mx); lsum += s[c][r]; }
    const float l = wave_sum(lsum);
    float o0 = 0.f, o1 = 0.f;
#pragma unroll
    for (int c = 0; c < 4; ++c) { if (!valid[c]) continue;
#pragma unroll
        for (int r = 0; r < 4; ++r) { const bf16* vp = VP + ((size_t)b * SEQ + blk[c] * MBLK + 64 * r) * AW + h * HD + 2 * lane;
            for (int src = 0; src < 64; ++src) { const float p = __shfl(s[c][r], src); const unsigned w = *(const unsigned*)(vp + (size_t)src * AW); o0 += p * bflo(w); o1 += p * bfhi(w); } } }
    const float rl = 1.f / l;
    *(unsigned*)(AO + t * AW + h * HD + 2 * lane) = pk2(o0 * rl, o1 * rl);
}
__device__ __forceinline__ void naive_xattn_item(int b, int h, int i, const bf16* HQ, const float* R2, const bf16* MKV, bf16* XO, int lane) {
    const size_t t = (size_t)b * SEQ + i; const float qs = R2[t] * ATT_SCALE;
    float q[128];
    { const v4u* qp = (const v4u*)(HQ + t * XW + h * HD);
#pragma unroll
      for (int c = 0; c < 16; ++c) { const v4u w = qp[c]; q[8 * c + 0] = bflo(w.x) * qs; q[8 * c + 1] = bfhi(w.x) * qs; q[8 * c + 2] = bflo(w.y) * qs; q[8 * c + 3] = bfhi(w.y) * qs; q[8 * c + 4] = bflo(w.z) * qs; q[8 * c + 5] = bfhi(w.z) * qs; q[8 * c + 6] = bflo(w.w) * qs; q[8 * c + 7] = bfhi(w.w) * qs; } }
    float s[4]; float mloc = -INFINITY;
#pragma unroll
    for (int r = 0; r < 4; ++r) { const int key = lane + 64 * r; const v4u* kp = (const v4u*)(MKV + ((size_t)b * NMEM + key) * (2 * XW) + h * HD); float a = 0.f;
#pragma unroll
        for (int cc = 0; cc < 16; ++cc) { const v4u w = kp[cc]; a += q[8 * cc + 0] * bflo(w.x) + q[8 * cc + 1] * bfhi(w.x) + q[8 * cc + 2] * bflo(w.y) + q[8 * cc + 3] * bfhi(w.y) + q[8 * cc + 4] * bflo(w.z) + q[8 * cc + 5] * bfhi(w.z) + q[8 * cc + 6] * bflo(w.w) + q[8 * cc + 7] * bfhi(w.w); }
        s[r] = a; mloc = fmaxf(mloc, a); }
    const float mx = wave_max(mloc); float lsum = 0.f;
#pragma unroll
    for (int r = 0; r < 4; ++r) { s[r] = __expf(s[r] - mx); lsum += s[r]; }
    const float l = wave_sum(lsum);
    float o0 = 0.f, o1 = 0.f;
#pragma unroll
    for (int r = 0; r < 4; ++r) { const bf16* vp = MKV + ((size_t)b * NMEM + 64 * r) * (2 * XW) + XW + h * HD + 2 * lane;
        for (int src = 0; src < 64; ++src) { const float p = __shfl(s[r], src); const unsigned w = *(const unsigned*)(vp + (size_t)src * (2 * XW)); o0 += p * bflo(w); o1 += p * bfhi(w); } }
    const float rl = 1.f / l;
    *(unsigned*)(XO + t * XW + h * HD + 2 * lane) = pk2(o0 * rl, o1 * rl);
}

__global__ void __launch_bounds__(NWAVES * 64, 2) mk_fwd(Args args) {
    extern __shared__ __attribute__((aligned(16))) unsigned char lds[];
    LAS unsigned char* const ldsp = (LAS unsigned char*)lds;
    volatile LAS unsigned* const MISC = (volatile LAS unsigned*)(ldsp + MISC_OFF);
    const int tid = threadIdx.x, lane = tid & 63, wave = __builtin_amdgcn_readfirstlane(tid >> 6);
    const int G = gridDim.x; const int bx = blockIdx.x; const int vcu = (G % 8 == 0) ? (bx % 8) * (G / 8) + bx / 8 : bx;
    unsigned char* const ws = args.ws;
    gu32* const ctl = (gu32*)(ws + WS_CTL);
    for (int u = tid; u < (LDS_BYTES - LDSCTL_OFF) / 4; u += NWAVES * 64) ((LAS unsigned*)(ldsp + LDSCTL_OFF))[u] = 0u;
    __syncthreads();
    XcdBarrier bar; bar.bar = (unsigned*)(ctl + CW_BAR); bar.x = 0; bar.st = nullptr;
    if (!MK_PER_PHASE) bar = xcd_barrier_post((unsigned*)(ctl + CW_BAR), MISC + 8);
    const int lo = args.ph_lo, hi = args.ph_hi;
#define IN(k) (lo <= (k) && (k) < hi)
#define SEAM(k) do { if (IN(k) && IN((k) + 1)) xcd_barrier(bar); } while (0)
    const int gw = vcu * NWAVES + wave, NGW = G * NWAVES;
    const int gt = vcu * (NWAVES * 64) + tid, NGT = G * NWAVES * 64;

#define x_in (args.in[0])
#define mem_in (args.in[1])
#define norm_mix (args.in[2])
#define w_in (args.in[3])
#define conv_w (args.in[4])
#define w_attn_out (args.in[5])
#define w_conv_out (args.in[6])
#define w_mix_out (args.in[7])
#define norm_xattn (args.in[8])
#define norm_mem (args.in[9])
#define wq_x (args.in[10])
#define wkv_x (args.in[11])
#define wo_x (args.in[12])
#define norm_mlp (args.in[13])
#define w_up (args.in[14])
#define w_down (args.in[15])
#define norm_final (args.in[16])
    float* const out = args.out; unsigned char* const outb = (unsigned char*)args.out;
#define ROPE ((float2*)(ws + WS_ROPE))
#define KMEAN ((float*)(ws + WS_KMEAN))
#define R2 ((float*)(ws + WS_R2))
#define R3 ((float*)(ws + WS_R3))
#define MEMN ((bf16*)(ws + WS_MEMN))
#define MKV ((bf16*)(ws + WS_MKV))
#define WIN ((bf16*)(ws + WS_WIN))
#define WA ((bf16*)(ws + WS_WA))
#define WC ((bf16*)(ws + WS_WC))
#define WM ((bf16*)(ws + WS_WM))
#define WQ ((bf16*)(ws + WS_WQ))
#define WKV ((bf16*)(ws + WS_WKV))
#define WO ((bf16*)(ws + WS_WO))
#define WUP ((bf16*)(ws + WS_WUP))
#define WD ((bf16*)(ws + WS_WD))
#define XB ((bf16*)(ws + WS_XB))
#define QP ((bf16*)(ws + WS_G))
#define KP ((bf16*)(ws + WS_G + GRP))
#define VP ((bf16*)(ws + WS_G + 2 * GRP))
#define CX ((bf16*)(ws + WS_G + 3 * GRP))
#define CB ((bf16*)(ws + WS_G + 4 * GRP))
#define CC ((bf16*)(ws + WS_G + 5 * GRP))
#define GA ((bf16*)(ws + WS_G + 6 * GRP))
#define GC ((bf16*)(outb + DO_GC))
#define AO ((bf16*)(outb + DO_AO))
#define CO ((bf16*)(outb + DO_CO))
#define YA ((bf16*)(ws + WS_YA))
#define YC ((bf16*)(ws + WS_YC))
#define MERGED ((bf16*)(ws + WS_MERGED))
#define HQ ((bf16*)(ws + WS_HQ))
#define XO ((bf16*)(ws + WS_XO))
#define UP ((bf16*)(ws + WS_UP))
    if (IN(0)) {
        LAS float* scr = (LAS float*)(ldsp + RING_OFF + wave * 16384);
        constexpr int I_IN = (DM / 64) * (NPROJ / 32), I_A = (AW / 64) * (DM / 32), I_C = I_A, I_M = (DM / 64) * (DM / 32), I_Q = (DM / 64) * (XW / 32), I_KV = (DM / 64) * (2 * XW / 32),
                      I_O = (XW / 64) * (DM / 32), I_UP = (DM / 64) * (DFF / 32), I_D = (DFF / 64) * (DM / 32);
        constexpr int NITEMS = I_IN + I_A + I_C + I_M + I_Q + I_KV + I_O + I_UP + I_D;
        for (int it = gw; it < NITEMS; it += NGW) {
            int r = it;
            if (r < I_IN) { p0_transpose_item(w_in, DM, NPROJ, WIN, DM, 0, 0, nullptr, scr, r, lane); continue; } r -= I_IN;
            if (r < I_A) { p0_transpose_item(w_attn_out, AW, DM, WA, AW, 0, 0, nullptr, scr, r, lane); continue; } r -= I_A;
            if (r < I_C) { p0_transpose_item(w_conv_out, CWID, DM, WC, CWID, 0, 0, nullptr, scr, r, lane); continue; } r -= I_C;
            if (r < I_M) { p0_transpose_item(w_mix_out, DM, DM, WM, DM, 0, 0, nullptr, scr, r, lane); continue; } r -= I_M;
            if (r < I_Q) { p0_transpose_item(wq_x, DM, XW, WQ, DM, 0, 0, norm_xattn, scr, r, lane); continue; } r -= I_Q;
            if (r < I_KV) { p0_transpose_item(wkv_x, DM, 2 * XW, WKV, DM, 0, 0, nullptr, scr, r, lane); continue; } r -= I_KV;
            if (r < I_O) { p0_transpose_item(wo_x, XW, DM, WO, XW, 0, 0, nullptr, scr, r, lane); continue; } r -= I_O;
            if (r < I_UP) { p0_transpose_item(w_up, DM, DFF, WUP, DM, 0, 0, norm_mlp, scr, r, lane); continue; } r -= I_UP;
            p0_transpose_item(w_down, DFF, DM, WD, DFF, 0, 0, nullptr, scr, r, lane);
        }
        for (int m = gw; m < M; m += NGW) rms_row_to_bf16(x_in + (size_t)m * DM, norm_mix, XB + (size_t)m * DM, lane);
        for (int m = gw; m < NB * NMEM; m += NGW) rms_row_to_bf16(mem_in + (size_t)m * DM, norm_mem, MEMN + (size_t)m * DM, lane);
        for (int e = gt; e < SEQ * 16; e += NGT) { const int pos = e >> 4, j = e & 15;
            const float inv_freq = ROPE_INV_FREQ[j]; const float ang = (float)pos * inv_freq;
            const double turns = (double)ang * 0.15915494309189535; const float fr = (float)(turns - rint(turns));
            ROPE[e] = make_float2(__builtin_amdgcn_cosf(fr), __builtin_amdgcn_sinf(fr)); }
    }
    SEAM(0);
    if (IN(1)) {
        { pg8::Gemm g{XB, WIN, M, NPROJ, DM}; pg8::StaticOrder S; S.init(M, NPROJ, G, bx);
          pg8::EpiBf16G E{QP, GC, 8, (size_t)M * 1024, 1024, 1024, nullptr};
          pg8::gemm_phase<pg8::EpiBf16G, pg8::StaticOrder, true, true>(ldsp + RING_OFF, g, S, E); }
        { pg8::Gemm g{MEMN, WKV, NB * NMEM, 2 * XW, DM}; pg8::StaticOrder S; S.init(NB * NMEM, 2 * XW, G, bx);
          pg8::EpiBf16G E{MKV, MKV, 1 << 30, 0, 1 << 30, 2 * XW, nullptr};
          pg8::gemm_phase<pg8::EpiBf16G, pg8::StaticOrder, true, true>(ldsp + RING_OFF, g, S, E); }
    }
    SEAM(1);
    if (IN(2)) {
        for (int e = gt; e < M * NH * 16; e += NGT) { const int d = e & 15, h = (e >> 4) & 7, t = e >> 7, pos = t & (SEQ - 1); const float2 cs = ROPE[pos * 16 + d];
            bf16* qp = QP + (size_t)t * AW + h * HD + d; bf16* kp = KP + (size_t)t * AW + h * HD + d;
            const float q1 = bf2f(qp[0]), q2 = bf2f(qp[16]), k1 = bf2f(kp[0]), k2 = bf2f(kp[16]);
            qp[0] = (bf16)f2bf(q1 * cs.x - q2 * cs.y); qp[16] = (bf16)f2bf(q2 * cs.x + q1 * cs.y);
            kp[0] = (bf16)f2bf(k1 * cs.x - k2 * cs.y); kp[16] = (bf16)f2bf(k2 * cs.x + k1 * cs.y); }
    }
    SEAM(2);
    if (IN(3)) {
        for (int e = gt; e < NB * NH * NBLK * HD; e += NGT) { const int d = e & 127, n = (e >> 7) & 31, h = (e >> 12) & 7, b = e >> 15; float a = 0.f;
            const bf16* kp = KP + ((size_t)b * SEQ + (size_t)n * MBLK) * AW + h * HD + d;
            for (int j = 0; j < MBLK; ++j) a += bf2f(kp[(size_t)j * AW]);
            KMEAN[e] = a * (1.f / MBLK); }
    }
    SEAM(3);
    if (IN(4)) {
        { att::Seam S; char* albase = (char*)lds + RING_OFF; unsigned* selw = (unsigned*)(albase + att::LDS_SEL); constexpr int NIT = NB * NH * 16; constexpr long VOFF = (long)(GRP / 2);
          for (int L = vcu; L < NIT; L += G) { int tv = threadIdx.x; asm volatile("" : "+v"(tv)); const int bh = L >> 4, b = bh >> 3, h = bh & 7, s = L & 15;
              const bf16* Kp = KP + (size_t)b * SEQ * AW + h * HD; const float* KM = KMEAN + (size_t)bh * NBLK * HD;
              const bf16* Q0 = QP + ((size_t)b * SEQ + (size_t)s * 256) * AW + h * HD; const bf16* Q1 = QP + ((size_t)b * SEQ + (size_t)(31 - s) * 256) * AW + h * HD;
              att::moba_gate<AW>(tv, Q0, KM, s, selw); att::moba_gate<AW>(tv, Q1, KM, 31 - s, selw + 256);
              att::attn_prime<AW, AW, VOFF>(tv, Q0, Kp, albase, S);
              for (int pass = 0; pass < 2; ++pass) { const int qb = pass ? 31 - s : s;
                  bf16* Op = AO + ((size_t)b * SEQ + (size_t)qb * 256) * AW + h * HD;
                  att::attn_block<true, AW, AW, VOFF, AW>(tv, Kp, Op, 4 * (qb + 1), pass * 256, Q1, Kp, albase, S); } } }
        for (int e = gt; e < M * (CWID / 2); e += NGT) { const int c2 = e & 511; const int t = e >> 9; const int s = t & (SEQ - 1); const int c = 2 * c2;
            const unsigned x0 = *(const unsigned*)(CX + (size_t)t * CWID + c), c0 = *(const unsigned*)(CC + (size_t)t * CWID + c);
            float y0 = conv_w[2 * CWID + c] * (bflo(x0) * bflo(c0)), y1 = conv_w[2 * CWID + c + 1] * (bfhi(x0) * bfhi(c0));
            if (s >= 1) { const unsigned x1 = *(const unsigned*)(CX + (size_t)(t - 1) * CWID + c), c1 = *(const unsigned*)(CC + (size_t)(t - 1) * CWID + c);
                y0 += conv_w[CWID + c] * (bflo(x1) * bflo(c1)); y1 += conv_w[CWID + c + 1] * (bfhi(x1) * bfhi(c1)); }
            if (s >= 2) { const unsigned x2 = *(const unsigned*)(CX + (size_t)(t - 2) * CWID + c), c2v = *(const unsigned*)(CC + (size_t)(t - 2) * CWID + c);
                y0 += conv_w[c] * (bflo(x2) * bflo(c2v)); y1 += conv_w[c + 1] * (bfhi(x2) * bfhi(c2v)); }
            const unsigned b0 = *(const unsigned*)(CB + (size_t)t * CWID + c);
            *(unsigned*)(CO + (size_t)t * CWID + c) = pk2(bflo(b0) * y0, bfhi(b0) * y1); }
    }
    SEAM(4);
    if (IN(5)) {
        { pg8::Gemm g{AO, WA, M, DM, AW}; pg8::StaticOrder S; S.init(M, DM, G, bx); pg8::EpiBf16G E{YA, YA, 1 << 30, 0, 1 << 30, DM, nullptr};
          pg8::gemm_phase<pg8::EpiBf16G, pg8::StaticOrder, true, true>(ldsp + RING_OFF, g, S, E); }
        { pg8::Gemm g{CO, WC, M, DM, CWID}; pg8::StaticOrder S; S.init(M, DM, G, bx); pg8::EpiBf16G E{YC, YC, 1 << 30, 0, 1 << 30, DM, nullptr};
          pg8::gemm_phase<pg8::EpiBf16G, pg8::StaticOrder, true, true>(ldsp + RING_OFF, g, S, E); }
    }
    SEAM(5);
    if (IN(6)) {
        for (int e = gt; e < M * (DM / 2); e += NGT) { const int c2 = e & 1023; const int t = e >> 10; const int c = 2 * c2; const int gi = c >> 10, cc = c & 1023;
            const unsigned a = *(const unsigned*)(GA + (size_t)gi * M * 1024 + (size_t)t * 1024 + cc), cg = *(const unsigned*)(GC + (size_t)gi * M * 1024 + (size_t)t * 1024 + cc);
            const unsigned ya = *(const unsigned*)(YA + (size_t)t * DM + c), yc = *(const unsigned*)(YC + (size_t)t * DM + c);
            const float s0 = 1.f / (1.f + __expf(-bflo(a))), s1 = 1.f / (1.f + __expf(-bfhi(a))), u0 = 1.f / (1.f + __expf(-bflo(cg))), u1 = 1.f / (1.f + __expf(-bfhi(cg)));
            *(unsigned*)(MERGED + (size_t)t * DM + c) = pk2(s0 * bflo(ya) + u0 * bflo(yc), s1 * bfhi(ya) + u1 * bfhi(yc)); }
    }
    SEAM(6);
    if (IN(7)) {
        pg8::Gemm g{MERGED, WM, M, DM, DM}; pg8::StaticOrder S; S.init(M, DM, G, bx); pg8::EpiResid E{x_in, out, XB, DM};
        pg8::gemm_phase<pg8::EpiResid, pg8::StaticOrder, true, true>(ldsp + RING_OFF, g, S, E);
    }
    SEAM(7);
    if (IN(8)) { for (int m = gw; m < M; m += NGW) { const float r = row_rstd(out + (size_t)m * DM, lane); if (lane == 0) R2[m] = r; } }
    SEAM(8);
    if (IN(9)) {
        pg8::Gemm g{XB, WQ, M, XW, DM}; pg8::StaticOrder S; S.init(M, XW, G, bx); pg8::EpiBf16G E{HQ, HQ, 1 << 30, 0, 1 << 30, XW, R2};
        pg8::gemm_phase<pg8::EpiBf16G, pg8::StaticOrder, true, true>(ldsp + RING_OFF, g, S, E);
    }
    SEAM(9);
    if (IN(10)) {
        att::Seam S; char* albase = (char*)lds + RING_OFF; constexpr int NIT = NB * XH * 32;
        for (int L = vcu; L < NIT; L += G) { int tv = threadIdx.x; asm volatile("" : "+v"(tv)); const int bh = L >> 5, b = bh >> 2, h = bh & 3, qb = L & 31;
            const bf16* Qp = HQ + ((size_t)b * SEQ + (size_t)qb * 256) * XW + h * HD; const bf16* Kp = MKV + (size_t)b * NMEM * (2 * XW) + h * HD;
            bf16* Op = XO + ((size_t)b * SEQ + (size_t)qb * 256) * XW + h * HD;
            att::attn_prime<XW, 2 * XW, (long)XW>(tv, Qp, Kp, albase, S);
            att::attn_block<false, XW, 2 * XW, (long)XW, XW>(tv, Kp, Op, NMEM / 64, 0, Qp, Kp, albase, S); }
    }
    SEAM(10);
    if (IN(11)) {
        pg8::Gemm g{XO, WO, M, DM, XW}; pg8::StaticOrder S; S.init(M, DM, G, bx); pg8::EpiResid E{out, out, XB, DM};
        pg8::gemm_phase<pg8::EpiResid, pg8::StaticOrder, true, true>(ldsp + RING_OFF, g, S, E);
    }
    SEAM(11);
    if (IN(12)) { for (int m = gw; m < M; m += NGW) { const float r = row_rstd(out + (size_t)m * DM, lane); if (lane == 0) R3[m] = r; } }
    SEAM(12);
    if (IN(13)) {
        pg8::Gemm g{XB, WUP, M, DFF, DM}; pg8::StaticOrder S; S.init(M, DFF, G, bx); pg8::EpiUp E{UP, DFF, R3};
        pg8::gemm_phase<pg8::EpiUp, pg8::StaticOrder, true, true>(ldsp + RING_OFF, g, S, E);
    }
    SEAM(13);
    if (IN(14)) {
        pg8::Gemm g{UP, WD, M, DM, DFF}; pg8::StaticOrder S; S.init(M, DM, G, bx); pg8::EpiResid E{out, out, nullptr, DM};
        pg8::gemm_phase<pg8::EpiResid, pg8::StaticOrder, true, true>(ldsp + RING_OFF, g, S, E);
    }
    SEAM(14);
    if (IN(15)) {
        for (int m = gw; m < M; m += NGW) { GAS f32x4* xr = (GAS f32x4*)(out + (size_t)m * DM) + lane; const GAS f32x4* gr = (const GAS f32x4*)norm_final + lane; f32x4 v[8]; float s = 0.f;
#pragma unroll
            for (int j = 0; j < 8; ++j) { v[j] = xr[64 * j]; s += (v[j].x * v[j].x + v[j].y * v[j].y) + (v[j].z * v[j].z + v[j].w * v[j].w); }
            const float rstd = 1.f / sqrtf(wave_sum(s) * (1.f / DM) + EPS);
#pragma unroll
            for (int j = 0; j < 8; ++j) { const f32x4 gg = gr[64 * j]; xr[64 * j] = (f32x4){v[j].x * rstd * gg.x, v[j].y * rstd * gg.y, v[j].z * rstd * gg.z, v[j].w * rstd * gg.w}; } }
    }
#undef IN
#undef SEAM
}
#undef x_in
#undef mem_in


extern "C" void kernel_launch(void* const* d_in, const int* in_sizes, int n_in, void* d_out, int out_size, void* d_ws, size_t ws_size, hipStream_t stream) {
    static int grid = 0;
    if (grid == 0) {
        if (n_in != 17 || in_sizes[0] != M * DM || out_size != M * DM || ws_size < WS_END) { fprintf(stderr, "kernel_launch: unexpected shapes: n_in %d in0 %d out %d ws %zu (need %zu)\n", n_in, n_in > 0 ? in_sizes[0] : -1, out_size, ws_size, (size_t)WS_END); grid = -1; return; }
        int dev = 0, cus = 0, per_cu = 0;
        if (hipGetDevice(&dev) != hipSuccess || hipDeviceGetAttribute(&cus, hipDeviceAttributeMultiprocessorCount, dev) != hipSuccess) { fprintf(stderr, "kernel_launch: device query failed\n"); grid = -1; return; }
        if (hipFuncSetAttribute((const void*)mk_fwd, hipFuncAttributeMaxDynamicSharedMemorySize, LDS_BYTES) != hipSuccess) { fprintf(stderr, "kernel_launch: hipFuncSetAttribute failed\n"); grid = -1; return; }
        if (hipOccupancyMaxActiveBlocksPerMultiprocessor(&per_cu, (const void*)mk_fwd, NWAVES * 64, LDS_BYTES) != hipSuccess || per_cu < 1) fprintf(stderr, "kernel_launch: note: occupancy query reports %d workgroups per CU\n", per_cu);
        (void)hipGetLastError();
        grid = cus;
    }
    if (grid < 0) return;
    if (hipMemsetAsync((char*)d_ws + WS_CTL, 0, CTL_ZERO_BYTES, stream) != hipSuccess) { fprintf(stderr, "kernel_launch: hipMemsetAsync failed\n"); return; }
    Args a{};
    for (int i = 0; i < 17; ++i) a.in[i] = (const float*)d_in[i];
    a.out = (float*)d_out; a.ws = (unsigned char*)d_ws;
#if MK_PER_PHASE
    for (int p = 0; p < N_PHASES; ++p) { a.ph_lo = p; a.ph_hi = p + 1; a.li = p; hipLaunchKernelGGL(mk_fwd, dim3(grid), dim3(NWAVES * 64), LDS_BYTES, stream, a); }
#else
    a.ph_lo = 0; a.ph_hi = N_PHASES; a.li = 0;
    hipLaunchKernelGGL(mk_fwd, dim3(grid), dim3(NWAVES * 64), LDS_BYTES, stream, a);
#endif
    const hipError_t le = hipPeekAtLastError();
    if (le != hipSuccess) fprintf(stderr, "kernel_launch: launch failed: %s\n", hipGetErrorName(le));
}
```

```cpp
#include <hip/hip_runtime.h>
#include <cstdio>
#include <cstdint>
namespace pg8 {
#define PG8_LAS __attribute__((address_space(3)))
typedef unsigned short bf16_t;
typedef short bf16x8 __attribute__((ext_vector_type(8)));
typedef float f32x4 __attribute__((ext_vector_type(4)));
typedef unsigned u32x4 __attribute__((ext_vector_type(4)));
constexpr int BM = 256, BK = 64, HALF = 128, HTB = HALF * BK * 2  , STAGE_BYTES = 8 * HTB, NXCD = 8, WGM = 8;

__host__ __device__ __forceinline__ int lds_byte(int r, int c) { const int st = (r >> 4) * 2 + (c >> 5), rr = r & 15, cc = c & 31, ob = rr * 64 + cc * 2; return st * 1024 + (ob ^ (((ob >> 9) & 1) << 5)); }
__host__ __device__ __forceinline__ void stage_rc(int b, int& R, int& C) { const int st = b / 1024, sb = b % 1024, swz = sb ^ (((sb >> 9) & 1) << 5); R = (st >> 1) * 16 + swz / 64; C = (st & 1) * 32 + (swz % 64) / 2; }
__host__ __device__ __forceinline__ int perm32(int rho) { const int n = rho >> 4, i = rho & 15; return 8 * (i >> 2) + 4 * n + (i & 3); }

struct Unit { int pm, pn; };
struct Gemm { const bf16_t* A; const bf16_t* Bt; int M, N, K; };

struct StaticOrder {
    int nM, nN, nwg, G, c;
    __host__ __device__ void init(int M, int N, int G_, int c_) { nM = M / BM; nN = N / BM; nwg = nM * nN; G = G_; c = c_; }
    __host__ __device__ bool next(int i, Unit& u) const {
        const long L = (long)i * G + c; if (L >= nwg) return false;
        int wgid = (int)L; { const int q = nwg / NXCD, r = nwg % NXCD, xcd = wgid % NXCD, off = wgid / NXCD; wgid = (xcd < r ? xcd * (q + 1) : r * (q + 1) + (xcd - r) * q) + off; }
        const int nig = WGM * nN, gid = wgid / nig, fm = gid * WGM, gsz = (nM - fm) < WGM ? (nM - fm) : WGM;
        u.pm = fm + ((wgid % nig) % gsz); u.pn = (wgid % nig) / gsz; return true;
    }
    __device__ __forceinline__ void a_ready(const Unit&) const {}
    __device__ __forceinline__ void done(const Unit&) const {}
};


__device__ __forceinline__ unsigned cvt_pk_bf16(float lo, float hi) { unsigned r; asm volatile("v_cvt_pk_bf16_f32 %0, %1, %2" : "=v"(r) : "v"(lo), "v"(hi)); return r; }
typedef unsigned u32x2 __attribute__((ext_vector_type(2)));

constexpr float SS_SCALE = 16777216.f, SS_INV = 1.f / (16777216.f * 2048.f), RMS_EPS = 1e-6f;
__device__ __forceinline__ float rstd_from_ss(const unsigned long long* ss, int row) { return 1.f / sqrtf((float)ss[row] * SS_INV + RMS_EPS); }
struct EpiBf16G {
    static constexpr bool PERM = true, AFTER_DRAIN = false;
    bf16_t* g0; bf16_t* g1; int tsplit; size_t gstride; int gcols; int ldc; const unsigned long long* ss;
    __device__ __forceinline__ void operator()(const f32x4 (&acc)[2][2][4][2], const Unit& u, int wr, int wc, int fr, int fq) const {
        const int row0 = u.pm * BM + wr * 64 + fr; int colt = u.pn * BM; const int t = colt / gcols; colt -= t * gcols;
        bf16_t* base = (t < tsplit) ? g0 + (size_t)t * gstride : g1 + (size_t)(t - tsplit) * gstride;
        const int col0 = colt + wc * 32 + 8 * fq;
#pragma unroll
        for (int ai = 0; ai < 2; ++ai)
#pragma unroll
            for (int m = 0; m < 4; ++m) { bf16_t* rowp = base + (size_t)(row0 + ai * HALF + m * 16) * ldc + col0; const float s = ss ? rstd_from_ss(ss, row0 + ai * HALF + m * 16) : 1.f;
#pragma unroll
                for (int bj = 0; bj < 2; ++bj) { const f32x4 v0 = acc[ai][bj][m][0] * s, v1 = acc[ai][bj][m][1] * s;
                    u32x4 w; w.x = cvt_pk_bf16(v0[0], v0[1]); w.y = cvt_pk_bf16(v0[2], v0[3]); w.z = cvt_pk_bf16(v1[0], v1[1]); w.w = cvt_pk_bf16(v1[2], v1[3]);
                    *(u32x4*)(rowp + bj * HALF) = w; } }
    }
};
struct EpiResid {
    static constexpr bool PERM = false, AFTER_DRAIN = false;
    const float* base; float* out; bf16_t* outb; int ldc; unsigned long long* ss;
    __device__ __forceinline__ void operator()(const f32x4 (&acc)[2][2][4][2], const Unit& u, int wr, int wc, int fr, int fq) const {
        const int row0 = u.pm * BM + wr * 64 + fr, col0 = u.pn * BM + wc * 32 + 4 * fq;
#pragma unroll
        for (int ai = 0; ai < 2; ++ai)
#pragma unroll
            for (int m = 0; m < 4; ++m) { const size_t off = (size_t)(row0 + ai * HALF + m * 16) * ldc + col0; float sq = 0.f;
#pragma unroll
                for (int bj = 0; bj < 2; ++bj)
#pragma unroll
                    for (int n = 0; n < 2; ++n) { const f32x4 o = *(const f32x4*)(base + off + bj * HALF + n * 16) + acc[ai][bj][m][n];
                        *(f32x4*)(out + off + bj * HALF + n * 16) = o; sq += (o[0] * o[0] + o[1] * o[1]) + (o[2] * o[2] + o[3] * o[3]);
                        if (outb) { u32x2 w; w.x = cvt_pk_bf16(o[0], o[1]); w.y = cvt_pk_bf16(o[2], o[3]); *(u32x2*)(outb + off + bj * HALF + n * 16) = w; } }
                if (ss) { sq += __shfl_xor(sq, 16); sq += __shfl_xor(sq, 32);
                    if (fq == 0) __hip_atomic_fetch_add(ss + row0 + ai * HALF + m * 16, (unsigned long long)__float2ull_rn(sq * SS_SCALE), __ATOMIC_RELAXED, __HIP_MEMORY_SCOPE_AGENT); }
                if (m & 1) asm volatile("" ::: "memory"); }
    }
};
struct EpiUp {
    static constexpr bool PERM = true, AFTER_DRAIN = false;
    bf16_t* O; int ldc; const unsigned long long* ss;
    __device__ __forceinline__ void operator()(const f32x4 (&acc)[2][2][4][2], const Unit& u, int wr, int wc, int fr, int fq) const {
        const int row0 = u.pm * BM + wr * 64 + fr, col0 = u.pn * BM + wc * 32 + 8 * fq;
#pragma unroll
        for (int ai = 0; ai < 2; ++ai)
#pragma unroll
            for (int m = 0; m < 4; ++m) { const int r = row0 + ai * HALF + m * 16; const float s = rstd_from_ss(ss, r); bf16_t* rowp = O + (size_t)r * ldc + col0;
#pragma unroll
                for (int bj = 0; bj < 2; ++bj) { f32x4 v0 = acc[ai][bj][m][0] * s, v1 = acc[ai][bj][m][1] * s;
#pragma unroll
                    for (int e = 0; e < 4; ++e) { v0[e] = fmaxf(v0[e], 0.f); v1[e] = fmaxf(v1[e], 0.f); }
                    v0 = v0 * v0; v1 = v1 * v1;
                    u32x4 w; w.x = cvt_pk_bf16(v0[0], v0[1]); w.y = cvt_pk_bf16(v0[2], v0[3]); w.z = cvt_pk_bf16(v1[0], v1[1]); w.w = cvt_pk_bf16(v1[2], v1[3]);
                    *(u32x4*)(rowp + bj * HALF) = w; } }
    }
};

template <class Epi, class Sched, bool ALIGN_EPI = false, bool SP2 = false>
__device__ __forceinline__ void gemm_phase(PG8_LAS unsigned char* lds, const Gemm g, const Sched& S, const Epi& E) {
    const int tid = threadIdx.x, wid = __builtin_amdgcn_readfirstlane(tid >> 6), lane = tid & 63, wr = wid >> 2, wc = wid & 3, fr = lane & 15, fq = lane >> 4;
    const int K = g.K, nt = K / BK;
    unsigned voffA[2], voffB[2];
#pragma unroll
    for (int i = 0; i < 2; ++i) { int R, C; stage_rc(tid * 16 + i * 8192, R, C); const int Rb = Epi::PERM ? ((R & ~31) + perm32(R & 31)) : R;
        voffA[i] = (unsigned)(R * K + C) * 2u; voffB[i] = (unsigned)(Rb * K + C) * 2u; }
    const size_t kstep = (size_t)(BK * 2);
    const size_t hstep = (size_t)HALF * K * 2;
    const size_t tstep = 2 * hstep;
    const unsigned ldsw = (unsigned)wid * 1024u;
    const int aoff = lds_byte(wr * 64 + fr, fq * 8), boff = lds_byte(wc * 32 + fr, fq * 8);
#define PG8_SA(b, h) (((b) * 2 + (h)) * HTB)
#define PG8_SB(b, h) ((4 + (b) * 2 + (h)) * HTB)
#define PG8_STAGE(bufoff, gbase, voff) do { _Pragma("unroll") for (int _i = 0; _i < 2; ++_i) \
        __builtin_amdgcn_global_load_lds((const unsigned*)((const char*)(gbase) + (voff)[_i]), (PG8_LAS unsigned*)(lds + (bufoff) + ldsw + _i * 8192), 16, 0, 0); } while (0)
#define PG8_LDA(dst, b, h) do { _Pragma("unroll") for (int m = 0; m < 4; ++m) _Pragma("unroll") for (int k = 0; k < 2; ++k) dst[m][k] = *(const PG8_LAS bf16x8*)(lds + PG8_SA(b, h) + aoff + m * 2048 + k * 1024); } while (0)
#define PG8_LDB(dst, b, h) do { _Pragma("unroll") for (int n = 0; n < 2; ++n) _Pragma("unroll") for (int k = 0; k < 2; ++k) dst[n][k] = *(const PG8_LAS bf16x8*)(lds + PG8_SB(b, h) + boff + n * 2048 + k * 1024); } while (0)
#define PG8_MMA(ai, bj, At, Bt) do { __builtin_amdgcn_s_setprio(1); _Pragma("unroll") for (int m = 0; m < 4; ++m) _Pragma("unroll") for (int n = 0; n < 2; ++n) _Pragma("unroll") for (int k = 0; k < 2; ++k) \
        acc[ai][bj][m][n] = __builtin_amdgcn_mfma_f32_16x16x32_bf16(Bt[n][k], At[m][k], acc[ai][bj][m][n], 0, 0, 0); __builtin_amdgcn_s_setprio(0); } while (0)
#define PG8_WAIT_V(n) asm volatile("s_waitcnt vmcnt(" #n ")" ::: "memory")
#define PG8_WAIT_L(n) asm volatile("s_waitcnt lgkmcnt(" #n ")" ::: "memory")
#define PG8_BAR __builtin_amdgcn_s_barrier()
#define PG8_SCHED __builtin_amdgcn_sched_barrier(0)
    Unit cur, nxt; int ui = 0;
    if (!S.next(0, cur)) return;
    f32x4 acc[2][2][4][2];
#pragma unroll
    for (int a = 0; a < 2; ++a)
#pragma unroll
        for (int b = 0; b < 2; ++b)
#pragma unroll
            for (int m = 0; m < 4; ++m)
#pragma unroll
                for (int n = 0; n < 2; ++n) acc[a][b][m][n] = (f32x4){0.f, 0.f, 0.f, 0.f};
    bf16x8 At[4][2], B0[2][2], B1[2][2];
    const char* cA = (const char*)g.A + (size_t)cur.pm * tstep; const char* cB = (const char*)g.Bt + (size_t)cur.pn * tstep;
    S.a_ready(cur);
    if constexpr (SP2) {
        PG8_STAGE(PG8_SB(0, 0), cB, voffB); PG8_STAGE(PG8_SB(0, 1), cB + hstep, voffB); PG8_STAGE(PG8_SA(0, 0), cA, voffA); PG8_STAGE(PG8_SA(0, 1), cA + hstep, voffA);
        if (wr == 1) PG8_BAR;
        PG8_WAIT_V(2); PG8_BAR;
        PG8_STAGE(PG8_SB(1, 0), cB + kstep, voffB); PG8_STAGE(PG8_SA(1, 0), cA + kstep, voffA); PG8_STAGE(PG8_SB(1, 1), cB + hstep + kstep, voffB);
        PG8_WAIT_V(6); PG8_BAR;
    } else {
        PG8_STAGE(PG8_SB(0, 0), cB, voffB); PG8_STAGE(PG8_SA(0, 0), cA, voffA); PG8_STAGE(PG8_SB(0, 1), cB + hstep, voffB); PG8_STAGE(PG8_SA(0, 1), cA + hstep, voffA);
        if (wr == 1) PG8_BAR;
        PG8_WAIT_V(4); PG8_BAR;
        PG8_STAGE(PG8_SB(1, 0), cB + kstep, voffB); PG8_STAGE(PG8_SA(1, 0), cA + kstep, voffA); PG8_STAGE(PG8_SB(1, 1), cB + hstep + kstep, voffB);
        PG8_WAIT_V(6); PG8_BAR;
    }
    for (;;) {
        const bool has_next = S.next(ui + 1, nxt);
        const char* nA = has_next ? (const char*)g.A + (size_t)nxt.pm * tstep : cA; const char* nB = has_next ? (const char*)g.Bt + (size_t)nxt.pn * tstep : cB;
        for (int t = 0; t < nt; t += 2) {
            const bool last = (t == nt - 2);
            const char* a1 = cA + (size_t)(t + 1) * kstep;
            const char* a2 = last ? nA : cA + (size_t)(t + 2) * kstep; const char* b2 = last ? nB : cB + (size_t)(t + 2) * kstep;
            const char* a3 = a2 + kstep; const char* b3 = b2 + kstep;
            if (last && has_next) S.a_ready(nxt);
            if constexpr (SP2) {
            PG8_LDB(B0, 0, 0); PG8_LDB(B1, 0, 1); PG8_SCHED; PG8_LDA(At, 0, 0); PG8_STAGE(PG8_SA(1, 1), a1 + hstep, voffA);
            PG8_WAIT_V(8); PG8_WAIT_L(0); PG8_BAR; PG8_MMA(0, 0, At, B0); PG8_MMA(0, 1, At, B1); PG8_BAR; PG8_SCHED;
            PG8_LDA(At, 0, 1); PG8_STAGE(PG8_SB(0, 0), b2, voffB); PG8_STAGE(PG8_SB(0, 1), b2 + hstep, voffB); PG8_STAGE(PG8_SA(0, 0), a2, voffA);
            PG8_WAIT_V(8); PG8_WAIT_L(0); PG8_BAR; PG8_MMA(1, 0, At, B0); PG8_MMA(1, 1, At, B1); PG8_BAR; PG8_SCHED;
            PG8_LDB(B0, 1, 0); PG8_LDB(B1, 1, 1); PG8_SCHED; PG8_LDA(At, 1, 0); PG8_STAGE(PG8_SA(0, 1), a2 + hstep, voffA);
            PG8_WAIT_V(8); PG8_WAIT_L(0); PG8_BAR; PG8_MMA(0, 0, At, B0); PG8_MMA(0, 1, At, B1); PG8_BAR; PG8_SCHED;
            PG8_LDA(At, 1, 1); PG8_STAGE(PG8_SB(1, 0), b3, voffB); PG8_STAGE(PG8_SB(1, 1), b3 + hstep, voffB); PG8_STAGE(PG8_SA(1, 0), a3, voffA);
            PG8_WAIT_V(8); PG8_WAIT_L(0); PG8_BAR; PG8_MMA(1, 0, At, B0); PG8_MMA(1, 1, At, B1); PG8_BAR; PG8_SCHED;
            } else {
            PG8_LDB(B0, 0, 0); PG8_SCHED; PG8_LDA(At, 0, 0); PG8_STAGE(PG8_SA(1, 1), a1 + hstep, voffA);
            PG8_WAIT_L(8); PG8_BAR; PG8_WAIT_L(0); PG8_MMA(0, 0, At, B0); PG8_BAR; PG8_SCHED;
            PG8_LDB(B1, 0, 1); PG8_STAGE(PG8_SB(0, 0), b2, voffB);
            PG8_BAR; PG8_WAIT_L(0); PG8_MMA(0, 1, At, B1); PG8_BAR;
            PG8_LDA(At, 0, 1); PG8_STAGE(PG8_SA(0, 0), a2, voffA);
            PG8_BAR; PG8_WAIT_L(0); PG8_MMA(1, 0, At, B0); PG8_BAR; PG8_SCHED;
            PG8_STAGE(PG8_SB(0, 1), b2 + hstep, voffB);
            PG8_WAIT_V(6); PG8_BAR; PG8_MMA(1, 1, At, B1); PG8_BAR;
            PG8_LDB(B0, 1, 0); PG8_SCHED; PG8_LDA(At, 1, 0); PG8_STAGE(PG8_SA(0, 1), a2 + hstep, voffA);
            PG8_WAIT_L(8); PG8_BAR; PG8_WAIT_L(0); PG8_MMA(0, 0, At, B0); PG8_BAR; PG8_SCHED;
            PG8_LDB(B1, 1, 1); PG8_STAGE(PG8_SB(1, 0), b3, voffB);
            PG8_BAR; PG8_WAIT_L(0); PG8_MMA(0, 1, At, B1); PG8_BAR;
            PG8_LDA(At, 1, 1); PG8_STAGE(PG8_SA(1, 0), a3, voffA);
            PG8_BAR; PG8_WAIT_L(0); PG8_MMA(1, 0, At, B0); PG8_BAR; PG8_SCHED;
            PG8_STAGE(PG8_SB(1, 1), b3 + hstep, voffB);
            PG8_WAIT_V(6); PG8_BAR; PG8_MMA(1, 1, At, B1); PG8_BAR;
            }
        }
        if constexpr (ALIGN_EPI) { if (wr == 0) PG8_BAR; }
        if constexpr (!Epi::AFTER_DRAIN) { E(acc, cur, wr, wc, fr, fq); S.done(cur); }
        if (!has_next) break;
#pragma unroll
        for (int a = 0; a < 2; ++a)
#pragma unroll
            for (int b = 0; b < 2; ++b)
#pragma unroll
                for (int m = 0; m < 4; ++m)
#pragma unroll
                    for (int n = 0; n < 2; ++n) acc[a][b][m][n] = (f32x4){0.f, 0.f, 0.f, 0.f};
        cur = nxt; cA = nA; cB = nB; ++ui;
        if constexpr (ALIGN_EPI) { if (wr == 1) PG8_BAR; }
    }
    PG8_WAIT_V(0);
    if constexpr (!ALIGN_EPI) { if (wr == 0) PG8_BAR; }
    PG8_BAR;
    if constexpr (Epi::AFTER_DRAIN) { E.fused(acc, cur, wr, wc, fr, fq, lds, wid, lane); S.done(cur); }
#undef PG8_SA
#undef PG8_SB
#undef PG8_STAGE
#undef PG8_LDA
#undef PG8_LDB
#undef PG8_MMA
#undef PG8_WAIT_V
#undef PG8_WAIT_L
#undef PG8_BAR
#undef PG8_SCHED
}
}
#define GAS __attribute__((address_space(1)))
#define LAS __attribute__((address_space(3)))
typedef unsigned short bf16;
typedef unsigned v4u __attribute__((ext_vector_type(4)));
typedef float f32x4 __attribute__((ext_vector_type(4)));
typedef short bf16x8 __attribute__((ext_vector_type(8)));
typedef GAS unsigned gu32;
typedef GAS unsigned long long gu64;
#define RLX_AGENT __ATOMIC_RELAXED, __HIP_MEMORY_SCOPE_AGENT
#define LDS_WAIT() asm volatile("s_waitcnt lgkmcnt(0)" ::: "memory")
#define VM_WAIT() asm volatile("s_waitcnt vmcnt(0)" ::: "memory")
__device__ __forceinline__ unsigned long long rt() { return __builtin_amdgcn_s_memrealtime(); }
__device__ __forceinline__ unsigned f2bf(float f) { unsigned u = __builtin_bit_cast(unsigned, f); return (u + 0x7fffu + ((u >> 16) & 1u)) >> 16; }
__device__ __forceinline__ unsigned pk2(float lo, float hi) { return f2bf(lo) | (f2bf(hi) << 16); }

#define XB_TMO      128
#define XB_XCNT(j)  (256  + 64 * (j))
#define XB_XSUB(j)  (1280 + 64 * (j))
#define XB_XGEN(j)  (2304 + 64 * (j))
#define XB_TOP      3328
#define XB_TOPGEN   3392
#define XCD_BAR_WORDS 3456
#define XB_SPIN_CAP (1u << 18)

__device__ __forceinline__ unsigned xb_ld(unsigned* p)              { return __hip_atomic_load(p, __ATOMIC_RELAXED, __HIP_MEMORY_SCOPE_AGENT); }
__device__ __forceinline__ unsigned xb_add(unsigned* p, unsigned v) { return __hip_atomic_fetch_add(p, v, __ATOMIC_RELAXED, __HIP_MEMORY_SCOPE_AGENT); }
__device__ __forceinline__ unsigned xb_xcc_id() { return (unsigned)__builtin_amdgcn_s_getreg((3 << 11) | 20) & 0xFu; }
#define XB_SPIN(cond, bar) do { unsigned _sp = 0; while (cond) { __builtin_amdgcn_s_sleep(1); \
    if ((++_sp & 255u) == 0u) { if (xb_ld(&(bar)[XB_TMO])) break; if (_sp > XB_SPIN_CAP) { atomicAdd(&(bar)[XB_TMO], 1u); break; } } } } while (0)

struct XcdBarrier {
    unsigned* bar; unsigned x;
    volatile LAS unsigned* st;
};

__device__ __forceinline__ XcdBarrier xcd_barrier_post(unsigned* bar, volatile LAS unsigned* st) {
    XcdBarrier b; b.bar = bar; b.x = xb_xcc_id(); b.st = st;
    if (threadIdx.x == 0) (void)xb_add(&bar[XB_XCNT(b.x)], 1u);
    return b;
}
__device__ __forceinline__ void xcd_barrier_complete(unsigned* bar, unsigned x, unsigned& nloc, unsigned& nx) {
    const unsigned G = gridDim.x * gridDim.y * gridDim.z;
    unsigned sum, cnt, mine, sp = 0u;
    for (;;) {
        sum = 0u; cnt = 0u; mine = 0u;
#pragma unroll
        for (unsigned j = 0; j < 16; ++j) { const unsigned c = xb_ld(&bar[XB_XCNT(j)]); sum += c; cnt += (c > 0u) ? 1u : 0u; mine = (j == x) ? c : mine; }
        if (sum == G) break;
        __builtin_amdgcn_s_sleep(1);
        if ((++sp & 255u) == 0u) { if (xb_ld(&bar[XB_TMO])) break; if (sp > XB_SPIN_CAP) { atomicAdd(&bar[XB_TMO], 1u); break; } }
    }
    nloc = mine > 0u ? mine : 1u; nx = cnt > 0u ? cnt : 1u;
}

__device__ __forceinline__ void xcd_barrier(const XcdBarrier& b) {
    asm volatile("s_waitcnt vmcnt(0)" ::: "memory");
    __syncthreads();
    if (threadIdx.x == 0) {
        unsigned* bar = b.bar;
        __builtin_amdgcn_s_waitcnt(0);
        unsigned nloc = b.st[0], nx = b.st[1];
        if (nloc == 0u) { xcd_barrier_complete(bar, b.x, nloc, nx); b.st[0] = nloc; b.st[1] = nx; }
        const unsigned old = xb_add(&bar[XB_XSUB(b.x)], 1u);
        const unsigned gen = old / nloc;
        if (old + 1u == (gen + 1u) * nloc) {
            __builtin_amdgcn_fence(__ATOMIC_RELEASE, "agent");
            asm volatile("s_waitcnt vmcnt(0)" ::: "memory");
            const unsigned og = xb_add(&bar[XB_TOP], 1u);
            const unsigned tg = og / nx;
            if (og + 1u == (tg + 1u) * nx) xb_add(&bar[XB_TOPGEN], 1u);
            else XB_SPIN(xb_ld(&bar[XB_TOPGEN]) == tg, bar);
            __builtin_amdgcn_fence(__ATOMIC_ACQUIRE, "agent");
            xb_add(&bar[XB_XGEN(b.x)], 1u);
            asm volatile("s_waitcnt vmcnt(0)" ::: "memory");
        } else {
            XB_SPIN(xb_ld(&bar[XB_XGEN(b.x)]) == gen, bar);
            __builtin_amdgcn_fence(__ATOMIC_ACQUIRE, "agent");
            asm volatile("s_waitcnt vmcnt(0)" ::: "memory");
        }
    }
    __syncthreads();
}

namespace att {
typedef short bf16x8 __attribute__((ext_vector_type(8)));
typedef short s16x4 __attribute__((ext_vector_type(4)));
typedef float f32x16 __attribute__((ext_vector_type(16)));
typedef float f32x4 __attribute__((ext_vector_type(4)));
typedef unsigned u32x4 __attribute__((ext_vector_type(4)));
typedef unsigned short bf16;
constexpr int D = 128, NW = 8, QBLK = 32, KVBLK = 64, QB = NW * QBLK;
constexpr int SHM_V = KVBLK * D * 2, SHM_K = KVBLK * D * 2;
constexpr int LDS_SEL = 2 * SHM_V + 2 * SHM_K + NW * 64 * 4;
constexpr int LDS_BYTES = LDS_SEL + 2 * QB * 4;
constexpr float SCALE = 0.08838834764831845f, THR = 8.f;
#define KSWZ(row, colB) ((row) * 256 + ((colB) ^ (((row) & 7) << 4)))
#define SBAR() __builtin_amdgcn_sched_barrier(0)
__device__ __forceinline__ int v_st(int k, int c) { const int kk = (k & ~0xC) | ((k & 4) << 1) | ((k & 8) >> 1); return ((kk >> 3) * 4 + (c >> 5)) * 512 + ((kk & 7) * 32 + (c & 31)) * 2; }
__device__ __forceinline__ int v_rd_base(int lane) { return ((lane & 3) << 3) | (((lane >> 2) & 3) << 6) | (((lane >> 4) & 1) << 5) | (((lane >> 5) & 1) << 8); }
constexpr int v_rd_off(int d0, int ks, int half) { return d0 * 512 + ks * 4096 + half * 2048; }
__device__ __forceinline__ int crow(int r, int hi) { return (r & 3) + 8 * (r >> 2) + 4 * hi; }
__device__ __forceinline__ unsigned cvtpk(float lo, float hi) { unsigned r; asm volatile("v_cvt_pk_bf16_f32 %0, %1, %2" : "=v"(r) : "v"(lo), "v"(hi)); return r; }
__device__ __forceinline__ bf16x8 load8(const bf16* p) { return *reinterpret_cast<const bf16x8*>(p); }
__device__ __forceinline__ void mask_causal(f32x16& p0, f32x16& p1, int dq) {
    const float NEG = -__builtin_inff();
#pragma unroll
    for (int r = 0; r < 16; ++r) { const int c = (r & 3) + 8 * (r >> 2); if (dq - c < 0) p0[r] = NEG; if (dq - c - 32 < 0) p1[r] = NEG; }
}
template <bool MOBA>
__device__ __forceinline__ void partialSM(f32x16& p0, f32x16& p1, float& m_reg, float& mn, float& alpha, bool rm) {
    float pmax = p0[0]; for (int r = 1; r < 16; ++r) pmax = fmaxf(pmax, p0[r]); for (int r = 0; r < 16; ++r) pmax = fmaxf(pmax, p1[r]);
    { auto rr = __builtin_amdgcn_permlane32_swap(__float_as_uint(pmax), __float_as_uint(pmax), false, false);
      pmax = fmaxf(__uint_as_float(rr[0]), __uint_as_float(rr[1])); }
    if (MOBA && rm) pmax = -__builtin_inff();
    constexpr float C2 = 1.4426950408889634f * SCALE;
    if (__builtin_expect(__all((pmax - m_reg) * SCALE <= THR), 1)) { mn = m_reg; alpha = 1.f; }
    else { mn = fmaxf(m_reg, pmax); alpha = __builtin_amdgcn_exp2f((m_reg - mn) * C2); m_reg = mn; }
    float mnL = -mn * C2; if (MOBA && rm) mnL = -__builtin_inff();
    for (int r = 0; r < 16; ++r) p0[r] = fmaf(p0[r], C2, mnL); for (int r = 0; r < 16; ++r) p1[r] = fmaf(p1[r], C2, mnL);
    for (int r = 0; r < 16; ++r) p0[r] = __builtin_amdgcn_exp2f(p0[r]);
}
__device__ __forceinline__ void finishSM(f32x16& p0, f32x16& p1, float alpha, float& l_reg, bf16x8& pa0, bf16x8& pa1, bf16x8& pa2, bf16x8& pa3) {
    for (int r = 0; r < 16; ++r) p1[r] = __builtin_amdgcn_exp2f(p1[r]);
    float ps = 0; for (int r = 0; r < 16; ++r) ps += p0[r]; for (int r = 0; r < 16; ++r) ps += p1[r];
    { auto rr = __builtin_amdgcn_permlane32_swap(__float_as_uint(ps), __float_as_uint(ps), false, false);
      ps = __uint_as_float(rr[0]) + __uint_as_float(rr[1]); }
    l_reg = l_reg * alpha + ps;
#define PK4(P, B_, OUT) do { unsigned a0 = cvtpk(P[B_+0], P[B_+1]), a1 = cvtpk(P[B_+2], P[B_+3]);                          \
        unsigned b0 = cvtpk(P[B_+4], P[B_+5]), b1 = cvtpk(P[B_+6], P[B_+7]);                                             \
        auto r0 = __builtin_amdgcn_permlane32_swap(a0, b0, false, false); auto r1 = __builtin_amdgcn_permlane32_swap(a1, b1, false, false); \
        u32x4 w = {r0[0], r1[0], r0[1], r1[1]}; OUT = *reinterpret_cast<bf16x8*>(&w); } while (0)
    PK4(p0, 0, pa0); PK4(p0, 8, pa1); PK4(p1, 0, pa2); PK4(p1, 8, pa3);
#undef PK4
}
template <int KB>
__device__ __forceinline__ void qkt(f32x16& p0, f32x16& p1, const char* K_lds, int r32, int hi, const bf16x8* qr) {
    p0 = f32x16{}; p1 = f32x16{};
    const char* kb[4];
#pragma unroll
    for (int dd = 0; dd < 4; ++dd) kb[dd] = K_lds + KB * SHM_K + KSWZ(r32, (dd * 16 + hi * 8) * 2);
#pragma unroll
    for (int d0 = 0; d0 < 8; ++d0) { const char* a = kb[d0 & 3] + (d0 >> 2) * 128;
        bf16x8 b0 = *reinterpret_cast<const bf16x8*>(a);
        bf16x8 b1 = *reinterpret_cast<const bf16x8*>(a + 32 * 256);
        p0 = __builtin_amdgcn_mfma_f32_32x32x16_bf16(b0, qr[d0], p0, 0, 0, 0);
        p1 = __builtin_amdgcn_mfma_f32_32x32x16_bf16(b1, qr[d0], p1, 0, 0, 0); }
}
template <int VB>
__device__ __forceinline__ void pv_tile(f32x16* o, int vb0, bf16x8 pa0, bf16x8 pa1, bf16x8 pa2, bf16x8 pa3) {
#define TRRD(dst, off) asm volatile("ds_read_b64_tr_b16 %0, %1 offset:%2" : "=&v"(dst) : "v"(vb0), "i"(off) : "memory")
#define PV_D0(d0) do { s16x4 l0, l1, l2, l3, h0, h1, h2, h3; constexpr int b_ = VB * SHM_V + v_rd_off(d0, 0, 0); \
        TRRD(l0, b_); TRRD(h0, b_ + 2048); TRRD(l1, b_ + 4096); TRRD(h1, b_ + 6144); TRRD(l2, b_ + 8192); TRRD(h2, b_ + 10240); TRRD(l3, b_ + 12288); TRRD(h3, b_ + 14336); \
        asm volatile("s_waitcnt lgkmcnt(0)" ::: "memory"); SBAR();   \
        o[d0] = __builtin_amdgcn_mfma_f32_32x32x16_bf16(pa0, (bf16x8){l0[0], l0[1], l0[2], l0[3], h0[0], h0[1], h0[2], h0[3]}, o[d0], 0, 0, 0);   \
        o[d0] = __builtin_amdgcn_mfma_f32_32x32x16_bf16(pa1, (bf16x8){l1[0], l1[1], l1[2], l1[3], h1[0], h1[1], h1[2], h1[3]}, o[d0], 0, 0, 0);   \
        o[d0] = __builtin_amdgcn_mfma_f32_32x32x16_bf16(pa2, (bf16x8){l2[0], l2[1], l2[2], l2[3], h2[0], h2[1], h2[2], h2[3]}, o[d0], 0, 0, 0);   \
        o[d0] = __builtin_amdgcn_mfma_f32_32x32x16_bf16(pa3, (bf16x8){l3[0], l3[1], l3[2], l3[3], h3[0], h3[1], h3[2], h3[3]}, o[d0], 0, 0, 0); } while (0)
    PV_D0(0); PV_D0(1); PV_D0(2); PV_D0(3);
#undef PV_D0
#undef TRRD
}
template <int QS>
__device__ __forceinline__ void moba_gate(int tid, const bf16* Q, const float* KM, int qb, unsigned* selw) {
    const int wid = __builtin_amdgcn_readfirstlane(tid >> 6), lane = tid & 63, r32 = lane & 31, hi = lane >> 5;
    bf16x8 qr[8];
#pragma unroll
    for (int d0 = 0; d0 < 8; ++d0) qr[d0] = load8(Q + (size_t)(wid * QBLK + r32) * QS + d0 * 16 + hi * 8);
    unsigned sel = 0u;
    {
        f32x16 g = {};
        const float* km = KM + (size_t)r32 * D + hi * 8;
#pragma unroll
        for (int d0 = 0; d0 < 8; ++d0) { const f32x4 a = *(const f32x4*)(km + d0 * 16), b = *(const f32x4*)(km + d0 * 16 + 4);
            u32x4 wh = {cvtpk(a[0], a[1]), cvtpk(a[2], a[3]), cvtpk(b[0], b[1]), cvtpk(b[2], b[3])};
            const f32x4 al = {a[0] - __uint_as_float(wh[0] << 16), a[1] - __uint_as_float(wh[0] & 0xffff0000u), a[2] - __uint_as_float(wh[1] << 16), a[3] - __uint_as_float(wh[1] & 0xffff0000u)};
            const f32x4 bl = {b[0] - __uint_as_float(wh[2] << 16), b[1] - __uint_as_float(wh[2] & 0xffff0000u), b[2] - __uint_as_float(wh[3] << 16), b[3] - __uint_as_float(wh[3] & 0xffff0000u)};
            u32x4 wl = {cvtpk(al[0], al[1]), cvtpk(al[2], al[3]), cvtpk(bl[0], bl[1]), cvtpk(bl[2], bl[3])};
            g = __builtin_amdgcn_mfma_f32_32x32x16_bf16(*reinterpret_cast<bf16x8*>(&wh), qr[d0], g, 0, 0, 0);
            g = __builtin_amdgcn_mfma_f32_32x32x16_bf16(*reinterpret_cast<bf16x8*>(&wl), qr[d0], g, 0, 0, 0); }
        const int IMIN = (int)0x80000000;
        int key[16];
#pragma unroll
        for (int r = 0; r < 16; ++r) { const int n = crow(r, hi); const int bits = (int)__float_as_uint(g[r]); const int s = bits ^ ((bits >> 31) & 0x7fffffff);
            key[r] = (n < qb) ? ((s & ~31) | (31 - n)) : IMIN; }
        int m1 = IMIN, m2 = IMIN, m3 = IMIN;
#pragma unroll
        for (int r = 0; r < 16; ++r) m1 = max(m1, key[r]);
#pragma unroll
        for (int r = 0; r < 16; ++r) m2 = max(m2, key[r] < m1 ? key[r] : IMIN);
#pragma unroll
        for (int r = 0; r < 16; ++r) m3 = max(m3, key[r] < m2 ? key[r] : IMIN);
        int c6[6];
        { auto r1 = __builtin_amdgcn_permlane32_swap((unsigned)m1, (unsigned)m1, false, false); c6[0] = (int)r1[0]; c6[1] = (int)r1[1];
          auto r2 = __builtin_amdgcn_permlane32_swap((unsigned)m2, (unsigned)m2, false, false); c6[2] = (int)r2[0]; c6[3] = (int)r2[1];
          auto r3 = __builtin_amdgcn_permlane32_swap((unsigned)m3, (unsigned)m3, false, false); c6[4] = (int)r3[0]; c6[5] = (int)r3[1]; }
        int t1 = IMIN, t2 = IMIN, t3 = IMIN;
#pragma unroll
        for (int r = 0; r < 6; ++r) t1 = max(t1, c6[r]);
#pragma unroll
        for (int r = 0; r < 6; ++r) t2 = max(t2, c6[r] < t1 ? c6[r] : IMIN);
#pragma unroll
        for (int r = 0; r < 6; ++r) t3 = max(t3, c6[r] < t2 ? c6[r] : IMIN);
        if (t1 != IMIN) sel |= 1u << (31 - (t1 & 31));
        if (t2 != IMIN) sel |= 1u << (31 - (t2 & 31));
        if (t3 != IMIN) sel |= 1u << (31 - (t3 & 31));
    }
    if (hi == 0) selw[wid * QBLK + r32] = sel;
}
struct Seam { bf16x8 qr[8]; bf16x8 st_v0, st_v1, st_k0, st_k1; };
#define ROWP(p, k0, rr, str) ((p) + (size_t)((k0) + (rr)) * (str) + sc)
#define VMW() asm volatile("s_waitcnt vmcnt(0)" ::: "memory")
#define VMWN(n) asm volatile("s_waitcnt vmcnt(%0)" :: "i"(n) : "memory")
#define SLOAD_H(Kp, Vp, k0, str) do { S.st_v0 = load8(ROWP(Vp, k0, sr, str)); S.st_v1 = load8(ROWP(Vp, k0, 32 + sr, str));              \
                         S.st_k0 = load8(ROWP(Kp, k0, sr, str)); S.st_k1 = load8(ROWP(Kp, k0, 32 + sr, str)); } while (0)
#define SWRITE_HK(bf) do { *(bf16x8*)(K_lds + (bf) * SHM_K + kws) = S.st_k0; *(bf16x8*)(K_lds + (bf) * SHM_K + kws + 32 * 256) = S.st_k1; } while (0)
#define SWRITE_HV(bf) do { *(bf16x8*)(V_lds + (bf) * SHM_V + vst0) = S.st_v0; *(bf16x8*)(V_lds + (bf) * SHM_V + vst1) = S.st_v1; } while (0)
#define SWRITE_H(bf) do { SWRITE_HV(bf); SWRITE_HK(bf); } while (0)
template <int QS, int KVS, long VOFF>
__device__ __forceinline__ void attn_prime(int tid, const bf16* curQ, const bf16* curK, char* lds, Seam& S) {
    const int wid = __builtin_amdgcn_readfirstlane(tid >> 6), lane = tid & 63, r32 = lane & 31, hi = lane >> 5;
    const int sr = tid >> 4, sc = (tid & 15) * 8, kws = KSWZ(sr, sc * 2); char* K_lds = lds + 2 * SHM_V;
    for (int d0 = 0; d0 < 8; ++d0) S.qr[d0] = load8(curQ + (size_t)(wid * QBLK + r32) * QS + d0 * 16 + hi * 8);
    SLOAD_H(curK, curK + VOFF, 0, KVS); VMW(); SWRITE_HK(0);
    __syncthreads();
}
template <bool MOBA, int QS, int KVS, long VOFF, int OS>
__device__ __forceinline__ void attn_block(int tid, const bf16* curK, bf16* curO, int NT, int selofs, const bf16* nxtQ, const bf16* nxtK, char* lds, Seam& S) {
    const int wid = __builtin_amdgcn_readfirstlane(tid >> 6), lane = tid & 63, r32 = lane & 31, hi = lane >> 5;
    const int qlo = wid * QBLK, qm = qlo + r32 - 4 * hi;
    char* V_lds = lds; char* K_lds = lds + 2 * SHM_V;
    float* ws = (float*)(lds + 2 * SHM_V + 2 * SHM_K) + wid * 64; float* li_l = ws, * al_l = ws + 32;
    const int sr = tid >> 4, sc = (tid & 15) * 8, vst0 = v_st(sr, sc), vst1 = v_st(32 + sr, sc), kws = KSWZ(sr, sc * 2);
    const int vb0 = (int)(uintptr_t)V_lds + v_rd_base(lane);
    const bf16* Kh = curK; const bf16* Vh = curK + VOFF; constexpr int kvs = KVS;
    unsigned sel = 0u;
    if (MOBA) sel = ((const unsigned*)(lds + LDS_SEL))[selofs + wid * QBLK + r32];
    float m_reg = -1e30f, l_reg = 0; f32x16 o[4] = {};
#define RESC(a) do { if (__any((a) < 1.f)) { if (hi == 0) al_l[r32] = (a); asm volatile("s_waitcnt lgkmcnt(0)" ::: "memory");              \
                     for (int d_ = 0; d_ < 4; ++d_) for (int r = 0; r < 16; ++r) o[d_][r] *= al_l[crow(r, hi)]; } } while (0)
#define KBASE(t) ((t) * KVBLK)
#define MASKT(P0_, P1_, t) do { if (MOBA) { const int kb_ = ((t) - (NT - 4)) * KVBLK; if (kb_ >= 0 && kb_ + KVBLK - 1 > qlo) mask_causal(P0_, P1_, qm - kb_); } } while (0)
#define RMT(t) (MOBA && ((t) < NT - 4) && !((sel >> ((t) >> 2)) & 1u))
    const int NQL = 8;
#define SEAM_K0() do { VMWN(8); SWRITE_HK(0); SBAR(); } while (0)
    f32x16 pA0, pA1, pB0, pB1; float mnA, mnB, alA, alB; bf16x8 pa0, pa1, pa2, pa3;
    (void)NQL;
    SWRITE_HV(0); SBAR();
    if (NT > 1) SLOAD_H(Kh, Vh, KBASE(1), kvs);
    SBAR(); qkt<0>(pA0, pA1, K_lds, r32, hi, S.qr);
    MASKT(pA0, pA1, 0); partialSM<MOBA>(pA0, pA1, m_reg, mnA, alA, RMT(0));
    if (NT > 1) { VMW(); SWRITE_H(1); }
    __syncthreads();
#define HALF_STEP(PX0, PX1, mnX, alX, PY0, PY1, alY, t, KB, VB, SB) do {                                                      \
        SBAR(); qkt<KB>(PX0, PX1, K_lds, r32, hi, S.qr);                                             \
        finishSM(PY0, PY1, alY, l_reg, pa0, pa1, pa2, pa3); SBAR();                                                           \
        if ((t) + 1 < NT) { SLOAD_H(Kh, Vh, KBASE((t) + 1), kvs); SBAR(); }                                               \
        pv_tile<VB>(o, vb0, pa0, pa1, pa2, pa3); MASKT(PX0, PX1, (t)); partialSM<MOBA>(PX0, PX1, m_reg, mnX, alX, RMT(t));                                        \
        __syncthreads();                                                                                                      \
        if ((t) + 1 < NT) { VMW(); SWRITE_H(SB); }                                                                          \
        RESC(alX); __syncthreads(); } while (0)
    for (int t = 1; t + 1 < NT; t += 2) {
        HALF_STEP(pB0, pB1, mnB, alB, pA0, pA1, alA, t, 1, 0, 0);
        HALF_STEP(pA0, pA1, mnA, alA, pB0, pB1, alB, t + 1, 0, 1, 1);
    }
    const bool even = (NT & 1) == 0;
    if (even) { SBAR(); qkt<1>(pB0, pB1, K_lds, r32, hi, S.qr); SBAR(); }
    SLOAD_H(nxtK, nxtK + VOFF, 0, KVS); SBAR();
#pragma unroll
    for (int d0 = 0; d0 < 8; ++d0) S.qr[d0] = load8(nxtQ + (size_t)(wid * QBLK + r32) * QS + d0 * 16 + hi * 8);
    SBAR();
    finishSM(pA0, pA1, alA, l_reg, pa0, pa1, pa2, pa3); SBAR();
    pv_tile<0>(o, vb0, pa0, pa1, pa2, pa3);
    if (even) { MASKT(pB0, pB1, NT - 1); partialSM<MOBA>(pB0, pB1, m_reg, mnB, alB, RMT(NT - 1)); __syncthreads(); RESC(alB);
        finishSM(pB0, pB1, alB, l_reg, pa0, pa1, pa2, pa3); SBAR(); pv_tile<1>(o, vb0, pa0, pa1, pa2, pa3); }
    SBAR(); SEAM_K0();
    if (hi == 0) li_l[r32] = l_reg; asm volatile("s_waitcnt lgkmcnt(0)" ::: "memory");
    float rli[16];
#pragma unroll
    for (int r = 0; r < 16; ++r) rli[r] = __builtin_amdgcn_rcpf(li_l[crow(r, hi)]);
    bf16* Ow = curO + (size_t)(wid * QBLK) * OS;
#pragma unroll
    for (int r = 0; r < 16; ++r) { const int orow = crow(r, hi);
#pragma unroll
        for (int d0 = 0; d0 < 4; ++d0) { const float v = o[d0][r] * rli[r];
            const float vn = __shfl_xor(v, 1);
            if ((r32 & 1) == 0) *(unsigned*)(Ow + (size_t)orow * OS + d0 * 32 + r32) = cvtpk(v, vn); } }
    __syncthreads();
#undef RESC
#undef KBASE
#undef MASKT
#undef RMT
#undef SEAM_K0
#undef HALF_STEP
}
#undef ROWP
#undef VMW
#undef VMWN
#undef SLOAD_H
#undef SWRITE_HK
#undef SWRITE_HV
#undef SWRITE_H
#undef KSWZ
#undef SBAR
}

constexpr int NWAVES = 8;
#ifndef MK_PER_PHASE
#define MK_PER_PHASE 0
#endif
constexpr int N_PHASES = 14;

constexpr int NB = 2, SEQ = 8192, DM = 2048, M = NB * SEQ;
constexpr int NH = 8, HD = 128, AW = NH * HD, CWID = 1024, NPROJ = 3 * AW + 3 * CWID + 2 * DM;
constexpr int NMEM = 256, XH = 4, XW = XH * HD, DFF = 4 * DM;
constexpr int MBLK = 256, NBLK = SEQ / MBLK, TOPK = 3;
constexpr float EPS = 1e-6f;
constexpr float ATT_SCALE = 0.08838834764831845f;

constexpr size_t MiB = 1u << 20;
constexpr size_t WS_CTL = 0, CTL_ZERO_BYTES = 1 * MiB;
constexpr size_t WS_ROPE = 2 * MiB;
constexpr size_t WS_KMEAN = 3 * MiB;
constexpr size_t WS_SS1 = 3 * MiB + 512 * 1024;
constexpr size_t WS_SS2 = WS_SS1 + 128 * 1024, WS_SS3 = WS_SS2 + 128 * 1024;
constexpr size_t WS_MEMN = 4 * MiB;
constexpr size_t WS_MKV = 6 * MiB;
constexpr size_t WS_WIN = 8 * MiB;
constexpr size_t WS_WA = 48 * MiB, WS_WC = 52 * MiB;
constexpr size_t WS_WM = 56 * MiB;
constexpr size_t WS_WQ = 64 * MiB;
constexpr size_t WS_WKV = 66 * MiB;
constexpr size_t WS_WO = 70 * MiB;
constexpr size_t WS_WUP = 72 * MiB;
constexpr size_t WS_WD = 104 * MiB;
constexpr size_t WS_XB = 136 * MiB;
constexpr size_t WS_G = 200 * MiB;
constexpr size_t GRP = 32 * MiB;
constexpr size_t WS_YA = 200 * MiB, WS_YC = 264 * MiB;
constexpr size_t WS_MERGED = 328 * MiB;
constexpr size_t WS_HQ = 200 * MiB, WS_XO = 216 * MiB;
constexpr size_t WS_UP = 232 * MiB;
constexpr size_t WS_END = 488 * MiB;
constexpr size_t DO_AO = 0, DO_CO = 32 * MiB, DO_GC = 64 * MiB;
constexpr int CW_TMO = 0, CW_CODE = 1, CW_BAR = 4096;

constexpr int RING_OFF = 0, RING_BYTES = 131072;
constexpr int LDSCTL_OFF = RING_BYTES, MISC_OFF = LDSCTL_OFF + 320;
constexpr int LDS_BYTES = 147456;

__device__ __forceinline__ float bf2f(unsigned short b) { return __uint_as_float((unsigned)b << 16); }
__device__ __forceinline__ float bflo(unsigned w) { return __uint_as_float(w << 16); }
__device__ __forceinline__ float bfhi(unsigned w) { return __uint_as_float(w & 0xffff0000u); }
__device__ __forceinline__ float wave_sum(float v) {
#pragma unroll
    for (int o = 1; o < 64; o <<= 1) v += __shfl_xor(v, o);
    return v;
}
__device__ __forceinline__ float wave_max(float v) {
#pragma unroll
    for (int o = 1; o < 64; o <<= 1) v = fmaxf(v, __shfl_xor(v, o));
    return v;
}

__device__ __forceinline__ void p0_transpose_item(const float* W, int K, int N, bf16* WT, int ldk, int koff, int row_off, const float* gk, LAS float* scr, int item, int lane) {
    const int nblk = N / 32, kb = item / nblk, nb = item % nblk, k0 = 64 * kb, n0 = 32 * nb;
#pragma unroll 8
    for (int i = 0; i < 32; ++i) { const int kk = 2 * i + (lane >> 5); float w = W[(size_t)(k0 + kk) * N + n0 + (lane & 31)]; if (gk) w *= gk[k0 + kk]; scr[kk * 33 + (lane & 31)] = w; }
    LDS_WAIT(); asm volatile("" ::: "memory");
    const int c = lane & 7;
#pragma unroll
    for (int j = 0; j < 4; ++j) { const int n = (lane >> 3) + 8 * j; const LAS float* s = scr + (8 * c) * 33 + n;
        v4u o; o.x = pk2(s[0 * 33], s[1 * 33]); o.y = pk2(s[2 * 33], s[3 * 33]); o.z = pk2(s[4 * 33], s[5 * 33]); o.w = pk2(s[6 * 33], s[7 * 33]);
        *(GAS v4u*)(WT + (size_t)(row_off + n0 + n) * ldk + koff + k0 + 8 * c) = o; }
    LDS_WAIT(); asm volatile("" ::: "memory");
}
__device__ __forceinline__ void rms_row_to_bf16(const float* xrow, const float* g, bf16* orow, int lane) {
    const GAS f32x4* xr = (const GAS f32x4*)xrow + lane; const GAS f32x4* gr = (const GAS f32x4*)g + lane;
    f32x4 v[8]; float s = 0.f;
#pragma unroll
    for (int j = 0; j < 8; ++j) { v[j] = xr[64 * j]; s += (v[j].x * v[j].x + v[j].y * v[j].y) + (v[j].z * v[j].z + v[j].w * v[j].w); }
    const float rstd = 1.f / sqrtf(wave_sum(s) * (1.f / DM) + EPS);
    GAS unsigned long long* o8 = (GAS unsigned long long*)orow + lane;
#pragma unroll
    for (int j = 0; j < 8; ++j) { const f32x4 gg = gr[64 * j];
        o8[64 * j] = (unsigned long long)pk2(v[j].x * rstd * gg.x, v[j].y * rstd * gg.y) | ((unsigned long long)pk2(v[j].z * rstd * gg.z, v[j].w * rstd * gg.w) << 32); }
}
__device__ __forceinline__ float row_rstd(const float* xrow, int lane) {
    const GAS f32x4* xr = (const GAS f32x4*)xrow + lane; float s = 0.f;
#pragma unroll
    for (int j = 0; j < 8; ++j) { const f32x4 v = xr[64 * j]; s += (v.x * v.x + v.y * v.y) + (v.z * v.z + v.w * v.w); }
    return 1.f / sqrtf(wave_sum(s) * (1.f / DM) + EPS);
}

__device__ const float ROPE_INV_FREQ[16] = {1.f, 0.440366596f, 0.193922743f, 0.0853971019f, 0.0376060307f, 0.016560439f, 0.00729266461f, 0.00321144587f, 0.00141421356f, 0.000622772379f, 0.000274248188f, 0.000120769735f, 5.3182961e-05f, 2.34199997e-05f, 1.03133862e-05f, 4.54167048e-06f};
struct Args { const float* in[17]; float* out; unsigned char* ws; int ph_lo, ph_hi, li, pad; };

__device__ __forceinline__ void naive_moba_item(int b, int h, int i, const bf16* QP, const bf16* KP, const bf16* VP, const float2* ROPE, const float* KMEAN, bf16* AO, int lane) {
    const size_t t = (size_t)b * SEQ + i; const int qb = i >> 8;
    float q[128];
    { const v4u* qp = (const v4u*)(QP + t * AW + h * HD);
#pragma unroll
      for (int c = 0; c < 16; ++c) { const v4u w = qp[c]; q[8 * c + 0] = bflo(w.x); q[8 * c + 1] = bfhi(w.x); q[8 * c + 2] = bflo(w.y); q[8 * c + 3] = bfhi(w.y); q[8 * c + 4] = bflo(w.z); q[8 * c + 5] = bfhi(w.z); q[8 * c + 6] = bflo(w.w); q[8 * c + 7] = bfhi(w.w); } }
#pragma unroll
    for (int d = 0; d < 16; ++d) { const float2 cs = ROPE[i * 16 + d]; const float q1 = q[d], q2 = q[d + 16]; q[d] = q1 * cs.x - q2 * cs.y; q[d + 16] = q2 * cs.x + q1 * cs.y; }
    float g = -INFINITY;
    if (lane < qb) { const f32x4* km = (const f32x4*)(KMEAN + ((size_t)(b * NH + h) * NBLK + lane) * HD); float a = 0.f;
#pragma unroll
        for (int c = 0; c < 32; ++c) { const f32x4 k4 = km[c]; a += q[4 * c] * k4.x + q[4 * c + 1] * k4.y + q[4 * c + 2] * k4.z + q[4 * c + 3] * k4.w; }
        g = a; }
    unsigned selmask = 0u;
#pragma unroll
    for (int k = 0; k < TOPK; ++k) { const float mx = wave_max(g);
        if (mx != -INFINITY) { const unsigned long long bal = __ballot(g == mx); const int idx = __ffsll((long long)bal) - 1; selmask |= 1u << idx; if (lane == idx) g = -INFINITY; } }
    selmask |= 1u << qb;
    float s[4][4]; int blk[4]; bool valid[4];
#pragma unroll
    for (int c = 0; c < 4; ++c) { valid[c] = selmask != 0u; blk[c] = valid[c] ? (__ffs((int)selmask) - 1) : 0; selmask &= selmask - 1u; }
    float mloc = -INFINITY;
#pragma unroll
    for (int c = 0; c < 4; ++c)
#pragma unroll
        for (int r = 0; r < 4; ++r) { const int key = blk[c] * MBLK + lane + 64 * r; float sc = -INFINITY;
            if (valid[c] && key <= i) { const v4u* kp = (const v4u*)(KP + ((size_t)b * SEQ + key) * AW + h * HD); float kk[32]; float a = 0.f;
#pragma unroll
                for (int cc = 0; cc < 4; ++cc) { const v4u w = kp[cc]; kk[8 * cc + 0] = bflo(w.x); kk[8 * cc + 1] = bfhi(w.x); kk[8 * cc + 2] = bflo(w.y); kk[8 * cc + 3] = bfhi(w.y); kk[8 * cc + 4] = bflo(w.z); kk[8 * cc + 5] = bfhi(w.z); kk[8 * cc + 6] = bflo(w.w); kk[8 * cc + 7] = bfhi(w.w); }
#pragma unroll
                for (int d = 0; d < 16; ++d) { const float2 cs = ROPE[key * 16 + d]; const float k1 = kk[d], k2 = kk[d + 16]; a += q[d] * (k1 * cs.x - k2 * cs.y) + q[d + 16] * (k2 * cs.x + k1 * cs.y); }
#pragma unroll
                for (int cc = 4; cc < 16; ++cc) { const v4u w = kp[cc]; a += q[8 * cc + 0] * bflo(w.x) + q[8 * cc + 1] * bfhi(w.x) + q[8 * cc + 2] * bflo(w.y) + q[8 * cc + 3] * bfhi(w.y) + q[8 * cc + 4] * bflo(w.z) + q[8 * cc + 5] * bfhi(w.z) + q[8 * cc + 6] * bflo(w.w) + q[8 * cc + 7] * bfhi(w.w); }
                sc = a * ATT_SCALE; }
            s[c][r] = sc; mloc = fmaxf(mloc, sc); }
    const float mx = wave_max(mloc); float lsum = 0.f;
#pragma unroll
    for (int c = 0; c < 4; ++c)
#pragma unroll
        for (int r = 0; r < 4; ++r) { s[c][r] = __expf(s[c][r] - mx); lsum += s[c][r]; }
    const float l = wave_sum(lsum);
    float o0 = 0.f, o1 = 0.f;
#pragma unroll
    for (int c = 0; c < 4; ++c) { if (!valid[c]) continue;
#pragma unroll
        for (int r = 0; r < 4; ++r) { const bf16* vp = VP + ((size_t)b * SEQ + blk[c] * MBLK + 64 * r) * AW + h * HD + 2 * lane;
            for (int src = 0; src < 64; ++src) { const float p = __shfl(s[c][r], src); const unsigned w = *(const unsigned*)(vp + (size_t)src * AW); o0 += p * bflo(w); o1 += p * bfhi(w); } } }
    const float rl = 1.f / l;
    *(unsigned*)(AO + t * AW + h * HD + 2 * lane) = pk2(o0 * rl, o1 * rl);
}
__device__ __forceinline__ void naive_xattn_item(int b, int h, int i, const bf16* HQ, const float* R2, const bf16* MKV, bf16* XO, int lane) {
    const size_t t = (size_t)b * SEQ + i; const float qs = R2[t] * ATT_SCALE;
    float q[128];
    { const v4u* qp = (const v4u*)(HQ + t * XW + h * HD);
#pragma unroll
      for (int c = 0; c < 16; ++c) { const v4u w = qp[c]; q[8 * c + 0] = bflo(w.x) * qs; q[8 * c + 1] = bfhi(w.x) * qs; q[8 * c + 2] = bflo(w.y) * qs; q[8 * c + 3] = bfhi(w.y) * qs; q[8 * c + 4] = bflo(w.z) * qs; q[8 * c + 5] = bfhi(w.z) * qs; q[8 * c + 6] = bflo(w.w) * qs; q[8 * c + 7] = bfhi(w.w) * qs; } }
    float s[4]; float mloc = -INFINITY;
#pragma unroll
    for (int r = 0; r < 4; ++r) { const int key = lane + 64 * r; const v4u* kp = (const v4u*)(MKV + ((size_t)b * NMEM + key) * (2 * XW) + h * HD); float a = 0.f;
#pragma unroll
        for (int cc = 0; cc < 16; ++cc) { const v4u w = kp[cc]; a += q[8 * cc + 0] * bflo(w.x) + q[8 * cc + 1] * bfhi(w.x) + q[8 * cc + 2] * bflo(w.y) + q[8 * cc + 3] * bfhi(w.y) + q[8 * cc + 4] * bflo(w.z) + q[8 * cc + 5] * bfhi(w.z) + q[8 * cc + 6] * bflo(w.w) + q[8 * cc + 7] * bfhi(w.w); }
        s[r] = a; mloc = fmaxf(mloc, a); }
    const float mx = wave_max(mloc); float lsum = 0.f;
#pragma unroll
    for (int r = 0; r < 4; ++r) { s[r] = __expf(s[r] - mx); lsum += s[r]; }
    const float l = wave_sum(lsum);
    float o0 = 0.f, o1 = 0.f;
#pragma unroll
    for (int r = 0; r < 4; ++r) { const bf16* vp = MKV + ((size_t)b * NMEM + 64 * r) * (2 * XW) + XW + h * HD + 2 * lane;
        for (int src = 0; src < 64; ++src) { const float p = __shfl(s[r], src); const unsigned w = *(const unsigned*)(vp + (size_t)src * (2 * XW)); o0 += p * bflo(w); o1 += p * bfhi(w); } }
    const float rl = 1.f / l;
    *(unsigned*)(XO + t * XW + h * HD + 2 * lane) = pk2(o0 * rl, o1 * rl);
}

__global__ void __launch_bounds__(NWAVES * 64, 2) mk_fwd(Args args) {
    extern __shared__ __attribute__((aligned(16))) unsigned char lds[];
    LAS unsigned char* const ldsp = (LAS unsigned char*)lds;
    volatile LAS unsigned* const MISC = (volatile LAS unsigned*)(ldsp + MISC_OFF);
    const int tid = threadIdx.x, lane = tid & 63, wave = __builtin_amdgcn_readfirstlane(tid >> 6);
    const int G = gridDim.x; const int bx = blockIdx.x; const int vcu = (G % 8 == 0) ? (bx % 8) * (G / 8) + bx / 8 : bx;
    unsigned char* const ws = args.ws;
    gu32* const ctl = (gu32*)(ws + WS_CTL);
    for (int u = tid; u < (LDS_BYTES - LDSCTL_OFF) / 4; u += NWAVES * 64) ((LAS unsigned*)(ldsp + LDSCTL_OFF))[u] = 0u;
    __syncthreads();
    XcdBarrier bar; bar.bar = (unsigned*)(ctl + CW_BAR); bar.x = 0; bar.st = nullptr;
    if (!MK_PER_PHASE) bar = xcd_barrier_post((unsigned*)(ctl + CW_BAR), MISC + 8);
    const int lo = args.ph_lo, hi = args.ph_hi;
#define IN(k) (lo <= (k) && (k) < hi)
#define SEAM(k) do { if (IN(k) && IN((k) + 1)) xcd_barrier(bar); } while (0)
    const int gw = vcu * NWAVES + wave, NGW = G * NWAVES;
    const int gt = vcu * (NWAVES * 64) + tid, NGT = G * NWAVES * 64;

#define x_in (args.in[0])
#define mem_in (args.in[1])
#define norm_mix (args.in[2])
#define w_in (args.in[3])
#define conv_w (args.in[4])
#define w_attn_out (args.in[5])
#define w_conv_out (args.in[6])
#define w_mix_out (args.in[7])
#define norm_xattn (args.in[8])
#define norm_mem (args.in[9])
#define wq_x (args.in[10])
#define wkv_x (args.in[11])
#define wo_x (args.in[12])
#define norm_mlp (args.in[13])
#define w_up (args.in[14])
#define w_down (args.in[15])
#define norm_final (args.in[16])
    float* const out = args.out; unsigned char* const outb = (unsigned char*)args.out;
#define ROPE ((float2*)(ws + WS_ROPE))
#define KMEAN ((float*)(ws + WS_KMEAN))
#define SS1 ((unsigned long long*)(ws + WS_SS1))
#define SS2 ((unsigned long long*)(ws + WS_SS2))
#define SS3 ((unsigned long long*)(ws + WS_SS3))
#define MEMN ((bf16*)(ws + WS_MEMN))
#define MKV ((bf16*)(ws + WS_MKV))
#define WIN ((bf16*)(ws + WS_WIN))
#define WA ((bf16*)(ws + WS_WA))
#define WC ((bf16*)(ws + WS_WC))
#define WM ((bf16*)(ws + WS_WM))
#define WQ ((bf16*)(ws + WS_WQ))
#define WKV ((bf16*)(ws + WS_WKV))
#define WO ((bf16*)(ws + WS_WO))
#define WUP ((bf16*)(ws + WS_WUP))
#define WD ((bf16*)(ws + WS_WD))
#define XB ((bf16*)(ws + WS_XB))
#define QP ((bf16*)(ws + WS_G))
#define KP ((bf16*)(ws + WS_G + GRP))
#define VP ((bf16*)(ws + WS_G + 2 * GRP))
#define CX ((bf16*)(ws + WS_G + 3 * GRP))
#define CB ((bf16*)(ws + WS_G + 4 * GRP))
#define CC ((bf16*)(ws + WS_G + 5 * GRP))
#define GA ((bf16*)(ws + WS_G + 6 * GRP))
#define GC ((bf16*)(outb + DO_GC))
#define AO ((bf16*)(outb + DO_AO))
#define CO ((bf16*)(outb + DO_CO))
#define YA ((bf16*)(ws + WS_YA))
#define YC ((bf16*)(ws + WS_YC))
#define MERGED ((bf16*)(ws + WS_MERGED))
#define HQ ((bf16*)(ws + WS_HQ))
#define XO ((bf16*)(ws + WS_XO))
#define UP ((bf16*)(ws + WS_UP))
    if (IN(0)) {
        LAS float* scr = (LAS float*)(ldsp + RING_OFF + wave * 16384);
        constexpr int I_IN = (DM / 64) * (NPROJ / 32), I_A = (AW / 64) * (DM / 32), I_C = I_A, I_M = (DM / 64) * (DM / 32), I_Q = (DM / 64) * (XW / 32), I_KV = (DM / 64) * (2 * XW / 32),
                      I_O = (XW / 64) * (DM / 32), I_UP = (DM / 64) * (DFF / 32), I_D = (DFF / 64) * (DM / 32);
        constexpr int NITEMS = I_IN + I_A + I_C + I_M + I_Q + I_KV + I_O + I_UP + I_D;
        for (int it = gw; it < NITEMS; it += NGW) {
            int r = it;
            if (r < I_IN) { p0_transpose_item(w_in, DM, NPROJ, WIN, DM, 0, 0, nullptr, scr, r, lane); continue; } r -= I_IN;
            if (r < I_A) { p0_transpose_item(w_attn_out, AW, DM, WA, AW, 0, 0, nullptr, scr, r, lane); continue; } r -= I_A;
            if (r < I_C) { p0_transpose_item(w_conv_out, CWID, DM, WC, CWID, 0, 0, nullptr, scr, r, lane); continue; } r -= I_C;
            if (r < I_M) { p0_transpose_item(w_mix_out, DM, DM, WM, DM, 0, 0, nullptr, scr, r, lane); continue; } r -= I_M;
            if (r < I_Q) { p0_transpose_item(wq_x, DM, XW, WQ, DM, 0, 0, norm_xattn, scr, r, lane); continue; } r -= I_Q;
            if (r < I_KV) { p0_transpose_item(wkv_x, DM, 2 * XW, WKV, DM, 0, 0, nullptr, scr, r, lane); continue; } r -= I_KV;
            if (r < I_O) { p0_transpose_item(wo_x, XW, DM, WO, XW, 0, 0, nullptr, scr, r, lane); continue; } r -= I_O;
            if (r < I_UP) { p0_transpose_item(w_up, DM, DFF, WUP, DM, 0, 0, norm_mlp, scr, r, lane); continue; } r -= I_UP;
            p0_transpose_item(w_down, DFF, DM, WD, DFF, 0, 0, nullptr, scr, r, lane);
        }
        for (int m = gw; m < M; m += NGW) rms_row_to_bf16(x_in + (size_t)m * DM, norm_mix, XB + (size_t)m * DM, lane);
        for (int m = gw; m < NB * NMEM; m += NGW) rms_row_to_bf16(mem_in + (size_t)m * DM, norm_mem, MEMN + (size_t)m * DM, lane);
        for (int e = gt; e < 3 * M; e += NGT) SS1[e] = 0ull;
        for (int e = gt; e < SEQ * 16; e += NGT) { const int pos = e >> 4, j = e & 15;
            const float inv_freq = ROPE_INV_FREQ[j]; const float ang = (float)pos * inv_freq;
            const double turns = (double)ang * 0.15915494309189535; const float fr = (float)(turns - rint(turns));
            ROPE[e] = make_float2(__builtin_amdgcn_cosf(fr), __builtin_amdgcn_sinf(fr)); }
    }
    SEAM(0);
    if (IN(1)) {
        { pg8::Gemm g{XB, WIN, M, NPROJ, DM}; pg8::StaticOrder S; S.init(M, NPROJ, G, bx);
          pg8::EpiBf16G E{QP, GC, 8, (size_t)M * 1024, 1024, 1024, nullptr};
          pg8::gemm_phase<pg8::EpiBf16G, pg8::StaticOrder, true, true>(ldsp + RING_OFF, g, S, E); }
        { pg8::Gemm g{MEMN, WKV, NB * NMEM, 2 * XW, DM}; pg8::StaticOrder S; S.init(NB * NMEM, 2 * XW, G, bx);
          pg8::EpiBf16G E{MKV, MKV, 1 << 30, 0, 1 << 30, 2 * XW, nullptr};
          pg8::gemm_phase<pg8::EpiBf16G, pg8::StaticOrder, true, true>(ldsp + RING_OFF, g, S, E); }
    }
    SEAM(1);
    if (IN(2)) {
        for (int e = gt; e < M * NH * 16; e += NGT) { const int d = e & 15, h = (e >> 4) & 7, t = e >> 7, pos = t & (SEQ - 1); const float2 cs = ROPE[pos * 16 + d];
            bf16* qp = QP + (size_t)t * AW + h * HD + d; bf16* kp = KP + (size_t)t * AW + h * HD + d;
            const float q1 = bf2f(qp[0]), q2 = bf2f(qp[16]), k1 = bf2f(kp[0]), k2 = bf2f(kp[16]);
            qp[0] = (bf16)f2bf(q1 * cs.x - q2 * cs.y); qp[16] = (bf16)f2bf(q2 * cs.x + q1 * cs.y);
            kp[0] = (bf16)f2bf(k1 * cs.x - k2 * cs.y); kp[16] = (bf16)f2bf(k2 * cs.x + k1 * cs.y); }
    }
    SEAM(2);
    if (IN(3)) {
        for (int e = gt; e < NB * NH * NBLK * HD; e += NGT) { const int d = e & 127, n = (e >> 7) & 31, h = (e >> 12) & 7, b = e >> 15; float a = 0.f;
            const bf16* kp = KP + ((size_t)b * SEQ + (size_t)n * MBLK) * AW + h * HD + d;
            for (int j = 0; j < MBLK; ++j) a += bf2f(kp[(size_t)j * AW]);
            KMEAN[e] = a * (1.f / MBLK); }
    }
    SEAM(3);
    if (IN(4)) {
        { att::Seam S; char* albase = (char*)lds + RING_OFF; unsigned* selw = (unsigned*)(albase + att::LDS_SEL); constexpr int NIT = NB * NH * 16; constexpr long VOFF = (long)(GRP / 2);
          for (int L = vcu; L < NIT; L += G) { int tv = threadIdx.x; asm volatile("" : "+v"(tv)); const int bh = L >> 4, b = bh >> 3, h = bh & 7, s = L & 15;
              const bf16* Kp = KP + (size_t)b * SEQ * AW + h * HD; const float* KM = KMEAN + (size_t)bh * NBLK * HD;
              const bf16* Q0 = QP + ((size_t)b * SEQ + (size_t)s * 256) * AW + h * HD; const bf16* Q1 = QP + ((size_t)b * SEQ + (size_t)(31 - s) * 256) * AW + h * HD;
              att::moba_gate<AW>(tv, Q0, KM, s, selw); att::moba_gate<AW>(tv, Q1, KM, 31 - s, selw + 256);
              att::attn_prime<AW, AW, VOFF>(tv, Q0, Kp, albase, S);
              for (int pass = 0; pass < 2; ++pass) { const int qb = pass ? 31 - s : s;
                  bf16* Op = AO + ((size_t)b * SEQ + (size_t)qb * 256) * AW + h * HD;
                  att::attn_block<true, AW, AW, VOFF, AW>(tv, Kp, Op, 4 * (qb + 1), pass * 256, Q1, Kp, albase, S); } } }
        for (int e = gt; e < M * (CWID / 2); e += NGT) { const int c2 = e & 511; const int t = e >> 9; const int s = t & (SEQ - 1); const int c = 2 * c2;
            const unsigned x0 = *(const unsigned*)(CX + (size_t)t * CWID + c), c0 = *(const unsigned*)(CC + (size_t)t * CWID + c);
            float y0 = conv_w[2 * CWID + c] * (bflo(x0) * bflo(c0)), y1 = conv_w[2 * CWID + c + 1] * (bfhi(x0) * bfhi(c0));
            if (s >= 1) { const unsigned x1 = *(const unsigned*)(CX + (size_t)(t - 1) * CWID + c), c1 = *(const unsigned*)(CC + (size_t)(t - 1) * CWID + c);
                y0 += conv_w[CWID + c] * (bflo(x1) * bflo(c1)); y1 += conv_w[CWID + c + 1] * (bfhi(x1) * bfhi(c1)); }
            if (s >= 2) { const unsigned x2 = *(const unsigned*)(CX + (size_t)(t - 2) * CWID + c), c2v = *(const unsigned*)(CC + (size_t)(t - 2) * CWID + c);
                y0 += conv_w[c] * (bflo(x2) * bflo(c2v)); y1 += conv_w[c + 1] * (bfhi(x2) * bfhi(c2v)); }
            const unsigned b0 = *(const unsigned*)(CB + (size_t)t * CWID + c);
            *(unsigned*)(CO + (size_t)t * CWID + c) = pk2(bflo(b0) * y0, bfhi(b0) * y1); }
    }
    SEAM(4);
    if (IN(5)) {
        { pg8::Gemm g{AO, WA, M, DM, AW}; pg8::StaticOrder S; S.init(M, DM, G, bx); pg8::EpiBf16G E{YA, YA, 1 << 30, 0, 1 << 30, DM, nullptr};
          pg8::gemm_phase<pg8::EpiBf16G, pg8::StaticOrder, true, true>(ldsp + RING_OFF, g, S, E); }
        { pg8::Gemm g{CO, WC, M, DM, CWID}; pg8::StaticOrder S; S.init(M, DM, G, bx); pg8::EpiBf16G E{YC, YC, 1 << 30, 0, 1 << 30, DM, nullptr};
          pg8::gemm_phase<pg8::EpiBf16G, pg8::StaticOrder, true, true>(ldsp + RING_OFF, g, S, E); }
    }
    SEAM(5);
    if (IN(6)) {
        for (int e = gt; e < M * (DM / 2); e += NGT) { const int c2 = e & 1023; const int t = e >> 10; const int c = 2 * c2; const int gi = c >> 10, cc = c & 1023;
            const unsigned a = *(const unsigned*)(GA + (size_t)gi * M * 1024 + (size_t)t * 1024 + cc), cg = *(const unsigned*)(GC + (size_t)gi * M * 1024 + (size_t)t * 1024 + cc);
            const unsigned ya = *(const unsigned*)(YA + (size_t)t * DM + c), yc = *(const unsigned*)(YC + (size_t)t * DM + c);
            const float s0 = 1.f / (1.f + __expf(-bflo(a))), s1 = 1.f / (1.f + __expf(-bfhi(a))), u0 = 1.f / (1.f + __expf(-bflo(cg))), u1 = 1.f / (1.f + __expf(-bfhi(cg)));
            *(unsigned*)(MERGED + (size_t)t * DM + c) = pk2(s0 * bflo(ya) + u0 * bflo(yc), s1 * bfhi(ya) + u1 * bfhi(yc)); }
    }
    SEAM(6);
    if (IN(7)) {
        pg8::Gemm g{MERGED, WM, M, DM, DM}; pg8::StaticOrder S; S.init(M, DM, G, bx); pg8::EpiResid E{x_in, out, XB, DM, SS1};
        pg8::gemm_phase<pg8::EpiResid, pg8::StaticOrder, true, true>(ldsp + RING_OFF, g, S, E);
    }
    SEAM(7);
    if (IN(8)) {
        pg8::Gemm g{XB, WQ, M, XW, DM}; pg8::StaticOrder S; S.init(M, XW, G, bx); pg8::EpiBf16G E{HQ, HQ, 1 << 30, 0, 1 << 30, XW, SS1};
        pg8::gemm_phase<pg8::EpiBf16G, pg8::StaticOrder, true, true>(ldsp + RING_OFF, g, S, E);
    }
    SEAM(8);
    if (IN(9)) {
        att::Seam S; char* albase = (char*)lds + RING_OFF; constexpr int NIT = NB * XH * 32;
        for (int L = vcu; L < NIT; L += G) { int tv = threadIdx.x; asm volatile("" : "+v"(tv)); const int bh = L >> 5, b = bh >> 2, h = bh & 3, qb = L & 31;
            const bf16* Qp = HQ + ((size_t)b * SEQ + (size_t)qb * 256) * XW + h * HD; const bf16* Kp = MKV + (size_t)b * NMEM * (2 * XW) + h * HD;
            bf16* Op = XO + ((size_t)b * SEQ + (size_t)qb * 256) * XW + h * HD;
            att::attn_prime<XW, 2 * XW, (long)XW>(tv, Qp, Kp, albase, S);
            att::attn_block<false, XW, 2 * XW, (long)XW, XW>(tv, Kp, Op, NMEM / 64, 0, Qp, Kp, albase, S); }
    }
    SEAM(9);
    if (IN(10)) {
        pg8::Gemm g{XO, WO, M, DM, XW}; pg8::StaticOrder S; S.init(M, DM, G, bx); pg8::EpiResid E{out, out, XB, DM, SS2};
        pg8::gemm_phase<pg8::EpiResid, pg8::StaticOrder, true, true>(ldsp + RING_OFF, g, S, E);
    }
    SEAM(10);
    if (IN(11)) {
        pg8::Gemm g{XB, WUP, M, DFF, DM}; pg8::StaticOrder S; S.init(M, DFF, G, bx); pg8::EpiUp E{UP, DFF, SS2};
        pg8::gemm_phase<pg8::EpiUp, pg8::StaticOrder, true, true>(ldsp + RING_OFF, g, S, E);
    }
    SEAM(11);
    if (IN(12)) {
        pg8::Gemm g{UP, WD, M, DM, DFF}; pg8::StaticOrder S; S.init(M, DM, G, bx); pg8::EpiResid E{out, out, nullptr, DM, SS3};
        pg8::gemm_phase<pg8::EpiResid, pg8::StaticOrder, true, true>(ldsp + RING_OFF, g, S, E);
    }
    SEAM(12);
    if (IN(13)) {
        for (int m = gw; m < M; m += NGW) { GAS f32x4* xr = (GAS f32x4*)(out + (size_t)m * DM) + lane; const GAS f32x4* gr = (const GAS f32x4*)norm_final + lane;
            const float rstd = pg8::rstd_from_ss(SS3, m);
#pragma unroll
            for (int j = 0; j < 8; ++j) { const f32x4 v = xr[64 * j]; const f32x4 gg = gr[64 * j]; xr[64 * j] = (f32x4){v.x * rstd * gg.x, v.y * rstd * gg.y, v.z * rstd * gg.z, v.w * rstd * gg.w}; } }
    }
#undef IN
#undef SEAM
}
#undef x_in
#undef mem_in


extern "C" void kernel_launch(void* const* d_in, const int* in_sizes, int n_in, void* d_out, int out_size, void* d_ws, size_t ws_size, hipStream_t stream) {
    static int grid = 0;
    if (grid == 0) {
        if (n_in != 17 || in_sizes[0] != M * DM || out_size != M * DM || ws_size < WS_END) { fprintf(stderr, "kernel_launch: unexpected shapes: n_in %d in0 %d out %d ws %zu (need %zu)\n", n_in, n_in > 0 ? in_sizes[0] : -1, out_size, ws_size, (size_t)WS_END); grid = -1; return; }
        int dev = 0, cus = 0, per_cu = 0;
        if (hipGetDevice(&dev) != hipSuccess || hipDeviceGetAttribute(&cus, hipDeviceAttributeMultiprocessorCount, dev) != hipSuccess) { fprintf(stderr, "kernel_launch: device query failed\n"); grid = -1; return; }
        if (hipFuncSetAttribute((const void*)mk_fwd, hipFuncAttributeMaxDynamicSharedMemorySize, LDS_BYTES) != hipSuccess) { fprintf(stderr, "kernel_launch: hipFuncSetAttribute failed\n"); grid = -1; return; }
        if (hipOccupancyMaxActiveBlocksPerMultiprocessor(&per_cu, (const void*)mk_fwd, NWAVES * 64, LDS_BYTES) != hipSuccess || per_cu < 1) fprintf(stderr, "kernel_launch: note: occupancy query reports %d workgroups per CU\n", per_cu);
        (void)hipGetLastError();
        grid = cus;
    }
    if (grid < 0) return;
    if (hipMemsetAsync((char*)d_ws + WS_CTL, 0, CTL_ZERO_BYTES, stream) != hipSuccess) { fprintf(stderr, "kernel_launch: hipMemsetAsync failed\n"); return; }
    Args a{};
    for (int i = 0; i < 17; ++i) a.in[i] = (const float*)d_in[i];
    a.out = (float*)d_out; a.ws = (unsigned char*)d_ws;
#if MK_PER_PHASE
    for (int p = 0; p < N_PHASES; ++p) { a.ph_lo = p; a.ph_hi = p + 1; a.li = p; hipLaunchKernelGGL(mk_fwd, dim3(grid), dim3(NWAVES * 64), LDS_BYTES, stream, a); }
#else
    a.ph_lo = 0; a.ph_hi = N_PHASES; a.li = 0;
    hipLaunchKernelGGL(mk_fwd, dim3(grid), dim3(NWAVES * 64), LDS_BYTES, stream, a);
#endif
    const hipError_t le = hipPeekAtLastError();
    if (le != hipSuccess) fprintf(stderr, "kernel_launch: launch failed: %s\n", hipGetErrorName(le));
}
```

```cpp
#include <hip/hip_runtime.h>
#include <cstdio>
#include <cstdint>
namespace pg8 {
#define PG8_LAS __attribute__((address_space(3)))
typedef unsigned short bf16_t;
typedef short bf16x8 __attribute__((ext_vector_type(8)));
typedef float f32x4 __attribute__((ext_vector_type(4)));
typedef unsigned u32x4 __attribute__((ext_vector_type(4)));
constexpr int BM = 256, BK = 64, HALF = 128, HTB = HALF * BK * 2  , STAGE_BYTES = 8 * HTB, NXCD = 8, WGM = 8;

__host__ __device__ __forceinline__ int lds_byte(int r, int c) { const int st = (r >> 4) * 2 + (c >> 5), rr = r & 15, cc = c & 31, ob = rr * 64 + cc * 2; return st * 1024 + (ob ^ (((ob >> 9) & 1) << 5)); }
__host__ __device__ __forceinline__ void stage_rc(int b, int& R, int& C) { const int st = b / 1024, sb = b % 1024, swz = sb ^ (((sb >> 9) & 1) << 5); R = (st >> 1) * 16 + swz / 64; C = (st & 1) * 32 + (swz % 64) / 2; }
__host__ __device__ __forceinline__ int perm32(int rho) { const int n = rho >> 4, i = rho & 15; return 8 * (i >> 2) + 4 * n + (i & 3); }

struct Unit { int pm, pn; };
struct Gemm { const bf16_t* A; const bf16_t* Bt; int M, N, K; };

struct StaticOrder {
    int nM, nN, nwg, G, c;
    __host__ __device__ void init(int M, int N, int G_, int c_) { nM = M / BM; nN = N / BM; nwg = nM * nN; G = G_; c = c_; }
    __host__ __device__ bool next(int i, Unit& u) const {
        const long L = (long)i * G + c; if (L >= nwg) return false;
        int wgid = (int)L; { const int q = nwg / NXCD, r = nwg % NXCD, xcd = wgid % NXCD, off = wgid / NXCD; wgid = (xcd < r ? xcd * (q + 1) : r * (q + 1) + (xcd - r) * q) + off; }
        const int nig = WGM * nN, gid = wgid / nig, fm = gid * WGM, gsz = (nM - fm) < WGM ? (nM - fm) : WGM;
        u.pm = fm + ((wgid % nig) % gsz); u.pn = (wgid % nig) / gsz; return true;
    }
    __device__ __forceinline__ void a_ready(const Unit&) const {}
    __device__ __forceinline__ void done(const Unit&) const {}
};


__device__ __forceinline__ unsigned cvt_pk_bf16(float lo, float hi) { unsigned r; asm volatile("v_cvt_pk_bf16_f32 %0, %1, %2" : "=v"(r) : "v"(lo), "v"(hi)); return r; }
typedef unsigned u32x2 __attribute__((ext_vector_type(2)));

constexpr float SS_SCALE = 16777216.f, SS_INV = 1.f / (16777216.f * 2048.f), RMS_EPS = 1e-6f;
__device__ __forceinline__ float rstd_from_ss(const unsigned long long* ss, int row) { return 1.f / sqrtf((float)ss[row] * SS_INV + RMS_EPS); }
struct EpiBf16G {
    static constexpr bool PERM = true, AFTER_DRAIN = false, MIDK = false;
    bf16_t* g0; bf16_t* g1; int tsplit; size_t gstride; int gcols; int ldc; const unsigned long long* ss;
    __device__ __forceinline__ void operator()(const f32x4 (&acc)[2][2][4][2], const Unit& u, int wr, int wc, int fr, int fq) const {
        const int row0 = u.pm * BM + wr * 64 + fr; int colt = u.pn * BM; const int t = colt / gcols; colt -= t * gcols;
        bf16_t* base = (t < tsplit) ? g0 + (size_t)t * gstride : g1 + (size_t)(t - tsplit) * gstride;
        const int col0 = colt + wc * 32 + 8 * fq;
#pragma unroll
        for (int ai = 0; ai < 2; ++ai)
#pragma unroll
            for (int m = 0; m < 4; ++m) { bf16_t* rowp = base + (size_t)(row0 + ai * HALF + m * 16) * ldc + col0; const float s = ss ? rstd_from_ss(ss, row0 + ai * HALF + m * 16) : 1.f;
#pragma unroll
                for (int bj = 0; bj < 2; ++bj) { const f32x4 v0 = acc[ai][bj][m][0] * s, v1 = acc[ai][bj][m][1] * s;
                    u32x4 w; w.x = cvt_pk_bf16(v0[0], v0[1]); w.y = cvt_pk_bf16(v0[2], v0[3]); w.z = cvt_pk_bf16(v1[0], v1[1]); w.w = cvt_pk_bf16(v1[2], v1[3]);
                    *(u32x4*)(rowp + bj * HALF) = w; } }
    }
};
struct EpiResid {
    static constexpr bool PERM = false, AFTER_DRAIN = false, MIDK = false;
    const float* base; float* out; bf16_t* outb; int ldc; unsigned long long* ss;
    __device__ __forceinline__ void operator()(const f32x4 (&acc)[2][2][4][2], const Unit& u, int wr, int wc, int fr, int fq) const {
        const int row0 = u.pm * BM + wr * 64 + fr, col0 = u.pn * BM + wc * 32 + 4 * fq;
#pragma unroll
        for (int ai = 0; ai < 2; ++ai)
#pragma unroll
            for (int m = 0; m < 4; ++m) { const size_t off = (size_t)(row0 + ai * HALF + m * 16) * ldc + col0; float sq = 0.f;
#pragma unroll
                for (int bj = 0; bj < 2; ++bj)
#pragma unroll
                    for (int n = 0; n < 2; ++n) { const f32x4 o = *(const f32x4*)(base + off + bj * HALF + n * 16) + acc[ai][bj][m][n];
                        *(f32x4*)(out + off + bj * HALF + n * 16) = o; sq += (o[0] * o[0] + o[1] * o[1]) + (o[2] * o[2] + o[3] * o[3]);
                        if (outb) { u32x2 w; w.x = cvt_pk_bf16(o[0], o[1]); w.y = cvt_pk_bf16(o[2], o[3]); *(u32x2*)(outb + off + bj * HALF + n * 16) = w; } }
                if (ss) { sq += __shfl_xor(sq, 16); sq += __shfl_xor(sq, 32);
                    if (fq == 0) __hip_atomic_fetch_add(ss + row0 + ai * HALF + m * 16, (unsigned long long)__float2ull_rn(sq * SS_SCALE), __ATOMIC_RELAXED, __HIP_MEMORY_SCOPE_AGENT); }
                if (m & 1) asm volatile("" ::: "memory"); }
    }
};
struct EpiUp {
    static constexpr bool PERM = true, AFTER_DRAIN = false, MIDK = false;
    bf16_t* O; int ldc; const unsigned long long* ss;
    __device__ __forceinline__ void operator()(const f32x4 (&acc)[2][2][4][2], const Unit& u, int wr, int wc, int fr, int fq) const {
        const int row0 = u.pm * BM + wr * 64 + fr, col0 = u.pn * BM + wc * 32 + 8 * fq;
#pragma unroll
        for (int ai = 0; ai < 2; ++ai)
#pragma unroll
            for (int m = 0; m < 4; ++m) { const int r = row0 + ai * HALF + m * 16; const float s = rstd_from_ss(ss, r); bf16_t* rowp = O + (size_t)r * ldc + col0;
#pragma unroll
                for (int bj = 0; bj < 2; ++bj) { f32x4 v0 = acc[ai][bj][m][0] * s, v1 = acc[ai][bj][m][1] * s;
#pragma unroll
                    for (int e = 0; e < 4; ++e) { v0[e] = fmaxf(v0[e], 0.f); v1[e] = fmaxf(v1[e], 0.f); }
                    v0 = v0 * v0; v1 = v1 * v1;
                    u32x4 w; w.x = cvt_pk_bf16(v0[0], v0[1]); w.y = cvt_pk_bf16(v0[2], v0[3]); w.z = cvt_pk_bf16(v1[0], v1[1]); w.w = cvt_pk_bf16(v1[2], v1[3]);
                    *(u32x4*)(rowp + bj * HALF) = w; } }
    }
};


__device__ __forceinline__ float bf_lo(unsigned w) { return __uint_as_float(w << 16); }
__device__ __forceinline__ float bf_hi(unsigned w) { return __uint_as_float(w & 0xffff0000u); }
typedef float f32x2p __attribute__((ext_vector_type(2)));
struct EpiProj {
    static constexpr bool PERM = true, AFTER_DRAIN = false, MIDK = false;
    bf16_t* QKV; size_t gstr; bf16_t* U; bf16_t* CBo; bf16_t* RATIO; bf16_t* SC; const float* rope; float* ksum;
    __device__ __forceinline__ void operator()(const f32x4 (&acc)[2][2][4][2], const Unit& u, int wr, int wc, int fr, int fq) const {
        asm volatile("" : "+v"(fr), "+v"(fq));
        const int pn = u.pn; const int row0 = u.pm * BM + wr * 64 + fr;
        if (pn < 12) {
            const int grp = pn >> 2; bf16_t* base = QKV + (size_t)grp * gstr; const int col0 = (pn & 3) * BM + wc * 32 + 8 * fq;
            const bool rope_wave = (grp < 2) && (wc == 0);
            const float sg = (fq < 2) ? -1.f : 1.f;
            f32x4 ks[2][2];
#pragma unroll
            for (int bj = 0; bj < 2; ++bj)
#pragma unroll
                for (int n = 0; n < 2; ++n) ks[bj][n] = (f32x4){0.f, 0.f, 0.f, 0.f};
#pragma unroll
            for (int ai = 0; ai < 2; ++ai)
#pragma unroll
                for (int m = 0; m < 4; ++m) { const int r = row0 + ai * HALF + m * 16; bf16_t* rowp = base + (size_t)r * 1024 + col0;
                    f32x4 t0 = {1.f, 0.f, 1.f, 0.f}, t1 = t0, t2 = t0, t3 = t0;
                    if (rope_wave) { const f32x4* rp = (const f32x4*)(rope + ((size_t)(r & 8191) * 16 + 8 * (fq & 1)) * 2); t0 = rp[0]; t1 = rp[1]; t2 = rp[2]; t3 = rp[3]; }
#pragma unroll
                    for (int bj = 0; bj < 2; ++bj) { f32x4 v0 = acc[ai][bj][m][0], v1 = acc[ai][bj][m][1];
                        if (rope_wave) { f32x4 p0, p1;
#pragma unroll
                            for (int e2 = 0; e2 < 4; ++e2) { p0[e2] = __shfl_xor(v0[e2], 32); p1[e2] = __shfl_xor(v1[e2], 32); }
                            v0 = (f32x4){v0[0] * t0[0] + sg * p0[0] * t0[1], v0[1] * t0[2] + sg * p0[1] * t0[3], v0[2] * t1[0] + sg * p0[2] * t1[1], v0[3] * t1[2] + sg * p0[3] * t1[3]};
                            v1 = (f32x4){v1[0] * t2[0] + sg * p1[0] * t2[1], v1[1] * t2[2] + sg * p1[1] * t2[3], v1[2] * t3[0] + sg * p1[2] * t3[1], v1[3] * t3[2] + sg * p1[3] * t3[3]}; }
                        if (grp == 1) { ks[bj][0] += v0; ks[bj][1] += v1; }
                        u32x4 w; w.x = cvt_pk_bf16(v0[0], v0[1]); w.y = cvt_pk_bf16(v0[2], v0[3]); w.z = cvt_pk_bf16(v1[0], v1[1]); w.w = cvt_pk_bf16(v1[2], v1[3]);
                        *(u32x4*)(rowp + bj * HALF) = w; } }
            if (grp == 1) {
                float* kd = ksum + ((size_t)(((u.pm >> 5) * 8 + 2 * (pn - 4)) * 32 + (u.pm & 31))) * 128 + wc * 32 + 8 * fq;
#pragma unroll
                for (int bj = 0; bj < 2; ++bj)
#pragma unroll
                    for (int n = 0; n < 2; ++n)
#pragma unroll
                        for (int e2 = 0; e2 < 4; ++e2) { float s = ks[bj][n][e2]; s += __shfl_xor(s, 1); s += __shfl_xor(s, 2); s += __shfl_xor(s, 4); s += __shfl_xor(s, 8);
                            if (fr == 0) __hip_atomic_fetch_add(kd + (size_t)bj * 32 * 128 + 4 * n + e2, s, __ATOMIC_RELAXED, __HIP_MEMORY_SCOPE_AGENT); }
            }
        } else if (pn < 20) {
            const int col0 = (pn - 12) * HALF + wc * 32 + 8 * fq;
#pragma unroll
            for (int ai = 0; ai < 2; ++ai)
#pragma unroll
                for (int m = 0; m < 4; ++m) { const int r = row0 + ai * HALF + m * 16; const f32x4 v0 = acc[ai][0][m][0] * acc[ai][1][m][0], v1 = acc[ai][0][m][1] * acc[ai][1][m][1];
                    u32x4 w; w.x = cvt_pk_bf16(v0[0], v0[1]); w.y = cvt_pk_bf16(v0[2], v0[3]); w.z = cvt_pk_bf16(v1[0], v1[1]); w.w = cvt_pk_bf16(v1[2], v1[3]);
                    *(u32x4*)(U + (size_t)r * 1024 + col0) = w; }
        } else if (pn < 24) {
            const int col0 = (pn - 20) * BM + wc * 32 + 8 * fq;
#pragma unroll
            for (int ai = 0; ai < 2; ++ai)
#pragma unroll
                for (int m = 0; m < 4; ++m) { bf16_t* rowp = CBo + (size_t)(row0 + ai * HALF + m * 16) * 1024 + col0;
#pragma unroll
                    for (int bj = 0; bj < 2; ++bj) { const f32x4 v0 = acc[ai][bj][m][0], v1 = acc[ai][bj][m][1];
                        u32x4 w; w.x = cvt_pk_bf16(v0[0], v0[1]); w.y = cvt_pk_bf16(v0[2], v0[3]); w.z = cvt_pk_bf16(v1[0], v1[1]); w.w = cvt_pk_bf16(v1[2], v1[3]);
                        *(u32x4*)(rowp + bj * HALF) = w; } }
        } else {
            const int col0 = (pn - 24) * HALF + wc * 32 + 8 * fq;
#pragma unroll
            for (int ai = 0; ai < 2; ++ai)
#pragma unroll
                for (int m = 0; m < 4; ++m) { const size_t off = (size_t)(row0 + ai * HALF + m * 16) * 2048 + col0; f32x4 rt[2], sv[2];
#pragma unroll
                    for (int n = 0; n < 2; ++n)
#pragma unroll
                        for (int e2 = 0; e2 < 4; ++e2) { const float ea = __expf(fminf(-acc[ai][0][m][n][e2], 80.f)), ec = __expf(fminf(-acc[ai][1][m][n][e2], 80.f));
                            sv[n][e2] = __builtin_amdgcn_rcpf(1.f + ec); rt[n][e2] = (1.f + ec) * __builtin_amdgcn_rcpf(1.f + ea); }
                    u32x4 w; w.x = cvt_pk_bf16(rt[0][0], rt[0][1]); w.y = cvt_pk_bf16(rt[0][2], rt[0][3]); w.z = cvt_pk_bf16(rt[1][0], rt[1][1]); w.w = cvt_pk_bf16(rt[1][2], rt[1][3]);
                    *(u32x4*)(RATIO + off) = w;
                    u32x4 w2; w2.x = cvt_pk_bf16(sv[0][0], sv[0][1]); w2.y = cvt_pk_bf16(sv[0][2], sv[0][3]); w2.z = cvt_pk_bf16(sv[1][0], sv[1][1]); w2.w = cvt_pk_bf16(sv[1][2], sv[1][3]);
                    *(u32x4*)(SC + off) = w2; }
        }
    }
};
struct EpiMerged {
    static constexpr bool PERM = true, AFTER_DRAIN = false, MIDK = true;
    bf16_t* O; const bf16_t* ratio; const bf16_t* sc; int ldc;
    __device__ __forceinline__ void mid(f32x4 (&acc)[2][2][4][2], const Unit& u, int wr, int wc, int fr, int fq) const {
        asm volatile("" : "+v"(fr), "+v"(fq));
        const int row0 = u.pm * BM + wr * 64 + fr, col0 = u.pn * BM + wc * 32 + 8 * fq;
#pragma unroll
        for (int ai = 0; ai < 2; ++ai) {
#pragma unroll
            for (int m = 0; m < 4; ++m) { const bf16_t* rp = ratio + (size_t)(row0 + ai * HALF + m * 16) * ldc + col0;
#pragma unroll
                for (int bj = 0; bj < 2; ++bj) { const u32x4 w = *(const u32x4*)(rp + bj * HALF);
                    acc[ai][bj][m][0] *= (f32x4){bf_lo(w.x), bf_hi(w.x), bf_lo(w.y), bf_hi(w.y)}; acc[ai][bj][m][1] *= (f32x4){bf_lo(w.z), bf_hi(w.z), bf_lo(w.w), bf_hi(w.w)}; } }
            asm volatile("" ::: "memory"); }
    }
    __device__ __forceinline__ void operator()(const f32x4 (&acc)[2][2][4][2], const Unit& u, int wr, int wc, int fr, int fq) const {
        asm volatile("" : "+v"(fr), "+v"(fq));
        const int row0 = u.pm * BM + wr * 64 + fr, col0 = u.pn * BM + wc * 32 + 8 * fq;
#pragma unroll
        for (int ai = 0; ai < 2; ++ai) {
#pragma unroll
            for (int m = 0; m < 4; ++m) { const size_t off = (size_t)(row0 + ai * HALF + m * 16) * ldc + col0;
#pragma unroll
                for (int bj = 0; bj < 2; ++bj) { const u32x4 s = *(const u32x4*)(sc + off + bj * HALF);
                    const f32x4 v0 = acc[ai][bj][m][0] * (f32x4){bf_lo(s.x), bf_hi(s.x), bf_lo(s.y), bf_hi(s.y)}, v1 = acc[ai][bj][m][1] * (f32x4){bf_lo(s.z), bf_hi(s.z), bf_lo(s.w), bf_hi(s.w)};
                    u32x4 w; w.x = cvt_pk_bf16(v0[0], v0[1]); w.y = cvt_pk_bf16(v0[2], v0[3]); w.z = cvt_pk_bf16(v1[0], v1[1]); w.w = cvt_pk_bf16(v1[2], v1[3]);
                    *(u32x4*)(O + off + bj * HALF) = w; } }
            asm volatile("" ::: "memory"); }
    }
};
template <class Epi, class Sched, bool ALIGN_EPI = false, bool SP2 = false>
__device__ __forceinline__ void gemm_phase(PG8_LAS unsigned char* lds, const Gemm g, const Sched& S, const Epi& E) {
    const int tid = threadIdx.x, wid = __builtin_amdgcn_readfirstlane(tid >> 6), lane = tid & 63, wr = wid >> 2, wc = wid & 3, fr = lane & 15, fq = lane >> 4;
    const int K = g.K, nt = K / BK;
    unsigned voffA[2], voffB[2];
#pragma unroll
    for (int i = 0; i < 2; ++i) { int R, C; stage_rc(tid * 16 + i * 8192, R, C); const int Rb = Epi::PERM ? ((R & ~31) + perm32(R & 31)) : R;
        voffA[i] = (unsigned)(R * K + C) * 2u; voffB[i] = (unsigned)(Rb * K + C) * 2u; }
    const size_t kstep = (size_t)(BK * 2);
    const size_t hstep = (size_t)HALF * K * 2;
    const size_t tstep = 2 * hstep;
    const unsigned ldsw = (unsigned)wid * 1024u;
    const int aoff = lds_byte(wr * 64 + fr, fq * 8), boff = lds_byte(wc * 32 + fr, fq * 8);
#define PG8_SA(b, h) (((b) * 2 + (h)) * HTB)
#define PG8_SB(b, h) ((4 + (b) * 2 + (h)) * HTB)
#define PG8_STAGE(bufoff, gbase, voff) do { _Pragma("unroll") for (int _i = 0; _i < 2; ++_i) \
        __builtin_amdgcn_global_load_lds((const unsigned*)((const char*)(gbase) + (voff)[_i]), (PG8_LAS unsigned*)(lds + (bufoff) + ldsw + _i * 8192), 16, 0, 0); } while (0)
#define PG8_LDA(dst, b, h) do { _Pragma("unroll") for (int m = 0; m < 4; ++m) _Pragma("unroll") for (int k = 0; k < 2; ++k) dst[m][k] = *(const PG8_LAS bf16x8*)(lds + PG8_SA(b, h) + aoff + m * 2048 + k * 1024); } while (0)
#define PG8_LDB(dst, b, h) do { _Pragma("unroll") for (int n = 0; n < 2; ++n) _Pragma("unroll") for (int k = 0; k < 2; ++k) dst[n][k] = *(const PG8_LAS bf16x8*)(lds + PG8_SB(b, h) + boff + n * 2048 + k * 1024); } while (0)
#define PG8_MMA(ai, bj, At, Bt) do { __builtin_amdgcn_s_setprio(1); _Pragma("unroll") for (int m = 0; m < 4; ++m) _Pragma("unroll") for (int n = 0; n < 2; ++n) _Pragma("unroll") for (int k = 0; k < 2; ++k) \
        acc[ai][bj][m][n] = __builtin_amdgcn_mfma_f32_16x16x32_bf16(Bt[n][k], At[m][k], acc[ai][bj][m][n], 0, 0, 0); __builtin_amdgcn_s_setprio(0); } while (0)
#define PG8_WAIT_V(n) asm volatile("s_waitcnt vmcnt(" #n ")" ::: "memory")
#define PG8_WAIT_L(n) asm volatile("s_waitcnt lgkmcnt(" #n ")" ::: "memory")
#define PG8_BAR __builtin_amdgcn_s_barrier()
#define PG8_SCHED __builtin_amdgcn_sched_barrier(0)
    Unit cur, nxt; int ui = 0;
    if (!S.next(0, cur)) return;
    f32x4 acc[2][2][4][2];
#pragma unroll
    for (int a = 0; a < 2; ++a)
#pragma unroll
        for (int b = 0; b < 2; ++b)
#pragma unroll
            for (int m = 0; m < 4; ++m)
#pragma unroll
                for (int n = 0; n < 2; ++n) acc[a][b][m][n] = (f32x4){0.f, 0.f, 0.f, 0.f};
    bf16x8 At[4][2], B0[2][2], B1[2][2];
    const char* cA = (const char*)g.A + (size_t)cur.pm * tstep; const char* cB = (const char*)g.Bt + (size_t)cur.pn * tstep;
    S.a_ready(cur);
    if constexpr (SP2) {
        PG8_STAGE(PG8_SB(0, 0), cB, voffB); PG8_STAGE(PG8_SB(0, 1), cB + hstep, voffB); PG8_STAGE(PG8_SA(0, 0), cA, voffA); PG8_STAGE(PG8_SA(0, 1), cA + hstep, voffA);
        if (wr == 1) PG8_BAR;
        PG8_WAIT_V(2); PG8_BAR;
        PG8_STAGE(PG8_SB(1, 0), cB + kstep, voffB); PG8_STAGE(PG8_SA(1, 0), cA + kstep, voffA); PG8_STAGE(PG8_SB(1, 1), cB + hstep + kstep, voffB);
        PG8_WAIT_V(6); PG8_BAR;
    } else {
        PG8_STAGE(PG8_SB(0, 0), cB, voffB); PG8_STAGE(PG8_SA(0, 0), cA, voffA); PG8_STAGE(PG8_SB(0, 1), cB + hstep, voffB); PG8_STAGE(PG8_SA(0, 1), cA + hstep, voffA);
        if (wr == 1) PG8_BAR;
        PG8_WAIT_V(4); PG8_BAR;
        PG8_STAGE(PG8_SB(1, 0), cB + kstep, voffB); PG8_STAGE(PG8_SA(1, 0), cA + kstep, voffA); PG8_STAGE(PG8_SB(1, 1), cB + hstep + kstep, voffB);
        PG8_WAIT_V(6); PG8_BAR;
    }
    for (;;) {
        const bool has_next = S.next(ui + 1, nxt);
        const char* nA = has_next ? (const char*)g.A + (size_t)nxt.pm * tstep : cA; const char* nB = has_next ? (const char*)g.Bt + (size_t)nxt.pn * tstep : cB;
        for (int t = 0; t < nt; t += 2) {
            const bool last = (t == nt - 2);
            if constexpr (Epi::MIDK) { if (t == (nt >> 1)) E.mid(acc, cur, wr, wc, fr, fq); }
            const char* a1 = cA + (size_t)(t + 1) * kstep;
            const char* a2 = last ? nA : cA + (size_t)(t + 2) * kstep; const char* b2 = last ? nB : cB + (size_t)(t + 2) * kstep;
            const char* a3 = a2 + kstep; const char* b3 = b2 + kstep;
            if (last && has_next) S.a_ready(nxt);
            if constexpr (SP2) {
            PG8_LDB(B0, 0, 0); PG8_LDB(B1, 0, 1); PG8_SCHED; PG8_LDA(At, 0, 0); PG8_STAGE(PG8_SA(1, 1), a1 + hstep, voffA);
            PG8_WAIT_V(8); PG8_WAIT_L(0); PG8_BAR; PG8_MMA(0, 0, At, B0); PG8_MMA(0, 1, At, B1); PG8_BAR; PG8_SCHED;
            PG8_LDA(At, 0, 1); PG8_STAGE(PG8_SB(0, 0), b2, voffB); PG8_STAGE(PG8_SB(0, 1), b2 + hstep, voffB); PG8_STAGE(PG8_SA(0, 0), a2, voffA);
            PG8_WAIT_V(8); PG8_WAIT_L(0); PG8_BAR; PG8_MMA(1, 0, At, B0); PG8_MMA(1, 1, At, B1); PG8_BAR; PG8_SCHED;
            PG8_LDB(B0, 1, 0); PG8_LDB(B1, 1, 1); PG8_SCHED; PG8_LDA(At, 1, 0); PG8_STAGE(PG8_SA(0, 1), a2 + hstep, voffA);
            PG8_WAIT_V(8); PG8_WAIT_L(0); PG8_BAR; PG8_MMA(0, 0, At, B0); PG8_MMA(0, 1, At, B1); PG8_BAR; PG8_SCHED;
            PG8_LDA(At, 1, 1); PG8_STAGE(PG8_SB(1, 0), b3, voffB); PG8_STAGE(PG8_SB(1, 1), b3 + hstep, voffB); PG8_STAGE(PG8_SA(1, 0), a3, voffA);
            PG8_WAIT_V(8); PG8_WAIT_L(0); PG8_BAR; PG8_MMA(1, 0, At, B0); PG8_MMA(1, 1, At, B1); PG8_BAR; PG8_SCHED;
            } else {
            PG8_LDB(B0, 0, 0); PG8_SCHED; PG8_LDA(At, 0, 0); PG8_STAGE(PG8_SA(1, 1), a1 + hstep, voffA);
            PG8_WAIT_L(8); PG8_BAR; PG8_WAIT_L(0); PG8_MMA(0, 0, At, B0); PG8_BAR; PG8_SCHED;
            PG8_LDB(B1, 0, 1); PG8_STAGE(PG8_SB(0, 0), b2, voffB);
            PG8_BAR; PG8_WAIT_L(0); PG8_MMA(0, 1, At, B1); PG8_BAR;
            PG8_LDA(At, 0, 1); PG8_STAGE(PG8_SA(0, 0), a2, voffA);
            PG8_BAR; PG8_WAIT_L(0); PG8_MMA(1, 0, At, B0); PG8_BAR; PG8_SCHED;
            PG8_STAGE(PG8_SB(0, 1), b2 + hstep, voffB);
            PG8_WAIT_V(6); PG8_BAR; PG8_MMA(1, 1, At, B1); PG8_BAR;
            PG8_LDB(B0, 1, 0); PG8_SCHED; PG8_LDA(At, 1, 0); PG8_STAGE(PG8_SA(0, 1), a2 + hstep, voffA);
            PG8_WAIT_L(8); PG8_BAR; PG8_WAIT_L(0); PG8_MMA(0, 0, At, B0); PG8_BAR; PG8_SCHED;
            PG8_LDB(B1, 1, 1); PG8_STAGE(PG8_SB(1, 0), b3, voffB);
            PG8_BAR; PG8_WAIT_L(0); PG8_MMA(0, 1, At, B1); PG8_BAR;
            PG8_LDA(At, 1, 1); PG8_STAGE(PG8_SA(1, 0), a3, voffA);
            PG8_BAR; PG8_WAIT_L(0); PG8_MMA(1, 0, At, B0); PG8_BAR; PG8_SCHED;
            PG8_STAGE(PG8_SB(1, 1), b3 + hstep, voffB);
            PG8_WAIT_V(6); PG8_BAR; PG8_MMA(1, 1, At, B1); PG8_BAR;
            }
        }
        if constexpr (ALIGN_EPI) { if (wr == 0) PG8_BAR; }
        if constexpr (!Epi::AFTER_DRAIN) { E(acc, cur, wr, wc, fr, fq); S.done(cur); }
        if (!has_next) break;
#pragma unroll
        for (int a = 0; a < 2; ++a)
#pragma unroll
            for (int b = 0; b < 2; ++b)
#pragma unroll
                for (int m = 0; m < 4; ++m)
#pragma unroll
                    for (int n = 0; n < 2; ++n) acc[a][b][m][n] = (f32x4){0.f, 0.f, 0.f, 0.f};
        cur = nxt; cA = nA; cB = nB; ++ui;
        if constexpr (ALIGN_EPI) { if (wr == 1) PG8_BAR; }
    }
    PG8_WAIT_V(0);
    if constexpr (!ALIGN_EPI) { if (wr == 0) PG8_BAR; }
    PG8_BAR;
    if constexpr (Epi::AFTER_DRAIN) { E.fused(acc, cur, wr, wc, fr, fq, lds, wid, lane); S.done(cur); }
#undef PG8_SA
#undef PG8_SB
#undef PG8_STAGE
#undef PG8_LDA
#undef PG8_LDB
#undef PG8_MMA
#undef PG8_WAIT_V
#undef PG8_WAIT_L
#undef PG8_BAR
#undef PG8_SCHED
}
}
#define GAS __attribute__((address_space(1)))
#define LAS __attribute__((address_space(3)))
typedef unsigned short bf16;
typedef unsigned v4u __attribute__((ext_vector_type(4)));
typedef float f32x4 __attribute__((ext_vector_type(4)));
typedef short bf16x8 __attribute__((ext_vector_type(8)));
typedef GAS unsigned gu32;
typedef GAS unsigned long long gu64;
#define RLX_AGENT __ATOMIC_RELAXED, __HIP_MEMORY_SCOPE_AGENT
#define LDS_WAIT() asm volatile("s_waitcnt lgkmcnt(0)" ::: "memory")
#define VM_WAIT() asm volatile("s_waitcnt vmcnt(0)" ::: "memory")
__device__ __forceinline__ unsigned long long rt() { return __builtin_amdgcn_s_memrealtime(); }
__device__ __forceinline__ unsigned f2bf(float f) { unsigned u = __builtin_bit_cast(unsigned, f); return (u + 0x7fffu + ((u >> 16) & 1u)) >> 16; }
__device__ __forceinline__ unsigned pk2(float lo, float hi) { return f2bf(lo) | (f2bf(hi) << 16); }

#define XB_TMO      128
#define XB_XCNT(j)  (256  + 64 * (j))
#define XB_XSUB(j)  (1280 + 64 * (j))
#define XB_XGEN(j)  (2304 + 64 * (j))
#define XB_TOP      3328
#define XB_TOPGEN   3392
#define XCD_BAR_WORDS 3456
#define XB_SPIN_CAP (1u << 18)

__device__ __forceinline__ unsigned xb_ld(unsigned* p)              { return __hip_atomic_load(p, __ATOMIC_RELAXED, __HIP_MEMORY_SCOPE_AGENT); }
__device__ __forceinline__ unsigned xb_add(unsigned* p, unsigned v) { return __hip_atomic_fetch_add(p, v, __ATOMIC_RELAXED, __HIP_MEMORY_SCOPE_AGENT); }
__device__ __forceinline__ unsigned xb_xcc_id() { return (unsigned)__builtin_amdgcn_s_getreg((3 << 11) | 20) & 0xFu; }
#define XB_SPIN(cond, bar) do { unsigned _sp = 0; while (cond) { __builtin_amdgcn_s_sleep(1); \
    if ((++_sp & 255u) == 0u) { if (xb_ld(&(bar)[XB_TMO])) break; if (_sp > XB_SPIN_CAP) { atomicAdd(&(bar)[XB_TMO], 1u); break; } } } } while (0)

struct XcdBarrier {
    unsigned* bar; unsigned x;
    volatile LAS unsigned* st;
};

__device__ __forceinline__ XcdBarrier xcd_barrier_post(unsigned* bar, volatile LAS unsigned* st) {
    XcdBarrier b; b.bar = bar; b.x = xb_xcc_id(); b.st = st;
    if (threadIdx.x == 0) (void)xb_add(&bar[XB_XCNT(b.x)], 1u);
    return b;
}
__device__ __forceinline__ void xcd_barrier_complete(unsigned* bar, unsigned x, unsigned& nloc, unsigned& nx) {
    const unsigned G = gridDim.x * gridDim.y * gridDim.z;
    unsigned sum, cnt, mine, sp = 0u;
    for (;;) {
        sum = 0u; cnt = 0u; mine = 0u;
#pragma unroll
        for (unsigned j = 0; j < 16; ++j) { const unsigned c = xb_ld(&bar[XB_XCNT(j)]); sum += c; cnt += (c > 0u) ? 1u : 0u; mine = (j == x) ? c : mine; }
        if (sum == G) break;
        __builtin_amdgcn_s_sleep(1);
        if ((++sp & 255u) == 0u) { if (xb_ld(&bar[XB_TMO])) break; if (sp > XB_SPIN_CAP) { atomicAdd(&bar[XB_TMO], 1u); break; } }
    }
    nloc = mine > 0u ? mine : 1u; nx = cnt > 0u ? cnt : 1u;
}

__device__ __forceinline__ void xcd_barrier(const XcdBarrier& b) {
    asm volatile("s_waitcnt vmcnt(0)" ::: "memory");
    __syncthreads();
    if (threadIdx.x == 0) {
        unsigned* bar = b.bar;
        __builtin_amdgcn_s_waitcnt(0);
        unsigned nloc = b.st[0], nx = b.st[1];
        if (nloc == 0u) { xcd_barrier_complete(bar, b.x, nloc, nx); b.st[0] = nloc; b.st[1] = nx; }
        const unsigned old = xb_add(&bar[XB_XSUB(b.x)], 1u);
        const unsigned gen = old / nloc;
        if (old + 1u == (gen + 1u) * nloc) {
            __builtin_amdgcn_fence(__ATOMIC_RELEASE, "agent");
            asm volatile("s_waitcnt vmcnt(0)" ::: "memory");
            const unsigned og = xb_add(&bar[XB_TOP], 1u);
            const unsigned tg = og / nx;
            if (og + 1u == (tg + 1u) * nx) xb_add(&bar[XB_TOPGEN], 1u);
            else XB_SPIN(xb_ld(&bar[XB_TOPGEN]) == tg, bar);
            __builtin_amdgcn_fence(__ATOMIC_ACQUIRE, "agent");
            xb_add(&bar[XB_XGEN(b.x)], 1u);
            asm volatile("s_waitcnt vmcnt(0)" ::: "memory");
        } else {
            XB_SPIN(xb_ld(&bar[XB_XGEN(b.x)]) == gen, bar);
            __builtin_amdgcn_fence(__ATOMIC_ACQUIRE, "agent");
            asm volatile("s_waitcnt vmcnt(0)" ::: "memory");
        }
    }
    __syncthreads();
}

namespace att {
typedef short bf16x8 __attribute__((ext_vector_type(8)));
typedef short s16x4 __attribute__((ext_vector_type(4)));
typedef float f32x16 __attribute__((ext_vector_type(16)));
typedef float f32x4 __attribute__((ext_vector_type(4)));
typedef unsigned u32x4 __attribute__((ext_vector_type(4)));
typedef unsigned short bf16;
constexpr int D = 128, NW = 8, QBLK = 32, KVBLK = 64, QB = NW * QBLK;
constexpr int SHM_V = KVBLK * D * 2, SHM_K = KVBLK * D * 2;
constexpr int LDS_SEL = 2 * SHM_V + 2 * SHM_K + NW * 64 * 4;
constexpr int LDS_BYTES = LDS_SEL + 2 * QB * 4;
constexpr float SCALE = 0.08838834764831845f, THR = 8.f;
#define KSWZ(row, colB) ((row) * 256 + ((colB) ^ (((row) & 7) << 4)))
#define SBAR() __builtin_amdgcn_sched_barrier(0)
__device__ __forceinline__ int v_st(int k, int c) { const int kk = (k & ~0xC) | ((k & 4) << 1) | ((k & 8) >> 1); return ((kk >> 3) * 4 + (c >> 5)) * 512 + ((kk & 7) * 32 + (c & 31)) * 2; }
__device__ __forceinline__ int v_rd_base(int lane) { return ((lane & 3) << 3) | (((lane >> 2) & 3) << 6) | (((lane >> 4) & 1) << 5) | (((lane >> 5) & 1) << 8); }
constexpr int v_rd_off(int d0, int ks, int half) { return d0 * 512 + ks * 4096 + half * 2048; }
__device__ __forceinline__ int crow(int r, int hi) { return (r & 3) + 8 * (r >> 2) + 4 * hi; }
__device__ __forceinline__ unsigned cvtpk(float lo, float hi) { unsigned r; asm volatile("v_cvt_pk_bf16_f32 %0, %1, %2" : "=v"(r) : "v"(lo), "v"(hi)); return r; }
__device__ __forceinline__ bf16x8 load8(const bf16* p) { return *reinterpret_cast<const bf16x8*>(p); }
__device__ __forceinline__ void mask_causal(f32x16& p0, f32x16& p1, int dq) {
    const float NEG = -__builtin_inff();
#pragma unroll
    for (int r = 0; r < 16; ++r) { const int c = (r & 3) + 8 * (r >> 2); if (dq - c < 0) p0[r] = NEG; if (dq - c - 32 < 0) p1[r] = NEG; }
}
template <bool MOBA>
__device__ __forceinline__ void partialSM(f32x16& p0, f32x16& p1, float& m_reg, float& mn, float& alpha, bool rm) {
    float pmax = p0[0]; for (int r = 1; r < 16; ++r) pmax = fmaxf(pmax, p0[r]); for (int r = 0; r < 16; ++r) pmax = fmaxf(pmax, p1[r]);
    { auto rr = __builtin_amdgcn_permlane32_swap(__float_as_uint(pmax), __float_as_uint(pmax), false, false);
      pmax = fmaxf(__uint_as_float(rr[0]), __uint_as_float(rr[1])); }
    if (MOBA && rm) pmax = -__builtin_inff();
    constexpr float C2 = 1.4426950408889634f * SCALE;
    if (__builtin_expect(__all((pmax - m_reg) * SCALE <= THR), 1)) { mn = m_reg; alpha = 1.f; }
    else { mn = fmaxf(m_reg, pmax); alpha = __builtin_amdgcn_exp2f((m_reg - mn) * C2); m_reg = mn; }
    float mnL = -mn * C2; if (MOBA && rm) mnL = -__builtin_inff();
    for (int r = 0; r < 16; ++r) p0[r] = fmaf(p0[r], C2, mnL); for (int r = 0; r < 16; ++r) p1[r] = fmaf(p1[r], C2, mnL);
    for (int r = 0; r < 16; ++r) p0[r] = __builtin_amdgcn_exp2f(p0[r]);
}
__device__ __forceinline__ void finishSM(f32x16& p0, f32x16& p1, float alpha, float& l_reg, bf16x8& pa0, bf16x8& pa1, bf16x8& pa2, bf16x8& pa3) {
    for (int r = 0; r < 16; ++r) p1[r] = __builtin_amdgcn_exp2f(p1[r]);
    float ps = 0; for (int r = 0; r < 16; ++r) ps += p0[r]; for (int r = 0; r < 16; ++r) ps += p1[r];
    { auto rr = __builtin_amdgcn_permlane32_swap(__float_as_uint(ps), __float_as_uint(ps), false, false);
      ps = __uint_as_float(rr[0]) + __uint_as_float(rr[1]); }
    l_reg = l_reg * alpha + ps;
#define PK4(P, B_, OUT) do { unsigned a0 = cvtpk(P[B_+0], P[B_+1]), a1 = cvtpk(P[B_+2], P[B_+3]);                          \
        unsigned b0 = cvtpk(P[B_+4], P[B_+5]), b1 = cvtpk(P[B_+6], P[B_+7]);                                             \
        auto r0 = __builtin_amdgcn_permlane32_swap(a0, b0, false, false); auto r1 = __builtin_amdgcn_permlane32_swap(a1, b1, false, false); \
        u32x4 w = {r0[0], r1[0], r0[1], r1[1]}; OUT = *reinterpret_cast<bf16x8*>(&w); } while (0)
    PK4(p0, 0, pa0); PK4(p0, 8, pa1); PK4(p1, 0, pa2); PK4(p1, 8, pa3);
#undef PK4
}
template <int KB>
__device__ __forceinline__ void qkt(f32x16& p0, f32x16& p1, const char* K_lds, int r32, int hi, const bf16x8* qr) {
    p0 = f32x16{}; p1 = f32x16{};
    const char* kb[4];
#pragma unroll
    for (int dd = 0; dd < 4; ++dd) kb[dd] = K_lds + KB * SHM_K + KSWZ(r32, (dd * 16 + hi * 8) * 2);
#pragma unroll
    for (int d0 = 0; d0 < 8; ++d0) { const char* a = kb[d0 & 3] + (d0 >> 2) * 128;
        bf16x8 b0 = *reinterpret_cast<const bf16x8*>(a);
        bf16x8 b1 = *reinterpret_cast<const bf16x8*>(a + 32 * 256);
        p0 = __builtin_amdgcn_mfma_f32_32x32x16_bf16(b0, qr[d0], p0, 0, 0, 0);
        p1 = __builtin_amdgcn_mfma_f32_32x32x16_bf16(b1, qr[d0], p1, 0, 0, 0); }
}
template <int VB>
__device__ __forceinline__ void pv_tile(f32x16* o, int vb0, bf16x8 pa0, bf16x8 pa1, bf16x8 pa2, bf16x8 pa3) {
#define TRRD(dst, off) asm volatile("ds_read_b64_tr_b16 %0, %1 offset:%2" : "=&v"(dst) : "v"(vb0), "i"(off) : "memory")
#define PV_D0(d0) do { s16x4 l0, l1, l2, l3, h0, h1, h2, h3; constexpr int b_ = VB * SHM_V + v_rd_off(d0, 0, 0); \
        TRRD(l0, b_); TRRD(h0, b_ + 2048); TRRD(l1, b_ + 4096); TRRD(h1, b_ + 6144); TRRD(l2, b_ + 8192); TRRD(h2, b_ + 10240); TRRD(l3, b_ + 12288); TRRD(h3, b_ + 14336); \
        asm volatile("s_waitcnt lgkmcnt(0)" ::: "memory"); SBAR();   \
        o[d0] = __builtin_amdgcn_mfma_f32_32x32x16_bf16(pa0, (bf16x8){l0[0], l0[1], l0[2], l0[3], h0[0], h0[1], h0[2], h0[3]}, o[d0], 0, 0, 0);   \
        o[d0] = __builtin_amdgcn_mfma_f32_32x32x16_bf16(pa1, (bf16x8){l1[0], l1[1], l1[2], l1[3], h1[0], h1[1], h1[2], h1[3]}, o[d0], 0, 0, 0);   \
        o[d0] = __builtin_amdgcn_mfma_f32_32x32x16_bf16(pa2, (bf16x8){l2[0], l2[1], l2[2], l2[3], h2[0], h2[1], h2[2], h2[3]}, o[d0], 0, 0, 0);   \
        o[d0] = __builtin_amdgcn_mfma_f32_32x32x16_bf16(pa3, (bf16x8){l3[0], l3[1], l3[2], l3[3], h3[0], h3[1], h3[2], h3[3]}, o[d0], 0, 0, 0); } while (0)
    PV_D0(0); PV_D0(1); PV_D0(2); PV_D0(3);
#undef PV_D0
#undef TRRD
}
template <int QS>
__device__ __forceinline__ void moba_gate(int tid, const bf16* Q, const float* KM, int qb, unsigned* selw) {
    const int wid = __builtin_amdgcn_readfirstlane(tid >> 6), lane = tid & 63, r32 = lane & 31, hi = lane >> 5;
    bf16x8 qr[8];
#pragma unroll
    for (int d0 = 0; d0 < 8; ++d0) qr[d0] = load8(Q + (size_t)(wid * QBLK + r32) * QS + d0 * 16 + hi * 8);
    unsigned sel = 0u;
    {
        f32x16 g = {};
        const float* km = KM + (size_t)r32 * D + hi * 8;
#pragma unroll
        for (int d0 = 0; d0 < 8; ++d0) { const f32x4 a = *(const f32x4*)(km + d0 * 16), b = *(const f32x4*)(km + d0 * 16 + 4);
            u32x4 wh = {cvtpk(a[0], a[1]), cvtpk(a[2], a[3]), cvtpk(b[0], b[1]), cvtpk(b[2], b[3])};
            const f32x4 al = {a[0] - __uint_as_float(wh[0] << 16), a[1] - __uint_as_float(wh[0] & 0xffff0000u), a[2] - __uint_as_float(wh[1] << 16), a[3] - __uint_as_float(wh[1] & 0xffff0000u)};
            const f32x4 bl = {b[0] - __uint_as_float(wh[2] << 16), b[1] - __uint_as_float(wh[2] & 0xffff0000u), b[2] - __uint_as_float(wh[3] << 16), b[3] - __uint_as_float(wh[3] & 0xffff0000u)};
            u32x4 wl = {cvtpk(al[0], al[1]), cvtpk(al[2], al[3]), cvtpk(bl[0], bl[1]), cvtpk(bl[2], bl[3])};
            g = __builtin_amdgcn_mfma_f32_32x32x16_bf16(*reinterpret_cast<bf16x8*>(&wh), qr[d0], g, 0, 0, 0);
            g = __builtin_amdgcn_mfma_f32_32x32x16_bf16(*reinterpret_cast<bf16x8*>(&wl), qr[d0], g, 0, 0, 0); }
        const int IMIN = (int)0x80000000;
        int key[16];
#pragma unroll
        for (int r = 0; r < 16; ++r) { const int n = crow(r, hi); const int bits = (int)__float_as_uint(g[r]); const int s = bits ^ ((bits >> 31) & 0x7fffffff);
            key[r] = (n < qb) ? ((s & ~31) | (31 - n)) : IMIN; }
        int m1 = IMIN, m2 = IMIN, m3 = IMIN;
#pragma unroll
        for (int r = 0; r < 16; ++r) m1 = max(m1, key[r]);
#pragma unroll
        for (int r = 0; r < 16; ++r) m2 = max(m2, key[r] < m1 ? key[r] : IMIN);
#pragma unroll
        for (int r = 0; r < 16; ++r) m3 = max(m3, key[r] < m2 ? key[r] : IMIN);
        int c6[6];
        { auto r1 = __builtin_amdgcn_permlane32_swap((unsigned)m1, (unsigned)m1, false, false); c6[0] = (int)r1[0]; c6[1] = (int)r1[1];
          auto r2 = __builtin_amdgcn_permlane32_swap((unsigned)m2, (unsigned)m2, false, false); c6[2] = (int)r2[0]; c6[3] = (int)r2[1];
          auto r3 = __builtin_amdgcn_permlane32_swap((unsigned)m3, (unsigned)m3, false, false); c6[4] = (int)r3[0]; c6[5] = (int)r3[1]; }
        int t1 = IMIN, t2 = IMIN, t3 = IMIN;
#pragma unroll
        for (int r = 0; r < 6; ++r) t1 = max(t1, c6[r]);
#pragma unroll
        for (int r = 0; r < 6; ++r) t2 = max(t2, c6[r] < t1 ? c6[r] : IMIN);
#pragma unroll
        for (int r = 0; r < 6; ++r) t3 = max(t3, c6[r] < t2 ? c6[r] : IMIN);
        if (t1 != IMIN) sel |= 1u << (31 - (t1 & 31));
        if (t2 != IMIN) sel |= 1u << (31 - (t2 & 31));
        if (t3 != IMIN) sel |= 1u << (31 - (t3 & 31));
    }
    if (hi == 0) selw[wid * QBLK + r32] = sel;
}
struct Seam { bf16x8 qr[8]; bf16x8 st_v0, st_v1, st_k0, st_k1; };
#define ROWP(p, k0, rr, str) ((p) + (size_t)((k0) + (rr)) * (str) + sc)
#define VMW() asm volatile("s_waitcnt vmcnt(0)" ::: "memory")
#define VMWN(n) asm volatile("s_waitcnt vmcnt(%0)" :: "i"(n) : "memory")
#define SLOAD_H(Kp, Vp, k0, str) do { S.st_v0 = load8(ROWP(Vp, k0, sr, str)); S.st_v1 = load8(ROWP(Vp, k0, 32 + sr, str));              \
                         S.st_k0 = load8(ROWP(Kp, k0, sr, str)); S.st_k1 = load8(ROWP(Kp, k0, 32 + sr, str)); } while (0)
#define SWRITE_HK(bf) do { *(bf16x8*)(K_lds + (bf) * SHM_K + kws) = S.st_k0; *(bf16x8*)(K_lds + (bf) * SHM_K + kws + 32 * 256) = S.st_k1; } while (0)
#define SWRITE_HV(bf) do { *(bf16x8*)(V_lds + (bf) * SHM_V + vst0) = S.st_v0; *(bf16x8*)(V_lds + (bf) * SHM_V + vst1) = S.st_v1; } while (0)
#define SWRITE_H(bf) do { SWRITE_HV(bf); SWRITE_HK(bf); } while (0)
template <int QS, int KVS, long VOFF>
__device__ __forceinline__ void attn_prime(int tid, const bf16* curQ, const bf16* curK, char* lds, Seam& S) {
    const int wid = __builtin_amdgcn_readfirstlane(tid >> 6), lane = tid & 63, r32 = lane & 31, hi = lane >> 5;
    const int sr = tid >> 4, sc = (tid & 15) * 8, kws = KSWZ(sr, sc * 2); char* K_lds = lds + 2 * SHM_V;
    for (int d0 = 0; d0 < 8; ++d0) S.qr[d0] = load8(curQ + (size_t)(wid * QBLK + r32) * QS + d0 * 16 + hi * 8);
    SLOAD_H(curK, curK + VOFF, 0, KVS); VMW(); SWRITE_HK(0);
    __syncthreads();
}
template <bool MOBA, int QS, int KVS, long VOFF, int OS>
__device__ __forceinline__ void attn_block(int tid, const bf16* curK, bf16* curO, int NT, int selofs, const bf16* nxtQ, const bf16* nxtK, char* lds, Seam& S) {
    const int wid = __builtin_amdgcn_readfirstlane(tid >> 6), lane = tid & 63, r32 = lane & 31, hi = lane >> 5;
    const int qlo = wid * QBLK, qm = qlo + r32 - 4 * hi;
    char* V_lds = lds; char* K_lds = lds + 2 * SHM_V;
    float* ws = (float*)(lds + 2 * SHM_V + 2 * SHM_K) + wid * 64; float* li_l = ws, * al_l = ws + 32;
    const int sr = tid >> 4, sc = (tid & 15) * 8, vst0 = v_st(sr, sc), vst1 = v_st(32 + sr, sc), kws = KSWZ(sr, sc * 2);
    const int vb0 = (int)(uintptr_t)V_lds + v_rd_base(lane);
    const bf16* Kh = curK; const bf16* Vh = curK + VOFF; constexpr int kvs = KVS;
    unsigned sel = 0u;
    if (MOBA) sel = ((const unsigned*)(lds + LDS_SEL))[selofs + wid * QBLK + r32];
    float m_reg = -1e30f, l_reg = 0; f32x16 o[4] = {};
#define RESC(a) do { if (__any((a) < 1.f)) { if (hi == 0) al_l[r32] = (a); asm volatile("s_waitcnt lgkmcnt(0)" ::: "memory");              \
                     for (int d_ = 0; d_ < 4; ++d_) for (int r = 0; r < 16; ++r) o[d_][r] *= al_l[crow(r, hi)]; } } while (0)
#define KBASE(t) ((t) * KVBLK)
#define MASKT(P0_, P1_, t) do { if (MOBA) { const int kb_ = ((t) - (NT - 4)) * KVBLK; if (kb_ >= 0 && kb_ + KVBLK - 1 > qlo) mask_causal(P0_, P1_, qm - kb_); } } while (0)
#define RMT(t) (MOBA && ((t) < NT - 4) && !((sel >> ((t) >> 2)) & 1u))
    const int NQL = 8;
#define SEAM_K0() do { VMWN(8); SWRITE_HK(0); SBAR(); } while (0)
    f32x16 pA0, pA1, pB0, pB1; float mnA, mnB, alA, alB; bf16x8 pa0, pa1, pa2, pa3;
    (void)NQL;
    SWRITE_HV(0); SBAR();
    if (NT > 1) SLOAD_H(Kh, Vh, KBASE(1), kvs);
    SBAR(); qkt<0>(pA0, pA1, K_lds, r32, hi, S.qr);
    MASKT(pA0, pA1, 0); partialSM<MOBA>(pA0, pA1, m_reg, mnA, alA, RMT(0));
    if (NT > 1) { VMW(); SWRITE_H(1); }
    __syncthreads();
#define HALF_STEP(PX0, PX1, mnX, alX, PY0, PY1, alY, t, KB, VB, SB) do {                                                      \
        SBAR(); qkt<KB>(PX0, PX1, K_lds, r32, hi, S.qr);                                             \
        finishSM(PY0, PY1, alY, l_reg, pa0, pa1, pa2, pa3); SBAR();                                                           \
        if ((t) + 1 < NT) { SLOAD_H(Kh, Vh, KBASE((t) + 1), kvs); SBAR(); }                                               \
        pv_tile<VB>(o, vb0, pa0, pa1, pa2, pa3); MASKT(PX0, PX1, (t)); partialSM<MOBA>(PX0, PX1, m_reg, mnX, alX, RMT(t));                                        \
        __syncthreads();                                                                                                      \
        if ((t) + 1 < NT) { VMW(); SWRITE_H(SB); }                                                                          \
        RESC(alX); __syncthreads(); } while (0)
    for (int t = 1; t + 1 < NT; t += 2) {
        HALF_STEP(pB0, pB1, mnB, alB, pA0, pA1, alA, t, 1, 0, 0);
        HALF_STEP(pA0, pA1, mnA, alA, pB0, pB1, alB, t + 1, 0, 1, 1);
    }
    const bool even = (NT & 1) == 0;
    if (even) { SBAR(); qkt<1>(pB0, pB1, K_lds, r32, hi, S.qr); SBAR(); }
    SLOAD_H(nxtK, nxtK + VOFF, 0, KVS); SBAR();
#pragma unroll
    for (int d0 = 0; d0 < 8; ++d0) S.qr[d0] = load8(nxtQ + (size_t)(wid * QBLK + r32) * QS + d0 * 16 + hi * 8);
    SBAR();
    finishSM(pA0, pA1, alA, l_reg, pa0, pa1, pa2, pa3); SBAR();
    pv_tile<0>(o, vb0, pa0, pa1, pa2, pa3);
    if (even) { MASKT(pB0, pB1, NT - 1); partialSM<MOBA>(pB0, pB1, m_reg, mnB, alB, RMT(NT - 1)); __syncthreads(); RESC(alB);
        finishSM(pB0, pB1, alB, l_reg, pa0, pa1, pa2, pa3); SBAR(); pv_tile<1>(o, vb0, pa0, pa1, pa2, pa3); }
    SBAR(); SEAM_K0();
    if (hi == 0) li_l[r32] = l_reg; asm volatile("s_waitcnt lgkmcnt(0)" ::: "memory");
    float rli[16];
#pragma unroll
    for (int r = 0; r < 16; ++r) rli[r] = __builtin_amdgcn_rcpf(li_l[crow(r, hi)]);
    bf16* Ow = curO + (size_t)(wid * QBLK) * OS;
#pragma unroll
    for (int r = 0; r < 16; ++r) { const int orow = crow(r, hi);
#pragma unroll
        for (int d0 = 0; d0 < 4; ++d0) { const float v = o[d0][r] * rli[r];
            const float vn = __shfl_xor(v, 1);
            if ((r32 & 1) == 0) *(unsigned*)(Ow + (size_t)orow * OS + d0 * 32 + r32) = cvtpk(v, vn); } }
    __syncthreads();
#undef RESC
#undef KBASE
#undef MASKT
#undef RMT
#undef SEAM_K0
#undef HALF_STEP
}
#undef ROWP
#undef VMW
#undef VMWN
#undef SLOAD_H
#undef SWRITE_HK
#undef SWRITE_HV
#undef SWRITE_H
#undef KSWZ
#undef SBAR
}

constexpr int NWAVES = 8;
#ifndef MK_PER_PHASE
#define MK_PER_PHASE 0
#endif
constexpr int N_PHASES = 11;

constexpr int NB = 2, SEQ = 8192, DM = 2048, M = NB * SEQ;
constexpr int NH = 8, HD = 128, AW = NH * HD, CWID = 1024, NPROJ = 3 * AW + 3 * CWID + 2 * DM;
constexpr int NMEM = 256, XH = 4, XW = XH * HD, DFF = 4 * DM;
constexpr int MBLK = 256, NBLK = SEQ / MBLK, TOPK = 3;
constexpr float EPS = 1e-6f;
constexpr float ATT_SCALE = 0.08838834764831845f;

constexpr size_t MiB = 1u << 20;
constexpr size_t WS_CTL = 0, CTL_ZERO_BYTES = 1 * MiB;
constexpr size_t WS_ROPE = 2 * MiB;
constexpr size_t WS_KMEAN = 3 * MiB;
constexpr size_t WS_SS1 = 3 * MiB + 512 * 1024;
constexpr size_t WS_SS2 = WS_SS1 + 128 * 1024, WS_SS3 = WS_SS2 + 128 * 1024;
constexpr size_t WS_MEMN = 4 * MiB;
constexpr size_t WS_MKV = 6 * MiB;
constexpr size_t WS_WIN = 8 * MiB;
constexpr size_t WS_WAC = 48 * MiB;
constexpr size_t WS_WM = 56 * MiB;
constexpr size_t WS_WQ = 64 * MiB;
constexpr size_t WS_WKV = 66 * MiB;
constexpr size_t WS_WO = 70 * MiB;
constexpr size_t WS_WUP = 72 * MiB;
constexpr size_t WS_WD = 104 * MiB;
constexpr size_t WS_XB = 136 * MiB;
constexpr size_t WS_G = 200 * MiB;
constexpr size_t GRP = 32 * MiB;
constexpr size_t WS_RATIO = 360 * MiB, WS_SC = 424 * MiB;
constexpr size_t WS_MERGED = 200 * MiB;
constexpr size_t WS_HQ = 264 * MiB, WS_XO = 280 * MiB;
constexpr size_t WS_UP = 232 * MiB;
constexpr size_t WS_END = 488 * MiB;
constexpr int CW_TMO = 0, CW_CODE = 1, CW_BAR = 4096;

constexpr int RING_OFF = 0, RING_BYTES = 131072;
constexpr int LDSCTL_OFF = RING_BYTES, MISC_OFF = LDSCTL_OFF + 320;
constexpr int LDS_BYTES = 147456;

__device__ __forceinline__ float bf2f(unsigned short b) { return __uint_as_float((unsigned)b << 16); }
__device__ __forceinline__ float bflo(unsigned w) { return __uint_as_float(w << 16); }
__device__ __forceinline__ float bfhi(unsigned w) { return __uint_as_float(w & 0xffff0000u); }
__device__ __forceinline__ float wave_sum(float v) {
#pragma unroll
    for (int o = 1; o < 64; o <<= 1) v += __shfl_xor(v, o);
    return v;
}
__device__ __forceinline__ float wave_max(float v) {
#pragma unroll
    for (int o = 1; o < 64; o <<= 1) v = fmaxf(v, __shfl_xor(v, o));
    return v;
}

__device__ __forceinline__ void p0_transpose_item(const float* W, int K, int N, bf16* WT, int ldk, int koff, int row_off, const float* gk, LAS float* scr, int item, int lane) {
    const int nblk = N / 32, kb = item / nblk, nb = item % nblk, k0 = 64 * kb, n0 = 32 * nb;
#pragma unroll 8
    for (int i = 0; i < 32; ++i) { const int kk = 2 * i + (lane >> 5); float w = W[(size_t)(k0 + kk) * N + n0 + (lane & 31)]; if (gk) w *= gk[k0 + kk]; scr[kk * 33 + (lane & 31)] = w; }
    LDS_WAIT(); asm volatile("" ::: "memory");
    const int c = lane & 7;
#pragma unroll
    for (int j = 0; j < 4; ++j) { const int n = (lane >> 3) + 8 * j; const LAS float* s = scr + (8 * c) * 33 + n;
        v4u o; o.x = pk2(s[0 * 33], s[1 * 33]); o.y = pk2(s[2 * 33], s[3 * 33]); o.z = pk2(s[4 * 33], s[5 * 33]); o.w = pk2(s[6 * 33], s[7 * 33]);
        *(GAS v4u*)(WT + (size_t)(row_off + n0 + n) * ldk + koff + k0 + 8 * c) = o; }
    LDS_WAIT(); asm volatile("" ::: "memory");
}
__device__ __forceinline__ void rms_row_to_bf16(const float* xrow, const float* g, bf16* orow, int lane) {
    const GAS f32x4* xr = (const GAS f32x4*)xrow + lane; const GAS f32x4* gr = (const GAS f32x4*)g + lane;
    f32x4 v[8]; float s = 0.f;
#pragma unroll
    for (int j = 0; j < 8; ++j) { v[j] = xr[64 * j]; s += (v[j].x * v[j].x + v[j].y * v[j].y) + (v[j].z * v[j].z + v[j].w * v[j].w); }
    const float rstd = 1.f / sqrtf(wave_sum(s) * (1.f / DM) + EPS);
    GAS unsigned long long* o8 = (GAS unsigned long long*)orow + lane;
#pragma unroll
    for (int j = 0; j < 8; ++j) { const f32x4 gg = gr[64 * j];
        o8[64 * j] = (unsigned long long)pk2(v[j].x * rstd * gg.x, v[j].y * rstd * gg.y) | ((unsigned long long)pk2(v[j].z * rstd * gg.z, v[j].w * rstd * gg.w) << 32); }
}
__device__ __forceinline__ float row_rstd(const float* xrow, int lane) {
    const GAS f32x4* xr = (const GAS f32x4*)xrow + lane; float s = 0.f;
#pragma unroll
    for (int j = 0; j < 8; ++j) { const f32x4 v = xr[64 * j]; s += (v.x * v.x + v.y * v.y) + (v.z * v.z + v.w * v.w); }
    return 1.f / sqrtf(wave_sum(s) * (1.f / DM) + EPS);
}

__device__ const float ROPE_INV_FREQ[16] = {1.f, 0.440366596f, 0.193922743f, 0.0853971019f, 0.0376060307f, 0.016560439f, 0.00729266461f, 0.00321144587f, 0.00141421356f, 0.000622772379f, 0.000274248188f, 0.000120769735f, 5.3182961e-05f, 2.34199997e-05f, 1.03133862e-05f, 4.54167048e-06f};
struct Args { const float* in[17]; float* out; unsigned char* ws; int ph_lo, ph_hi, li, pad; };

__device__ __forceinline__ void naive_moba_item(int b, int h, int i, const bf16* QP, const bf16* KP, const bf16* VP, const float2* ROPE, const float* KMEAN, bf16* AO, int lane) {
    const size_t t = (size_t)b * SEQ + i; const int qb = i >> 8;
    float q[128];
    { const v4u* qp = (const v4u*)(QP + t * AW + h * HD);
#pragma unroll
      for (int c = 0; c < 16; ++c) { const v4u w = qp[c]; q[8 * c + 0] = bflo(w.x); q[8 * c + 1] = bfhi(w.x); q[8 * c + 2] = bflo(w.y); q[8 * c + 3] = bfhi(w.y); q[8 * c + 4] = bflo(w.z); q[8 * c + 5] = bfhi(w.z); q[8 * c + 6] = bflo(w.w); q[8 * c + 7] = bfhi(w.w); } }
#pragma unroll
    for (int d = 0; d < 16; ++d) { const float2 cs = ROPE[i * 16 + d]; const float q1 = q[d], q2 = q[d + 16]; q[d] = q1 * cs.x - q2 * cs.y; q[d + 16] = q2 * cs.x + q1 * cs.y; }
    float g = -INFINITY;
    if (lane < qb) { const f32x4* km = (const f32x4*)(KMEAN + ((size_t)(b * NH + h) * NBLK + lane) * HD); float a = 0.f;
#pragma unroll
        for (int c = 0; c < 32; ++c) { const f32x4 k4 = km[c]; a += q[4 * c] * k4.x + q[4 * c + 1] * k4.y + q[4 * c + 2] * k4.z + q[4 * c + 3] * k4.w; }
        g = a; }
    unsigned selmask = 0u;
#pragma unroll
    for (int k = 0; k < TOPK; ++k) { const float mx = wave_max(g);
        if (mx != -INFINITY) { const unsigned long long bal = __ballot(g == mx); const int idx = __ffsll((long long)bal) - 1; selmask |= 1u << idx; if (lane == idx) g = -INFINITY; } }
    selmask |= 1u << qb;
    float s[4][4]; int blk[4]; bool valid[4];
#pragma unroll
    for (int c = 0; c < 4; ++c) { valid[c] = selmask != 0u; blk[c] = valid[c] ? (__ffs((int)selmask) - 1) : 0; selmask &= selmask - 1u; }
    float mloc = -INFINITY;
#pragma unroll
    for (int c = 0; c < 4; ++c)
#pragma unroll
        for (int r = 0; r < 4; ++r) { const int key = blk[c] * MBLK + lane + 64 * r; float sc = -INFINITY;
            if (valid[c] && key <= i) { const v4u* kp = (const v4u*)(KP + ((size_t)b * SEQ + key) * AW + h * HD); float kk[32]; float a = 0.f;
#pragma unroll
                for (int cc = 0; cc < 4; ++cc) { const v4u w = kp[cc]; kk[8 * cc + 0] = bflo(w.x); kk[8 * cc + 1] = bfhi(w.x); kk[8 * cc + 2] = bflo(w.y); kk[8 * cc + 3] = bfhi(w.y); kk[8 * cc + 4] = bflo(w.z); kk[8 * cc + 5] = bfhi(w.z); kk[8 * cc + 6] = bflo(w.w); kk[8 * cc + 7] = bfhi(w.w); }
#pragma unroll
                for (int d = 0; d < 16; ++d) { const float2 cs = ROPE[key * 16 + d]; const float k1 = kk[d], k2 = kk[d + 16]; a += q[d] * (k1 * cs.x - k2 * cs.y) + q[d + 16] * (k2 * cs.x + k1 * cs.y); }
#pragma unroll
                for (int cc = 4; cc < 16; ++cc) { const v4u w = kp[cc]; a += q[8 * cc + 0] * bflo(w.x) + q[8 * cc + 1] * bfhi(w.x) + q[8 * cc + 2] * bflo(w.y) + q[8 * cc + 3] * bfhi(w.y) + q[8 * cc + 4] * bflo(w.z) + q[8 * cc + 5] * bfhi(w.z) + q[8 * cc + 6] * bflo(w.w) + q[8 * cc + 7] * bfhi(w.w); }
                sc = a * ATT_SCALE; }
            s[c][r] = sc; mloc = fmaxf(mloc, sc); }
    const float mx = wave_max(mloc); float lsum = 0.f;
#pragma unroll
    for (int c = 0; c < 4; ++c)
#pragma unroll
        for (int r = 0; r < 4; ++r) { s[c][r] = __expf(s[c][r] - mx); lsum += s[c][r]; }
    const float l = wave_sum(lsum);
    float o0 = 0.f, o1 = 0.f;
#pragma unroll
    for (int c = 0; c < 4; ++c) { if (!valid[c]) continue;
#pragma unroll
        for (int r = 0; r < 4; ++r) { const bf16* vp = VP + ((size_t)b * SEQ + blk[c] * MBLK + 64 * r) * AW + h * HD + 2 * lane;
            for (int src = 0; src < 64; ++src) { const float p = __shfl(s[c][r], src); const unsigned w = *(const unsigned*)(vp + (size_t)src * AW); o0 += p * bflo(w); o1 += p * bfhi(w); } } }
    const float rl = 1.f / l;
    *(unsigned*)(AO + t * AW + h * HD + 2 * lane) = pk2(o0 * rl, o1 * rl);
}
__device__ __forceinline__ void naive_xattn_item(int b, int h, int i, const bf16* HQ, const float* R2, const bf16* MKV, bf16* XO, int lane) {
    const size_t t = (size_t)b * SEQ + i; const float qs = R2[t] * ATT_SCALE;
    float q[128];
    { const v4u* qp = (const v4u*)(HQ + t * XW + h * HD);
#pragma unroll
      for (int c = 0; c < 16; ++c) { const v4u w = qp[c]; q[8 * c + 0] = bflo(w.x) * qs; q[8 * c + 1] = bfhi(w.x) * qs; q[8 * c + 2] = bflo(w.y) * qs; q[8 * c + 3] = bfhi(w.y) * qs; q[8 * c + 4] = bflo(w.z) * qs; q[8 * c + 5] = bfhi(w.z) * qs; q[8 * c + 6] = bflo(w.w) * qs; q[8 * c + 7] = bfhi(w.w) * qs; } }
    float s[4]; float mloc = -INFINITY;
#pragma unroll
    for (int r = 0; r < 4; ++r) { const int key = lane + 64 * r; const v4u* kp = (const v4u*)(MKV + ((size_t)b * NMEM + key) * (2 * XW) + h * HD); float a = 0.f;
#pragma unroll
        for (int cc = 0; cc < 16; ++cc) { const v4u w = kp[cc]; a += q[8 * cc + 0] * bflo(w.x) + q[8 * cc + 1] * bfhi(w.x) + q[8 * cc + 2] * bflo(w.y) + q[8 * cc + 3] * bfhi(w.y) + q[8 * cc + 4] * bflo(w.z) + q[8 * cc + 5] * bfhi(w.z) + q[8 * cc + 6] * bflo(w.w) + q[8 * cc + 7] * bfhi(w.w); }
        s[r] = a; mloc = fmaxf(mloc, a); }
    const float mx = wave_max(mloc); float lsum = 0.f;
#pragma unroll
    for (int r = 0; r < 4; ++r) { s[r] = __expf(s[r] - mx); lsum += s[r]; }
    const float l = wave_sum(lsum);
    float o0 = 0.f, o1 = 0.f;
#pragma unroll
    for (int r = 0; r < 4; ++r) { const bf16* vp = MKV + ((size_t)b * NMEM + 64 * r) * (2 * XW) + XW + h * HD + 2 * lane;
        for (int src = 0; src < 64; ++src) { const float p = __shfl(s[r], src); const unsigned w = *(const unsigned*)(vp + (size_t)src * (2 * XW)); o0 += p * bflo(w); o1 += p * bfhi(w); } }
    const float rl = 1.f / l;
    *(unsigned*)(XO + t * XW + h * HD + 2 * lane) = pk2(o0 * rl, o1 * rl);
}

__global__ void __launch_bounds__(NWAVES * 64, 2) mk_fwd(Args args) {
    extern __shared__ __attribute__((aligned(16))) unsigned char lds[];
    LAS unsigned char* const ldsp = (LAS unsigned char*)lds;
    volatile LAS unsigned* const MISC = (volatile LAS unsigned*)(ldsp + MISC_OFF);
    const int tid = threadIdx.x, wave = __builtin_amdgcn_readfirstlane(tid >> 6);
    const int G = gridDim.x; const int bx = blockIdx.x; const int vcu = (G % 8 == 0) ? (bx % 8) * (G / 8) + bx / 8 : bx;
    unsigned char* const ws = args.ws;
    gu32* const ctl = (gu32*)(ws + WS_CTL);
    for (int u = tid; u < (LDS_BYTES - LDSCTL_OFF) / 4; u += NWAVES * 64) ((LAS unsigned*)(ldsp + LDSCTL_OFF))[u] = 0u;
    __syncthreads();
    XcdBarrier bar; bar.bar = (unsigned*)(ctl + CW_BAR); bar.x = 0; bar.st = nullptr;
    if (!MK_PER_PHASE) bar = xcd_barrier_post((unsigned*)(ctl + CW_BAR), MISC + 8);
    const int lo = args.ph_lo, hi = args.ph_hi;
#define IN(k) (lo <= (k) && (k) < hi)
#define SEAM(k) do { if (IN(k) && IN((k) + 1)) xcd_barrier(bar); } while (0)
    const int NGW = G * NWAVES, NGT = G * NWAVES * 64;
#define PHASE_IDS() int tv_ = threadIdx.x; asm volatile("" : "+v"(tv_)); const int lane = tv_ & 63; const int gw = vcu * NWAVES + wave; const int gt = vcu * (NWAVES * 64) + tv_; (void)gw; (void)gt; (void)lane

#define x_in (args.in[0])
#define mem_in (args.in[1])
#define norm_mix (args.in[2])
#define w_in (args.in[3])
#define conv_w (args.in[4])
#define w_attn_out (args.in[5])
#define w_conv_out (args.in[6])
#define w_mix_out (args.in[7])
#define norm_xattn (args.in[8])
#define norm_mem (args.in[9])
#define wq_x (args.in[10])
#define wkv_x (args.in[11])
#define wo_x (args.in[12])
#define norm_mlp (args.in[13])
#define w_up (args.in[14])
#define w_down (args.in[15])
#define norm_final (args.in[16])
    float* const out = args.out; unsigned char* const outb = (unsigned char*)args.out;
#define ROPE ((float2*)(ws + WS_ROPE))
#define KSUM ((float*)(ws + WS_KMEAN))
#define SS1 ((unsigned long long*)(ws + WS_SS1))
#define SS2 ((unsigned long long*)(ws + WS_SS2))
#define SS3 ((unsigned long long*)(ws + WS_SS3))
#define MEMN ((bf16*)(ws + WS_MEMN))
#define MKV ((bf16*)(ws + WS_MKV))
#define WIN ((bf16*)(ws + WS_WIN))
#define WM ((bf16*)(ws + WS_WM))
#define WQ ((bf16*)(ws + WS_WQ))
#define WKV ((bf16*)(ws + WS_WKV))
#define WO ((bf16*)(ws + WS_WO))
#define WUP ((bf16*)(ws + WS_WUP))
#define WD ((bf16*)(ws + WS_WD))
#define XB ((bf16*)(ws + WS_XB))
#define QP ((bf16*)(ws + WS_G))
#define KP ((bf16*)(ws + WS_G + GRP))
#define VP ((bf16*)(ws + WS_G + 2 * GRP))
#define MERGED ((bf16*)(ws + WS_MERGED))
#define WAC ((bf16*)(ws + WS_WAC))
#define U_ ((bf16*)(ws + WS_G + 3 * GRP))
#define CB ((bf16*)(ws + WS_G + 4 * GRP))
#define RATIO ((bf16*)(ws + WS_RATIO))
#define SC ((bf16*)(ws + WS_SC))
#define AOCO ((bf16*)outb)
#define HQ ((bf16*)(ws + WS_HQ))
#define XO ((bf16*)(ws + WS_XO))
#define UP ((bf16*)(ws + WS_UP))
    if (IN(0)) { PHASE_IDS();
        LAS float* scr = (LAS float*)(ldsp + RING_OFF + wave * 16384);
        constexpr int I_IN = (DM / 64) * (NPROJ / 32), I_A = (AW / 64) * (DM / 32), I_C = I_A, I_M = (DM / 64) * (DM / 32), I_Q = (DM / 64) * (XW / 32), I_KV = (DM / 64) * (2 * XW / 32),
                      I_O = (XW / 64) * (DM / 32), I_UP = (DM / 64) * (DFF / 32), I_D = (DFF / 64) * (DM / 32);
        constexpr int NITEMS = I_IN + I_A + I_C + I_M + I_Q + I_KV + I_O + I_UP + I_D;
        for (int it = gw; it < NITEMS; it += NGW) {
            int r = it;
            if (r < I_IN) { const int n0 = 32 * (r % (NPROJ / 32)); int d;
                if (n0 < 3072) d = n0;
                else if (n0 < 4096) { const int ch = n0 - 3072; d = 3072 + 256 * (ch >> 7) + (ch & 127); }
                else if (n0 < 5120) d = 5120 + (n0 - 4096);
                else if (n0 < 6144) { const int ch = n0 - 5120; d = 3072 + 256 * (ch >> 7) + 128 + (ch & 127); }
                else if (n0 < 8192) { const int ch = n0 - 6144; d = 6144 + 256 * (ch >> 7) + (ch & 127); }
                else { const int ch = n0 - 8192; d = 6144 + 256 * (ch >> 7) + 128 + (ch & 127); }
                p0_transpose_item(w_in, DM, NPROJ, WIN, DM, 0, d - n0, nullptr, scr, r, lane); continue; } r -= I_IN;
            if (r < I_A) { p0_transpose_item(w_attn_out, AW, DM, WAC, 2 * AW, 0, 0, nullptr, scr, r, lane); continue; } r -= I_A;
            if (r < I_C) { p0_transpose_item(w_conv_out, CWID, DM, WAC, 2 * AW, AW, 0, nullptr, scr, r, lane); continue; } r -= I_C;
            if (r < I_M) { p0_transpose_item(w_mix_out, DM, DM, WM, DM, 0, 0, nullptr, scr, r, lane); continue; } r -= I_M;
            if (r < I_Q) { p0_transpose_item(wq_x, DM, XW, WQ, DM, 0, 0, norm_xattn, scr, r, lane); continue; } r -= I_Q;
            if (r < I_KV) { p0_transpose_item(wkv_x, DM, 2 * XW, WKV, DM, 0, 0, nullptr, scr, r, lane); continue; } r -= I_KV;
            if (r < I_O) { p0_transpose_item(wo_x, XW, DM, WO, XW, 0, 0, nullptr, scr, r, lane); continue; } r -= I_O;
            if (r < I_UP) { p0_transpose_item(w_up, DM, DFF, WUP, DM, 0, 0, norm_mlp, scr, r, lane); continue; } r -= I_UP;
            p0_transpose_item(w_down, DFF, DM, WD, DFF, 0, 0, nullptr, scr, r, lane);
        }
        for (int m = gw; m < M; m += NGW) rms_row_to_bf16(x_in + (size_t)m * DM, norm_mix, XB + (size_t)m * DM, lane);
        for (int m = gw; m < NB * NMEM; m += NGW) rms_row_to_bf16(mem_in + (size_t)m * DM, norm_mem, MEMN + (size_t)m * DM, lane);
        for (int e = gt; e < 3 * M; e += NGT) SS1[e] = 0ull;
        for (int e = gt; e < NB * NH * NBLK * HD; e += NGT) KSUM[e] = 0.f;
        for (int e = gt; e < SEQ * 16; e += NGT) { const int pos = e >> 4, j = e & 15;
            const float inv_freq = ROPE_INV_FREQ[j]; const float ang = (float)pos * inv_freq;
            const double turns = (double)ang * 0.15915494309189535; const float fr = (float)(turns - rint(turns));
            ROPE[e] = make_float2(__builtin_amdgcn_cosf(fr), __builtin_amdgcn_sinf(fr)); }
    }
    SEAM(0);
    if (IN(1)) {
        { pg8::Gemm g{XB, WIN, M, NPROJ, DM}; pg8::StaticOrder S; S.init(M, NPROJ, G, bx);
          pg8::EpiProj E{QP, (size_t)(GRP / 2), U_, CB, RATIO, SC, (const float*)ROPE, KSUM};
          pg8::gemm_phase<pg8::EpiProj, pg8::StaticOrder, true, true>(ldsp + RING_OFF, g, S, E); }
        { pg8::Gemm g{MEMN, WKV, NB * NMEM, 2 * XW, DM}; pg8::StaticOrder S; S.init(NB * NMEM, 2 * XW, G, bx);
          pg8::EpiBf16G E{MKV, MKV, 1 << 30, 0, 1 << 30, 2 * XW, nullptr};
          pg8::gemm_phase<pg8::EpiBf16G, pg8::StaticOrder, true, true>(ldsp + RING_OFF, g, S, E); }
    }
    SEAM(1);
    if (IN(2)) { PHASE_IDS();
        { att::Seam S; char* albase = (char*)lds + RING_OFF; unsigned* selw = (unsigned*)(albase + att::LDS_SEL); constexpr int NIT = NB * NH * 16; constexpr long VOFF = (long)(GRP / 2);
          for (int L = vcu; L < NIT; L += G) { int tv = threadIdx.x; asm volatile("" : "+v"(tv)); const int bh = L >> 4, b = bh >> 3, h = bh & 7, s = L & 15;
              const bf16* Kp = KP + (size_t)b * SEQ * AW + h * HD; const float* KM = KSUM + (size_t)bh * NBLK * HD;
              const bf16* Q0 = QP + ((size_t)b * SEQ + (size_t)s * 256) * AW + h * HD; const bf16* Q1 = QP + ((size_t)b * SEQ + (size_t)(31 - s) * 256) * AW + h * HD;
              att::moba_gate<AW>(tv, Q0, KM, s, selw); att::moba_gate<AW>(tv, Q1, KM, 31 - s, selw + 256);
              att::attn_prime<AW, AW, VOFF>(tv, Q0, Kp, albase, S);
              for (int pass = 0; pass < 2; ++pass) { const int qb = pass ? 31 - s : s;
                  bf16* Op = AOCO + ((size_t)b * SEQ + (size_t)qb * 256) * (2 * AW) + h * HD;
                  att::attn_block<true, AW, AW, VOFF, 2 * AW>(tv, Kp, Op, 4 * (qb + 1), pass * 256, Q1, Kp, albase, S); } } }
        for (int e = gt; e < M * (CWID / 8); e += NGT) { const int c = (e & 127) * 8; const int t = e >> 7; const int s = t & (SEQ - 1);
            const v4u u0 = *(const v4u*)(U_ + (size_t)t * CWID + c); v4u u1 = {0u, 0u, 0u, 0u}, u2 = {0u, 0u, 0u, 0u};
            if (s >= 1) u1 = *(const v4u*)(U_ + (size_t)(t - 1) * CWID + c);
            if (s >= 2) u2 = *(const v4u*)(U_ + (size_t)(t - 2) * CWID + c);
            const v4u cb = *(const v4u*)(CB + (size_t)t * CWID + c);
            const f32x4 w0a = *(const f32x4*)(conv_w + c), w0b = *(const f32x4*)(conv_w + c + 4), w1a = *(const f32x4*)(conv_w + CWID + c), w1b = *(const f32x4*)(conv_w + CWID + c + 4),
                        w2a = *(const f32x4*)(conv_w + 2 * CWID + c), w2b = *(const f32x4*)(conv_w + 2 * CWID + c + 4);
            float y[8];
            y[0] = w2a.x * bflo(u0.x) + w1a.x * bflo(u1.x) + w0a.x * bflo(u2.x); y[1] = w2a.y * bfhi(u0.x) + w1a.y * bfhi(u1.x) + w0a.y * bfhi(u2.x);
            y[2] = w2a.z * bflo(u0.y) + w1a.z * bflo(u1.y) + w0a.z * bflo(u2.y); y[3] = w2a.w * bfhi(u0.y) + w1a.w * bfhi(u1.y) + w0a.w * bfhi(u2.y);
            y[4] = w2b.x * bflo(u0.z) + w1b.x * bflo(u1.z) + w0b.x * bflo(u2.z); y[5] = w2b.y * bfhi(u0.z) + w1b.y * bfhi(u1.z) + w0b.y * bfhi(u2.z);
            y[6] = w2b.z * bflo(u0.w) + w1b.z * bflo(u1.w) + w0b.z * bflo(u2.w); y[7] = w2b.w * bfhi(u0.w) + w1b.w * bfhi(u1.w) + w0b.w * bfhi(u2.w);
            v4u o; o.x = pk2(bflo(cb.x) * y[0], bfhi(cb.x) * y[1]); o.y = pk2(bflo(cb.y) * y[2], bfhi(cb.y) * y[3]); o.z = pk2(bflo(cb.z) * y[4], bfhi(cb.z) * y[5]); o.w = pk2(bflo(cb.w) * y[6], bfhi(cb.w) * y[7]);
            *(v4u*)(AOCO + (size_t)t * (2 * AW) + AW + c) = o; }
    }
    SEAM(2);
    if (IN(3)) {
        pg8::Gemm g{AOCO, WAC, M, DM, 2 * AW}; pg8::StaticOrder S; S.init(M, DM, G, bx); pg8::EpiMerged E{MERGED, RATIO, SC, DM};
        pg8::gemm_phase<pg8::EpiMerged, pg8::StaticOrder, true, true>(ldsp + RING_OFF, g, S, E);
    }
    SEAM(3);
    if (IN(4)) {
        pg8::Gemm g{MERGED, WM, M, DM, DM}; pg8::StaticOrder S; S.init(M, DM, G, bx); pg8::EpiResid E{x_in, out, XB, DM, SS1};
        pg8::gemm_phase<pg8::EpiResid, pg8::StaticOrder, true, true>(ldsp + RING_OFF, g, S, E);
    }
    SEAM(4);
    if (IN(5)) {
        pg8::Gemm g{XB, WQ, M, XW, DM}; pg8::StaticOrder S; S.init(M, XW, G, bx); pg8::EpiBf16G E{HQ, HQ, 1 << 30, 0, 1 << 30, XW, SS1};
        pg8::gemm_phase<pg8::EpiBf16G, pg8::StaticOrder, true, true>(ldsp + RING_OFF, g, S, E);
    }
    SEAM(5);
    if (IN(6)) {
        att::Seam S; char* albase = (char*)lds + RING_OFF; constexpr int NIT = NB * XH * 32;
        for (int L = vcu; L < NIT; L += G) { int tv = threadIdx.x; asm volatile("" : "+v"(tv)); const int bh = L >> 5, b = bh >> 2, h = bh & 3, qb = L & 31;
            const bf16* Qp = HQ + ((size_t)b * SEQ + (size_t)qb * 256) * XW + h * HD; const bf16* Kp = MKV + (size_t)b * NMEM * (2 * XW) + h * HD;
            bf16* Op = XO + ((size_t)b * SEQ + (size_t)qb * 256) * XW + h * HD;
            att::attn_prime<XW, 2 * XW, (long)XW>(tv, Qp, Kp, albase, S);
            att::attn_block<false, XW, 2 * XW, (long)XW, XW>(tv, Kp, Op, NMEM / 64, 0, Qp, Kp, albase, S); }
    }
    SEAM(6);
    if (IN(7)) {
        pg8::Gemm g{XO, WO, M, DM, XW}; pg8::StaticOrder S; S.init(M, DM, G, bx); pg8::EpiResid E{out, out, XB, DM, SS2};
        pg8::gemm_phase<pg8::EpiResid, pg8::StaticOrder, true, true>(ldsp + RING_OFF, g, S, E);
    }
    SEAM(7);
    if (IN(8)) {
        pg8::Gemm g{XB, WUP, M, DFF, DM}; pg8::StaticOrder S; S.init(M, DFF, G, bx); pg8::EpiUp E{UP, DFF, SS2};
        pg8::gemm_phase<pg8::EpiUp, pg8::StaticOrder, true, true>(ldsp + RING_OFF, g, S, E);
    }
    SEAM(8);
    if (IN(9)) {
        pg8::Gemm g{UP, WD, M, DM, DFF}; pg8::StaticOrder S; S.init(M, DM, G, bx); pg8::EpiResid E{out, out, nullptr, DM, SS3};
        pg8::gemm_phase<pg8::EpiResid, pg8::StaticOrder, true, true>(ldsp + RING_OFF, g, S, E);
    }
    SEAM(9);
    if (IN(10)) { PHASE_IDS();
        for (int m = gw; m < M; m += NGW) { GAS f32x4* xr = (GAS f32x4*)(out + (size_t)m * DM) + lane; const GAS f32x4* gr = (const GAS f32x4*)norm_final + lane;
            const float rstd = pg8::rstd_from_ss(SS3, m);
#pragma unroll
            for (int j = 0; j < 8; ++j) { const f32x4 v = xr[64 * j]; const f32x4 gg = gr[64 * j]; xr[64 * j] = (f32x4){v.x * rstd * gg.x, v.y * rstd * gg.y, v.z * rstd * gg.z, v.w * rstd * gg.w}; } }
    }
#undef IN
#undef SEAM
}
#undef x_in
#undef mem_in


extern "C" void kernel_launch(void* const* d_in, const int* in_sizes, int n_in, void* d_out, int out_size, void* d_ws, size_t ws_size, hipStream_t stream) {
    static int grid = 0;
    if (grid == 0) {
        if (n_in != 17 || in_sizes[0] != M * DM || out_size != M * DM || ws_size < WS_END) { fprintf(stderr, "kernel_launch: unexpected shapes: n_in %d in0 %d out %d ws %zu (need %zu)\n", n_in, n_in > 0 ? in_sizes[0] : -1, out_size, ws_size, (size_t)WS_END); grid = -1; return; }
        int dev = 0, cus = 0, per_cu = 0;
        if (hipGetDevice(&dev) != hipSuccess || hipDeviceGetAttribute(&cus, hipDeviceAttributeMultiprocessorCount, dev) != hipSuccess) { fprintf(stderr, "kernel_launch: device query failed\n"); grid = -1; return; }
        if (hipFuncSetAttribute((const void*)mk_fwd, hipFuncAttributeMaxDynamicSharedMemorySize, LDS_BYTES) != hipSuccess) { fprintf(stderr, "kernel_launch: hipFuncSetAttribute failed\n"); grid = -1; return; }
        if (hipOccupancyMaxActiveBlocksPerMultiprocessor(&per_cu, (const void*)mk_fwd, NWAVES * 64, LDS_BYTES) != hipSuccess || per_cu < 1) fprintf(stderr, "kernel_launch: note: occupancy query reports %d workgroups per CU\n", per_cu);
        (void)hipGetLastError();
        grid = cus;
    }
    if (grid < 0) return;
    if (hipMemsetAsync((char*)d_ws + WS_CTL, 0, CTL_ZERO_BYTES, stream) != hipSuccess) { fprintf(stderr, "kernel_launch: hipMemsetAsync failed\n"); return; }
    Args a{};
    for (int i = 0; i < 17; ++i) a.in[i] = (const float*)d_in[i];
    a.out = (float*)d_out; a.ws = (unsigned char*)d_ws;
#if MK_PER_PHASE
    for (int p = 0; p < N_PHASES; ++p) { a.ph_lo = p; a.ph_hi = p + 1; a.li = p; hipLaunchKernelGGL(mk_fwd, dim3(grid), dim3(NWAVES * 64), LDS_BYTES, stream, a); }
#else
    a.ph_lo = 0; a.ph_hi = N_PHASES; a.li = 0;
    hipLaunchKernelGGL(mk_fwd, dim3(grid), dim3(NWAVES * 64), LDS_BYTES, stream, a);
#endif
    const hipError_t le = hipPeekAtLastError();
    if (le != hipSuccess) fprintf(stderr, "kernel_launch: launch failed: %s\n", hipGetErrorName(le));
}
```

```cpp
#include <hip/hip_runtime.h>
#include <cstdio>
#include <cstdint>
namespace pg8 {
#define PG8_LAS __attribute__((address_space(3)))
typedef unsigned short bf16_t;
typedef short bf16x8 __attribute__((ext_vector_type(8)));
typedef float f32x4 __attribute__((ext_vector_type(4)));
typedef unsigned u32x4 __attribute__((ext_vector_type(4)));
constexpr int BM = 256, BK = 64, HALF = 128, HTB = HALF * BK * 2  , STAGE_BYTES = 8 * HTB, NXCD = 8, WGM = 8;

__host__ __device__ __forceinline__ int lds_byte(int r, int c) { const int st = (r >> 4) * 2 + (c >> 5), rr = r & 15, cc = c & 31, ob = rr * 64 + cc * 2; return st * 1024 + (ob ^ (((ob >> 9) & 1) << 5)); }
__host__ __device__ __forceinline__ void stage_rc(int b, int& R, int& C) { const int st = b / 1024, sb = b % 1024, swz = sb ^ (((sb >> 9) & 1) << 5); R = (st >> 1) * 16 + swz / 64; C = (st & 1) * 32 + (swz % 64) / 2; }
__host__ __device__ __forceinline__ int perm32(int rho) { const int n = rho >> 4, i = rho & 15; return 8 * (i >> 2) + 4 * n + (i & 3); }

struct Unit { int pm, pn; };
struct Gemm { const bf16_t* A; const bf16_t* Bt; int M, N, K; };

struct StaticOrder {
    int nM, nN, nwg, G, c;
    __host__ __device__ void init(int M, int N, int G_, int c_) { nM = M / BM; nN = N / BM; nwg = nM * nN; G = G_; c = c_; }
    __host__ __device__ bool next(int i, Unit& u) const {
        const long L = (long)i * G + c; if (L >= nwg) return false;
        int wgid = (int)L; { const int q = nwg / NXCD, r = nwg % NXCD, xcd = wgid % NXCD, off = wgid / NXCD; wgid = (xcd < r ? xcd * (q + 1) : r * (q + 1) + (xcd - r) * q) + off; }
        const int nig = WGM * nN, gid = wgid / nig, fm = gid * WGM, gsz = (nM - fm) < WGM ? (nM - fm) : WGM;
        u.pm = fm + ((wgid % nig) % gsz); u.pn = (wgid % nig) / gsz; return true;
    }
    __device__ __forceinline__ void a_ready(const Unit&) const {}
    __device__ __forceinline__ void done(const Unit&) const {}
};


__device__ __forceinline__ unsigned cvt_pk_bf16(float lo, float hi) { unsigned r; asm volatile("v_cvt_pk_bf16_f32 %0, %1, %2" : "=v"(r) : "v"(lo), "v"(hi)); return r; }
typedef unsigned u32x2 __attribute__((ext_vector_type(2)));

constexpr float SS_SCALE = 16777216.f, SS_INV = 1.f / (16777216.f * 2048.f), RMS_EPS = 1e-6f;
__device__ __forceinline__ float rstd_from_ss(const unsigned long long* ss, int row) { return 1.f / sqrtf((float)ss[row] * SS_INV + RMS_EPS); }
struct EpiBf16G {
    static constexpr bool PERM = true, AFTER_DRAIN = false, MIDK = false;
    bf16_t* g0; bf16_t* g1; int tsplit; size_t gstride; int gcols; int ldc; const unsigned long long* ss;
    __device__ __forceinline__ void operator()(const f32x4 (&acc)[2][2][4][2], const Unit& u, int wr, int wc, int fr, int fq) const {
        const int row0 = u.pm * BM + wr * 64 + fr; int colt = u.pn * BM; const int t = colt / gcols; colt -= t * gcols;
        bf16_t* base = (t < tsplit) ? g0 + (size_t)t * gstride : g1 + (size_t)(t - tsplit) * gstride;
        const int col0 = colt + wc * 32 + 8 * fq;
#pragma unroll
        for (int ai = 0; ai < 2; ++ai)
#pragma unroll
            for (int m = 0; m < 4; ++m) { bf16_t* rowp = base + (size_t)(row0 + ai * HALF + m * 16) * ldc + col0; const float s = ss ? rstd_from_ss(ss, row0 + ai * HALF + m * 16) : 1.f;
#pragma unroll
                for (int bj = 0; bj < 2; ++bj) { const f32x4 v0 = acc[ai][bj][m][0] * s, v1 = acc[ai][bj][m][1] * s;
                    u32x4 w; w.x = cvt_pk_bf16(v0[0], v0[1]); w.y = cvt_pk_bf16(v0[2], v0[3]); w.z = cvt_pk_bf16(v1[0], v1[1]); w.w = cvt_pk_bf16(v1[2], v1[3]);
                    *(u32x4*)(rowp + bj * HALF) = w; } }
    }
};
struct EpiResid {
    static constexpr bool PERM = false, AFTER_DRAIN = false, MIDK = false;
    const float* base; float* out; bf16_t* outb; int ldc; unsigned long long* ss;
    __device__ __forceinline__ void operator()(const f32x4 (&acc)[2][2][4][2], const Unit& u, int wr, int wc, int fr, int fq) const {
        const int row0 = u.pm * BM + wr * 64 + fr, col0 = u.pn * BM + wc * 32 + 4 * fq;
#pragma unroll
        for (int ai = 0; ai < 2; ++ai)
#pragma unroll
            for (int m = 0; m < 4; ++m) { const size_t off = (size_t)(row0 + ai * HALF + m * 16) * ldc + col0; float sq = 0.f;
#pragma unroll
                for (int bj = 0; bj < 2; ++bj)
#pragma unroll
                    for (int n = 0; n < 2; ++n) { const f32x4 o = *(const f32x4*)(base + off + bj * HALF + n * 16) + acc[ai][bj][m][n];
                        *(f32x4*)(out + off + bj * HALF + n * 16) = o; sq += (o[0] * o[0] + o[1] * o[1]) + (o[2] * o[2] + o[3] * o[3]);
                        if (outb) { u32x2 w; w.x = cvt_pk_bf16(o[0], o[1]); w.y = cvt_pk_bf16(o[2], o[3]); *(u32x2*)(outb + off + bj * HALF + n * 16) = w; } }
                if (ss) { sq += __shfl_xor(sq, 16); sq += __shfl_xor(sq, 32);
                    if (fq == 0) __hip_atomic_fetch_add(ss + row0 + ai * HALF + m * 16, (unsigned long long)__float2ull_rn(sq * SS_SCALE), __ATOMIC_RELAXED, __HIP_MEMORY_SCOPE_AGENT); }
                if (m & 1) asm volatile("" ::: "memory"); }
    }
};
struct EpiUp {
    static constexpr bool PERM = true, AFTER_DRAIN = false, MIDK = false;
    bf16_t* O; int ldc; const unsigned long long* ss;
    __device__ __forceinline__ void operator()(const f32x4 (&acc)[2][2][4][2], const Unit& u, int wr, int wc, int fr, int fq) const {
        const int row0 = u.pm * BM + wr * 64 + fr, col0 = u.pn * BM + wc * 32 + 8 * fq;
#pragma unroll
        for (int ai = 0; ai < 2; ++ai)
#pragma unroll
            for (int m = 0; m < 4; ++m) { const int r = row0 + ai * HALF + m * 16; const float s = rstd_from_ss(ss, r); bf16_t* rowp = O + (size_t)r * ldc + col0;
#pragma unroll
                for (int bj = 0; bj < 2; ++bj) { f32x4 v0 = acc[ai][bj][m][0] * s, v1 = acc[ai][bj][m][1] * s;
#pragma unroll
                    for (int e = 0; e < 4; ++e) { v0[e] = fmaxf(v0[e], 0.f); v1[e] = fmaxf(v1[e], 0.f); }
                    v0 = v0 * v0; v1 = v1 * v1;
                    u32x4 w; w.x = cvt_pk_bf16(v0[0], v0[1]); w.y = cvt_pk_bf16(v0[2], v0[3]); w.z = cvt_pk_bf16(v1[0], v1[1]); w.w = cvt_pk_bf16(v1[2], v1[3]);
                    *(u32x4*)(rowp + bj * HALF) = w; } }
    }
};


__device__ __forceinline__ float bf_lo(unsigned w) { return __uint_as_float(w << 16); }
__device__ __forceinline__ float bf_hi(unsigned w) { return __uint_as_float(w & 0xffff0000u); }
typedef float f32x2p __attribute__((ext_vector_type(2)));
struct EpiProj {
    static constexpr bool PERM = true, AFTER_DRAIN = false, MIDK = false;
    bf16_t* QKV; size_t gstr; bf16_t* U; bf16_t* CBo; bf16_t* RATIO; bf16_t* SC; const float* rope; float* ksum;
    __device__ __forceinline__ void operator()(const f32x4 (&acc)[2][2][4][2], const Unit& u, int wr, int wc, int fr, int fq) const {
        asm volatile("" : "+v"(fr), "+v"(fq));
        const int pn = u.pn; const int row0 = u.pm * BM + wr * 64 + fr;
        if (pn < 12) {
            const int grp = pn >> 2; bf16_t* base = QKV + (size_t)grp * gstr; const int col0 = (pn & 3) * BM + wc * 32 + 8 * fq;
            const bool rope_wave = (grp < 2) && (wc == 0);
            const float sg = (fq < 2) ? -1.f : 1.f;
            f32x4 ks[2][2];
#pragma unroll
            for (int bj = 0; bj < 2; ++bj)
#pragma unroll
                for (int n = 0; n < 2; ++n) ks[bj][n] = (f32x4){0.f, 0.f, 0.f, 0.f};
#pragma unroll
            for (int ai = 0; ai < 2; ++ai)
#pragma unroll
                for (int m = 0; m < 4; ++m) { const int r = row0 + ai * HALF + m * 16; bf16_t* rowp = base + (size_t)r * 1024 + col0;
                    f32x4 t0 = {1.f, 0.f, 1.f, 0.f}, t1 = t0, t2 = t0, t3 = t0;
                    if (rope_wave) { const f32x4* rp = (const f32x4*)(rope + ((size_t)(r & 8191) * 16 + 8 * (fq & 1)) * 2); t0 = rp[0]; t1 = rp[1]; t2 = rp[2]; t3 = rp[3]; }
#pragma unroll
                    for (int bj = 0; bj < 2; ++bj) { f32x4 v0 = acc[ai][bj][m][0], v1 = acc[ai][bj][m][1];
                        if (rope_wave) { f32x4 p0, p1;
#pragma unroll
                            for (int e2 = 0; e2 < 4; ++e2) { p0[e2] = __shfl_xor(v0[e2], 32); p1[e2] = __shfl_xor(v1[e2], 32); }
                            v0 = (f32x4){v0[0] * t0[0] + sg * p0[0] * t0[1], v0[1] * t0[2] + sg * p0[1] * t0[3], v0[2] * t1[0] + sg * p0[2] * t1[1], v0[3] * t1[2] + sg * p0[3] * t1[3]};
                            v1 = (f32x4){v1[0] * t2[0] + sg * p1[0] * t2[1], v1[1] * t2[2] + sg * p1[1] * t2[3], v1[2] * t3[0] + sg * p1[2] * t3[1], v1[3] * t3[2] + sg * p1[3] * t3[3]}; }
                        if (grp == 1) { ks[bj][0] += v0; ks[bj][1] += v1; }
                        u32x4 w; w.x = cvt_pk_bf16(v0[0], v0[1]); w.y = cvt_pk_bf16(v0[2], v0[3]); w.z = cvt_pk_bf16(v1[0], v1[1]); w.w = cvt_pk_bf16(v1[2], v1[3]);
                        *(u32x4*)(rowp + bj * HALF) = w; } }
            if (grp == 1) {
                float* kd = ksum + ((size_t)(((u.pm >> 5) * 8 + 2 * (pn - 4)) * 32 + (u.pm & 31))) * 128 + wc * 32 + 8 * fq;
#pragma unroll
                for (int bj = 0; bj < 2; ++bj)
#pragma unroll
                    for (int n = 0; n < 2; ++n)
#pragma unroll
                        for (int e2 = 0; e2 < 4; ++e2) { float s = ks[bj][n][e2]; s += __shfl_xor(s, 1); s += __shfl_xor(s, 2); s += __shfl_xor(s, 4); s += __shfl_xor(s, 8);
                            if (fr == 0) __hip_atomic_fetch_add(kd + (size_t)bj * 32 * 128 + 4 * n + e2, s, __ATOMIC_RELAXED, __HIP_MEMORY_SCOPE_AGENT); }
            }
        } else if (pn < 20) {
            const int col0 = (pn - 12) * HALF + wc * 32 + 8 * fq;
#pragma unroll
            for (int ai = 0; ai < 2; ++ai)
#pragma unroll
                for (int m = 0; m < 4; ++m) { const int r = row0 + ai * HALF + m * 16; const f32x4 v0 = acc[ai][0][m][0] * acc[ai][1][m][0], v1 = acc[ai][0][m][1] * acc[ai][1][m][1];
                    u32x4 w; w.x = cvt_pk_bf16(v0[0], v0[1]); w.y = cvt_pk_bf16(v0[2], v0[3]); w.z = cvt_pk_bf16(v1[0], v1[1]); w.w = cvt_pk_bf16(v1[2], v1[3]);
                    *(u32x4*)(U + (size_t)r * 1024 + col0) = w; }
        } else if (pn < 24) {
            const int col0 = (pn - 20) * BM + wc * 32 + 8 * fq;
#pragma unroll
            for (int ai = 0; ai < 2; ++ai)
#pragma unroll
                for (int m = 0; m < 4; ++m) { bf16_t* rowp = CBo + (size_t)(row0 + ai * HALF + m * 16) * 1024 + col0;
#pragma unroll
                    for (int bj = 0; bj < 2; ++bj) { const f32x4 v0 = acc[ai][bj][m][0], v1 = acc[ai][bj][m][1];
                        u32x4 w; w.x = cvt_pk_bf16(v0[0], v0[1]); w.y = cvt_pk_bf16(v0[2], v0[3]); w.z = cvt_pk_bf16(v1[0], v1[1]); w.w = cvt_pk_bf16(v1[2], v1[3]);
                        *(u32x4*)(rowp + bj * HALF) = w; } }
        } else {
            const int col0 = (pn - 24) * HALF + wc * 32 + 8 * fq;
#pragma unroll
            for (int ai = 0; ai < 2; ++ai)
#pragma unroll
                for (int m = 0; m < 4; ++m) { const size_t off = (size_t)(row0 + ai * HALF + m * 16) * 2048 + col0; f32x4 rt[2], sv[2];
#pragma unroll
                    for (int n = 0; n < 2; ++n)
#pragma unroll
                        for (int e2 = 0; e2 < 4; ++e2) { const float ea = __expf(fminf(-acc[ai][0][m][n][e2], 80.f)), ec = __expf(fminf(-acc[ai][1][m][n][e2], 80.f));
                            sv[n][e2] = __builtin_amdgcn_rcpf(1.f + ec); rt[n][e2] = (1.f + ec) * __builtin_amdgcn_rcpf(1.f + ea); }
                    u32x4 w; w.x = cvt_pk_bf16(rt[0][0], rt[0][1]); w.y = cvt_pk_bf16(rt[0][2], rt[0][3]); w.z = cvt_pk_bf16(rt[1][0], rt[1][1]); w.w = cvt_pk_bf16(rt[1][2], rt[1][3]);
                    *(u32x4*)(RATIO + off) = w;
                    u32x4 w2; w2.x = cvt_pk_bf16(sv[0][0], sv[0][1]); w2.y = cvt_pk_bf16(sv[0][2], sv[0][3]); w2.z = cvt_pk_bf16(sv[1][0], sv[1][1]); w2.w = cvt_pk_bf16(sv[1][2], sv[1][3]);
                    *(u32x4*)(SC + off) = w2; }
        }
    }
};
struct EpiMerged {
    static constexpr bool PERM = true, AFTER_DRAIN = false, MIDK = true;
    bf16_t* O; const bf16_t* ratio; const bf16_t* sc; int ldc;
    __device__ __forceinline__ void mid(f32x4 (&acc)[2][2][4][2], const Unit& u, int wr, int wc, int fr, int fq) const {
        asm volatile("" : "+v"(fr), "+v"(fq));
        const int row0 = u.pm * BM + wr * 64 + fr, col0 = u.pn * BM + wc * 32 + 8 * fq;
#pragma unroll
        for (int ai = 0; ai < 2; ++ai) {
#pragma unroll
            for (int m = 0; m < 4; ++m) { const bf16_t* rp = ratio + (size_t)(row0 + ai * HALF + m * 16) * ldc + col0;
#pragma unroll
                for (int bj = 0; bj < 2; ++bj) { const u32x4 w = *(const u32x4*)(rp + bj * HALF);
                    acc[ai][bj][m][0] *= (f32x4){bf_lo(w.x), bf_hi(w.x), bf_lo(w.y), bf_hi(w.y)}; acc[ai][bj][m][1] *= (f32x4){bf_lo(w.z), bf_hi(w.z), bf_lo(w.w), bf_hi(w.w)}; } }
            asm volatile("" ::: "memory"); }
    }
    __device__ __forceinline__ void operator()(const f32x4 (&acc)[2][2][4][2], const Unit& u, int wr, int wc, int fr, int fq) const {
        asm volatile("" : "+v"(fr), "+v"(fq));
        const int row0 = u.pm * BM + wr * 64 + fr, col0 = u.pn * BM + wc * 32 + 8 * fq;
#pragma unroll
        for (int ai = 0; ai < 2; ++ai) {
#pragma unroll
            for (int m = 0; m < 4; ++m) { const size_t off = (size_t)(row0 + ai * HALF + m * 16) * ldc + col0;
#pragma unroll
                for (int bj = 0; bj < 2; ++bj) { const u32x4 s = *(const u32x4*)(sc + off + bj * HALF);
                    const f32x4 v0 = acc[ai][bj][m][0] * (f32x4){bf_lo(s.x), bf_hi(s.x), bf_lo(s.y), bf_hi(s.y)}, v1 = acc[ai][bj][m][1] * (f32x4){bf_lo(s.z), bf_hi(s.z), bf_lo(s.w), bf_hi(s.w)};
                    u32x4 w; w.x = cvt_pk_bf16(v0[0], v0[1]); w.y = cvt_pk_bf16(v0[2], v0[3]); w.z = cvt_pk_bf16(v1[0], v1[1]); w.w = cvt_pk_bf16(v1[2], v1[3]);
                    *(u32x4*)(O + off + bj * HALF) = w; } }
            asm volatile("" ::: "memory"); }
    }
};
template <class Epi, class Sched, bool ALIGN_EPI = false, bool SP2 = false>
__device__ __forceinline__ void gemm_phase(PG8_LAS unsigned char* lds, const Gemm g, const Sched& S, const Epi& E) {
    const int tid = threadIdx.x, wid = __builtin_amdgcn_readfirstlane(tid >> 6), lane = tid & 63, wr = wid >> 2, wc = wid & 3, fr = lane & 15, fq = lane >> 4;
    const int K = g.K, nt = K / BK;
    unsigned voffA[2], voffB[2];
#pragma unroll
    for (int i = 0; i < 2; ++i) { int R, C; stage_rc(tid * 16 + i * 8192, R, C); const int Rb = Epi::PERM ? ((R & ~31) + perm32(R & 31)) : R;
        voffA[i] = (unsigned)(R * K + C) * 2u; voffB[i] = (unsigned)(Rb * K + C) * 2u; }
    const size_t kstep = (size_t)(BK * 2);
    const size_t hstep = (size_t)HALF * K * 2;
    const size_t tstep = 2 * hstep;
    const unsigned ldsw = (unsigned)wid * 1024u;
    const int aoff = lds_byte(wr * 64 + fr, fq * 8), boff = lds_byte(wc * 32 + fr, fq * 8);
#define PG8_SA(b, h) (((b) * 2 + (h)) * HTB)
#define PG8_SB(b, h) ((4 + (b) * 2 + (h)) * HTB)
#define PG8_STAGE(bufoff, gbase, voff) do { _Pragma("unroll") for (int _i = 0; _i < 2; ++_i) \
        __builtin_amdgcn_global_load_lds((const unsigned*)((const char*)(gbase) + (voff)[_i]), (PG8_LAS unsigned*)(lds + (bufoff) + ldsw + _i * 8192), 16, 0, 0); } while (0)
#define PG8_LDA(dst, b, h) do { _Pragma("unroll") for (int m = 0; m < 4; ++m) _Pragma("unroll") for (int k = 0; k < 2; ++k) dst[m][k] = *(const PG8_LAS bf16x8*)(lds + PG8_SA(b, h) + aoff + m * 2048 + k * 1024); } while (0)
#define PG8_LDB(dst, b, h) do { _Pragma("unroll") for (int n = 0; n < 2; ++n) _Pragma("unroll") for (int k = 0; k < 2; ++k) dst[n][k] = *(const PG8_LAS bf16x8*)(lds + PG8_SB(b, h) + boff + n * 2048 + k * 1024); } while (0)
#define PG8_MMA(ai, bj, At, Bt) do { __builtin_amdgcn_s_setprio(1); _Pragma("unroll") for (int m = 0; m < 4; ++m) _Pragma("unroll") for (int n = 0; n < 2; ++n) _Pragma("unroll") for (int k = 0; k < 2; ++k) \
        acc[ai][bj][m][n] = __builtin_amdgcn_mfma_f32_16x16x32_bf16(Bt[n][k], At[m][k], acc[ai][bj][m][n], 0, 0, 0); __builtin_amdgcn_s_setprio(0); } while (0)
#define PG8_WAIT_V(n) asm volatile("s_waitcnt vmcnt(" #n ")" ::: "memory")
#define PG8_WAIT_L(n) asm volatile("s_waitcnt lgkmcnt(" #n ")" ::: "memory")
#define PG8_BAR __builtin_amdgcn_s_barrier()
#define PG8_SCHED __builtin_amdgcn_sched_barrier(0)
    Unit cur, nxt; int ui = 0;
    if (!S.next(0, cur)) return;
    f32x4 acc[2][2][4][2];
#pragma unroll
    for (int a = 0; a < 2; ++a)
#pragma unroll
        for (int b = 0; b < 2; ++b)
#pragma unroll
            for (int m = 0; m < 4; ++m)
#pragma unroll
                for (int n = 0; n < 2; ++n) acc[a][b][m][n] = (f32x4){0.f, 0.f, 0.f, 0.f};
    bf16x8 At[4][2], B0[2][2], B1[2][2];
    const char* cA = (const char*)g.A + (size_t)cur.pm * tstep; const char* cB = (const char*)g.Bt + (size_t)cur.pn * tstep;
    S.a_ready(cur);
    if constexpr (SP2) {
        PG8_STAGE(PG8_SB(0, 0), cB, voffB); PG8_STAGE(PG8_SB(0, 1), cB + hstep, voffB); PG8_STAGE(PG8_SA(0, 0), cA, voffA); PG8_STAGE(PG8_SA(0, 1), cA + hstep, voffA);
        if (wr == 1) PG8_BAR;
        PG8_WAIT_V(2); PG8_BAR;
        PG8_STAGE(PG8_SB(1, 0), cB + kstep, voffB); PG8_STAGE(PG8_SA(1, 0), cA + kstep, voffA); PG8_STAGE(PG8_SB(1, 1), cB + hstep + kstep, voffB);
        PG8_WAIT_V(6); PG8_BAR;
    } else {
        PG8_STAGE(PG8_SB(0, 0), cB, voffB); PG8_STAGE(PG8_SA(0, 0), cA, voffA); PG8_STAGE(PG8_SB(0, 1), cB + hstep, voffB); PG8_STAGE(PG8_SA(0, 1), cA + hstep, voffA);
        if (wr == 1) PG8_BAR;
        PG8_WAIT_V(4); PG8_BAR;
        PG8_STAGE(PG8_SB(1, 0), cB + kstep, voffB); PG8_STAGE(PG8_SA(1, 0), cA + kstep, voffA); PG8_STAGE(PG8_SB(1, 1), cB + hstep + kstep, voffB);
        PG8_WAIT_V(6); PG8_BAR;
    }
    for (;;) {
        const bool has_next = S.next(ui + 1, nxt);
        const char* nA = has_next ? (const char*)g.A + (size_t)nxt.pm * tstep : cA; const char* nB = has_next ? (const char*)g.Bt + (size_t)nxt.pn * tstep : cB;
        for (int t = 0; t < nt; t += 2) {
            const bool last = (t == nt - 2);
            if constexpr (Epi::MIDK) { if (t == (nt >> 1)) E.mid(acc, cur, wr, wc, fr, fq); }
            const char* a1 = cA + (size_t)(t + 1) * kstep;
            const char* a2 = last ? nA : cA + (size_t)(t + 2) * kstep; const char* b2 = last ? nB : cB + (size_t)(t + 2) * kstep;
            const char* a3 = a2 + kstep; const char* b3 = b2 + kstep;
            if (last && has_next) S.a_ready(nxt);
            if constexpr (SP2) {
            PG8_LDB(B0, 0, 0); PG8_LDB(B1, 0, 1); PG8_SCHED; PG8_LDA(At, 0, 0); PG8_STAGE(PG8_SA(1, 1), a1 + hstep, voffA);
            PG8_WAIT_V(8); PG8_WAIT_L(0); PG8_BAR; PG8_MMA(0, 0, At, B0); PG8_MMA(0, 1, At, B1); PG8_BAR; PG8_SCHED;
            PG8_LDA(At, 0, 1); PG8_STAGE(PG8_SB(0, 0), b2, voffB); PG8_STAGE(PG8_SB(0, 1), b2 + hstep, voffB); PG8_STAGE(PG8_SA(0, 0), a2, voffA);
            PG8_WAIT_V(8); PG8_WAIT_L(0); PG8_BAR; PG8_MMA(1, 0, At, B0); PG8_MMA(1, 1, At, B1); PG8_BAR; PG8_SCHED;
            PG8_LDB(B0, 1, 0); PG8_LDB(B1, 1, 1); PG8_SCHED; PG8_LDA(At, 1, 0); PG8_STAGE(PG8_SA(0, 1), a2 + hstep, voffA);
            PG8_WAIT_V(8); PG8_WAIT_L(0); PG8_BAR; PG8_MMA(0, 0, At, B0); PG8_MMA(0, 1, At, B1); PG8_BAR; PG8_SCHED;
            PG8_LDA(At, 1, 1); PG8_STAGE(PG8_SB(1, 0), b3, voffB); PG8_STAGE(PG8_SB(1, 1), b3 + hstep, voffB); PG8_STAGE(PG8_SA(1, 0), a3, voffA);
            PG8_WAIT_V(8); PG8_WAIT_L(0); PG8_BAR; PG8_MMA(1, 0, At, B0); PG8_MMA(1, 1, At, B1); PG8_BAR; PG8_SCHED;
            } else {
            PG8_LDB(B0, 0, 0); PG8_SCHED; PG8_LDA(At, 0, 0); PG8_STAGE(PG8_SA(1, 1), a1 + hstep, voffA);
            PG8_WAIT_L(8); PG8_BAR; PG8_WAIT_L(0); PG8_MMA(0, 0, At, B0); PG8_BAR; PG8_SCHED;
            PG8_LDB(B1, 0, 1); PG8_STAGE(PG8_SB(0, 0), b2, voffB);
            PG8_BAR; PG8_WAIT_L(0); PG8_MMA(0, 1, At, B1); PG8_BAR;
            PG8_LDA(At, 0, 1); PG8_STAGE(PG8_SA(0, 0), a2, voffA);
            PG8_BAR; PG8_WAIT_L(0); PG8_MMA(1, 0, At, B0); PG8_BAR; PG8_SCHED;
            PG8_STAGE(PG8_SB(0, 1), b2 + hstep, voffB);
            PG8_WAIT_V(6); PG8_BAR; PG8_MMA(1, 1, At, B1); PG8_BAR;
            PG8_LDB(B0, 1, 0); PG8_SCHED; PG8_LDA(At, 1, 0); PG8_STAGE(PG8_SA(0, 1), a2 + hstep, voffA);
            PG8_WAIT_L(8); PG8_BAR; PG8_WAIT_L(0); PG8_MMA(0, 0, At, B0); PG8_BAR; PG8_SCHED;
            PG8_LDB(B1, 1, 1); PG8_STAGE(PG8_SB(1, 0), b3, voffB);
            PG8_BAR; PG8_WAIT_L(0); PG8_MMA(0, 1, At, B1); PG8_BAR;
            PG8_LDA(At, 1, 1); PG8_STAGE(PG8_SA(1, 0), a3, voffA);
            PG8_BAR; PG8_WAIT_L(0); PG8_MMA(1, 0, At, B0); PG8_BAR; PG8_SCHED;
            PG8_STAGE(PG8_SB(1, 1), b3 + hstep, voffB);
            PG8_WAIT_V(6); PG8_BAR; PG8_MMA(1, 1, At, B1); PG8_BAR;
            }
        }
        if constexpr (ALIGN_EPI) { if (wr == 0) PG8_BAR; }
        if constexpr (!Epi::AFTER_DRAIN) { E(acc, cur, wr, wc, fr, fq); S.done(cur); }
        if (!has_next) break;
#pragma unroll
        for (int a = 0; a < 2; ++a)
#pragma unroll
            for (int b = 0; b < 2; ++b)
#pragma unroll
                for (int m = 0; m < 4; ++m)
#pragma unroll
                    for (int n = 0; n < 2; ++n) acc[a][b][m][n] = (f32x4){0.f, 0.f, 0.f, 0.f};
        cur = nxt; cA = nA; cB = nB; ++ui;
        if constexpr (ALIGN_EPI) { if (wr == 1) PG8_BAR; }
    }
    PG8_WAIT_V(0);
    if constexpr (!ALIGN_EPI) { if (wr == 0) PG8_BAR; }
    PG8_BAR;
    if constexpr (Epi::AFTER_DRAIN) { E.fused(acc, cur, wr, wc, fr, fq, lds, wid, lane); S.done(cur); }
#undef PG8_SA
#undef PG8_SB
#undef PG8_STAGE
#undef PG8_LDA
#undef PG8_LDB
#undef PG8_MMA
#undef PG8_WAIT_V
#undef PG8_WAIT_L
#undef PG8_BAR
#undef PG8_SCHED
}
}
#define GAS __attribute__((address_space(1)))
#define LAS __attribute__((address_space(3)))
typedef unsigned short bf16;
typedef unsigned v4u __attribute__((ext_vector_type(4)));
typedef float f32x4 __attribute__((ext_vector_type(4)));
typedef short bf16x8 __attribute__((ext_vector_type(8)));
typedef GAS unsigned gu32;
typedef GAS unsigned long long gu64;
#define RLX_AGENT __ATOMIC_RELAXED, __HIP_MEMORY_SCOPE_AGENT
#define LDS_WAIT() asm volatile("s_waitcnt lgkmcnt(0)" ::: "memory")
#define VM_WAIT() asm volatile("s_waitcnt vmcnt(0)" ::: "memory")
__device__ __forceinline__ unsigned long long rt() { return __builtin_amdgcn_s_memrealtime(); }
__device__ __forceinline__ unsigned f2bf(float f) { unsigned u = __builtin_bit_cast(unsigned, f); return (u + 0x7fffu + ((u >> 16) & 1u)) >> 16; }
__device__ __forceinline__ unsigned pk2(float lo, float hi) { return f2bf(lo) | (f2bf(hi) << 16); }

#define XB_TMO      128
#define XB_XCNT(j)  (256  + 64 * (j))
#define XB_XSUB(j)  (1280 + 64 * (j))
#define XB_XGEN(j)  (2304 + 64 * (j))
#define XB_TOP      3328
#define XB_TOPGEN   3392
#define XCD_BAR_WORDS 3456
#define XB_SPIN_CAP (1u << 18)

__device__ __forceinline__ unsigned xb_ld(unsigned* p)              { return __hip_atomic_load(p, __ATOMIC_RELAXED, __HIP_MEMORY_SCOPE_AGENT); }
__device__ __forceinline__ unsigned xb_add(unsigned* p, unsigned v) { return __hip_atomic_fetch_add(p, v, __ATOMIC_RELAXED, __HIP_MEMORY_SCOPE_AGENT); }
__device__ __forceinline__ unsigned xb_xcc_id() { return (unsigned)__builtin_amdgcn_s_getreg((3 << 11) | 20) & 0xFu; }
#define XB_SPIN(cond, bar) do { unsigned _sp = 0; while (cond) { __builtin_amdgcn_s_sleep(1); \
    if ((++_sp & 255u) == 0u) { if (xb_ld(&(bar)[XB_TMO])) break; if (_sp > XB_SPIN_CAP) { atomicAdd(&(bar)[XB_TMO], 1u); break; } } } } while (0)

struct XcdBarrier {
    unsigned* bar; unsigned x;
    volatile LAS unsigned* st;
};

__device__ __forceinline__ XcdBarrier xcd_barrier_post(unsigned* bar, volatile LAS unsigned* st) {
    XcdBarrier b; b.bar = bar; b.x = xb_xcc_id(); b.st = st;
    if (threadIdx.x == 0) (void)xb_add(&bar[XB_XCNT(b.x)], 1u);
    return b;
}
__device__ __forceinline__ void xcd_barrier_complete(unsigned* bar, unsigned x, unsigned& nloc, unsigned& nx) {
    const unsigned G = gridDim.x * gridDim.y * gridDim.z;
    unsigned sum, cnt, mine, sp = 0u;
    for (;;) {
        sum = 0u; cnt = 0u; mine = 0u;
#pragma unroll
        for (unsigned j = 0; j < 16; ++j) { const unsigned c = xb_ld(&bar[XB_XCNT(j)]); sum += c; cnt += (c > 0u) ? 1u : 0u; mine = (j == x) ? c : mine; }
        if (sum == G) break;
        __builtin_amdgcn_s_sleep(1);
        if ((++sp & 255u) == 0u) { if (xb_ld(&bar[XB_TMO])) break; if (sp > XB_SPIN_CAP) { atomicAdd(&bar[XB_TMO], 1u); break; } }
    }
    nloc = mine > 0u ? mine : 1u; nx = cnt > 0u ? cnt : 1u;
}

__device__ __forceinline__ void xcd_barrier(const XcdBarrier& b) {
    asm volatile("s_waitcnt vmcnt(0)" ::: "memory");
    __syncthreads();
    if (threadIdx.x == 0) {
        unsigned* bar = b.bar;
        __builtin_amdgcn_s_waitcnt(0);
        unsigned nloc = b.st[0], nx = b.st[1];
        if (nloc == 0u) { xcd_barrier_complete(bar, b.x, nloc, nx); b.st[0] = nloc; b.st[1] = nx; }
        const unsigned old = xb_add(&bar[XB_XSUB(b.x)], 1u);
        const unsigned gen = old / nloc;
        if (old + 1u == (gen + 1u) * nloc) {
            __builtin_amdgcn_fence(__ATOMIC_RELEASE, "agent");
            asm volatile("s_waitcnt vmcnt(0)" ::: "memory");
            const unsigned og = xb_add(&bar[XB_TOP], 1u);
            const unsigned tg = og / nx;
            if (og + 1u == (tg + 1u) * nx) xb_add(&bar[XB_TOPGEN], 1u);
            else XB_SPIN(xb_ld(&bar[XB_TOPGEN]) == tg, bar);
            __builtin_amdgcn_fence(__ATOMIC_ACQUIRE, "agent");
            xb_add(&bar[XB_XGEN(b.x)], 1u);
            asm volatile("s_waitcnt vmcnt(0)" ::: "memory");
        } else {
            XB_SPIN(xb_ld(&bar[XB_XGEN(b.x)]) == gen, bar);
            __builtin_amdgcn_fence(__ATOMIC_ACQUIRE, "agent");
            asm volatile("s_waitcnt vmcnt(0)" ::: "memory");
        }
    }
    __syncthreads();
}

namespace att {
typedef short bf16x8 __attribute__((ext_vector_type(8)));
typedef short s16x4 __attribute__((ext_vector_type(4)));
typedef float f32x16 __attribute__((ext_vector_type(16)));
typedef float f32x4 __attribute__((ext_vector_type(4)));
typedef unsigned u32x4 __attribute__((ext_vector_type(4)));
typedef unsigned short bf16;
constexpr int D = 128, NW = 8, QBLK = 32, KVBLK = 64, QB = NW * QBLK;
constexpr int SHM_V = KVBLK * D * 2, SHM_K = KVBLK * D * 2;
constexpr int LDS_SEL = 2 * SHM_V + 2 * SHM_K + NW * 64 * 4;
constexpr int LDS_BYTES = LDS_SEL + 2 * QB * 4;
constexpr float SCALE = 0.08838834764831845f, THR = 8.f;
#define KSWZ(row, colB) ((row) * 256 + ((colB) ^ (((row) & 7) << 4)))
#define SBAR() __builtin_amdgcn_sched_barrier(0)
__device__ __forceinline__ int v_st(int k, int c) { const int kk = (k & ~0xC) | ((k & 4) << 1) | ((k & 8) >> 1); return ((kk >> 3) * 4 + (c >> 5)) * 512 + ((kk & 7) * 32 + (c & 31)) * 2; }
__device__ __forceinline__ int v_rd_base(int lane) { return ((lane & 3) << 3) | (((lane >> 2) & 3) << 6) | (((lane >> 4) & 1) << 5) | (((lane >> 5) & 1) << 8); }
constexpr int v_rd_off(int d0, int ks, int half) { return d0 * 512 + ks * 4096 + half * 2048; }
__device__ __forceinline__ int crow(int r, int hi) { return (r & 3) + 8 * (r >> 2) + 4 * hi; }
__device__ __forceinline__ unsigned cvtpk(float lo, float hi) { unsigned r; asm volatile("v_cvt_pk_bf16_f32 %0, %1, %2" : "=v"(r) : "v"(lo), "v"(hi)); return r; }
__device__ __forceinline__ bf16x8 load8(const bf16* p) { return *reinterpret_cast<const bf16x8*>(p); }
__device__ __forceinline__ void mask_causal(f32x16& p0, f32x16& p1, int dq) {
    const float NEG = -__builtin_inff();
#pragma unroll
    for (int r = 0; r < 16; ++r) { const int c = (r & 3) + 8 * (r >> 2); if (dq - c < 0) p0[r] = NEG; if (dq - c - 32 < 0) p1[r] = NEG; }
}
template <bool MOBA>
__device__ __forceinline__ void partialSM(f32x16& p0, f32x16& p1, float& m_reg, float& mn, float& alpha, bool rm) {
    float pmax = p0[0]; for (int r = 1; r < 16; ++r) pmax = fmaxf(pmax, p0[r]); for (int r = 0; r < 16; ++r) pmax = fmaxf(pmax, p1[r]);
    { auto rr = __builtin_amdgcn_permlane32_swap(__float_as_uint(pmax), __float_as_uint(pmax), false, false);
      pmax = fmaxf(__uint_as_float(rr[0]), __uint_as_float(rr[1])); }
    if (MOBA && rm) pmax = -__builtin_inff();
    constexpr float C2 = 1.4426950408889634f * SCALE;
    if (__builtin_expect(__all((pmax - m_reg) * SCALE <= THR), 1)) { mn = m_reg; alpha = 1.f; }
    else { mn = fmaxf(m_reg, pmax); alpha = __builtin_amdgcn_exp2f((m_reg - mn) * C2); m_reg = mn; }
    float mnL = -mn * C2; if (MOBA && rm) mnL = -__builtin_inff();
    for (int r = 0; r < 16; ++r) p0[r] = fmaf(p0[r], C2, mnL); for (int r = 0; r < 16; ++r) p1[r] = fmaf(p1[r], C2, mnL);
    for (int r = 0; r < 16; ++r) p0[r] = __builtin_amdgcn_exp2f(p0[r]);
}
__device__ __forceinline__ void finishSM(f32x16& p0, f32x16& p1, float alpha, float& l_reg, bf16x8& pa0, bf16x8& pa1, bf16x8& pa2, bf16x8& pa3) {
    for (int r = 0; r < 16; ++r) p1[r] = __builtin_amdgcn_exp2f(p1[r]);
    float ps = 0; for (int r = 0; r < 16; ++r) ps += p0[r]; for (int r = 0; r < 16; ++r) ps += p1[r];
    { auto rr = __builtin_amdgcn_permlane32_swap(__float_as_uint(ps), __float_as_uint(ps), false, false);
      ps = __uint_as_float(rr[0]) + __uint_as_float(rr[1]); }
    l_reg = l_reg * alpha + ps;
#define PK4(P, B_, OUT) do { unsigned a0 = cvtpk(P[B_+0], P[B_+1]), a1 = cvtpk(P[B_+2], P[B_+3]);                          \
        unsigned b0 = cvtpk(P[B_+4], P[B_+5]), b1 = cvtpk(P[B_+6], P[B_+7]);                                             \
        auto r0 = __builtin_amdgcn_permlane32_swap(a0, b0, false, false); auto r1 = __builtin_amdgcn_permlane32_swap(a1, b1, false, false); \
        u32x4 w = {r0[0], r1[0], r0[1], r1[1]}; OUT = *reinterpret_cast<bf16x8*>(&w); } while (0)
    PK4(p0, 0, pa0); PK4(p0, 8, pa1); PK4(p1, 0, pa2); PK4(p1, 8, pa3);
#undef PK4
}
template <int KB>
__device__ __forceinline__ void qkt(f32x16& p0, f32x16& p1, const char* K_lds, int r32, int hi, const bf16x8* qr) {
    p0 = f32x16{}; p1 = f32x16{};
    const char* kb[4];
#pragma unroll
    for (int dd = 0; dd < 4; ++dd) kb[dd] = K_lds + KB * SHM_K + KSWZ(r32, (dd * 16 + hi * 8) * 2);
#pragma unroll
    for (int d0 = 0; d0 < 8; ++d0) { const char* a = kb[d0 & 3] + (d0 >> 2) * 128;
        bf16x8 b0 = *reinterpret_cast<const bf16x8*>(a);
        bf16x8 b1 = *reinterpret_cast<const bf16x8*>(a + 32 * 256);
        p0 = __builtin_amdgcn_mfma_f32_32x32x16_bf16(b0, qr[d0], p0, 0, 0, 0);
        p1 = __builtin_amdgcn_mfma_f32_32x32x16_bf16(b1, qr[d0], p1, 0, 0, 0); }
}
template <int VB>
__device__ __forceinline__ void pv_tile(f32x16* o, int vb0, bf16x8 pa0, bf16x8 pa1, bf16x8 pa2, bf16x8 pa3) {
#define TRRD(dst, off) asm volatile("ds_read_b64_tr_b16 %0, %1 offset:%2" : "=&v"(dst) : "v"(vb0), "i"(off) : "memory")
#define PV_D0(d0) do { s16x4 l0, l1, l2, l3, h0, h1, h2, h3; constexpr int b_ = VB * SHM_V + v_rd_off(d0, 0, 0); \
        TRRD(l0, b_); TRRD(h0, b_ + 2048); TRRD(l1, b_ + 4096); TRRD(h1, b_ + 6144); TRRD(l2, b_ + 8192); TRRD(h2, b_ + 10240); TRRD(l3, b_ + 12288); TRRD(h3, b_ + 14336); \
        asm volatile("s_waitcnt lgkmcnt(0)" ::: "memory"); SBAR();   \
        o[d0] = __builtin_amdgcn_mfma_f32_32x32x16_bf16(pa0, (bf16x8){l0[0], l0[1], l0[2], l0[3], h0[0], h0[1], h0[2], h0[3]}, o[d0], 0, 0, 0);   \
        o[d0] = __builtin_amdgcn_mfma_f32_32x32x16_bf16(pa1, (bf16x8){l1[0], l1[1], l1[2], l1[3], h1[0], h1[1], h1[2], h1[3]}, o[d0], 0, 0, 0);   \
        o[d0] = __builtin_amdgcn_mfma_f32_32x32x16_bf16(pa2, (bf16x8){l2[0], l2[1], l2[2], l2[3], h2[0], h2[1], h2[2], h2[3]}, o[d0], 0, 0, 0);   \
        o[d0] = __builtin_amdgcn_mfma_f32_32x32x16_bf16(pa3, (bf16x8){l3[0], l3[1], l3[2], l3[3], h3[0], h3[1], h3[2], h3[3]}, o[d0], 0, 0, 0); } while (0)
    PV_D0(0); PV_D0(1); PV_D0(2); PV_D0(3);
#undef PV_D0
#undef TRRD
}
template <int QS>
__device__ __forceinline__ void moba_gate(int tid, const bf16* Q, const float* KM, int qb, unsigned* selw) {
    const int wid = __builtin_amdgcn_readfirstlane(tid >> 6), lane = tid & 63, r32 = lane & 31, hi = lane >> 5;
    bf16x8 qr[8];
#pragma unroll
    for (int d0 = 0; d0 < 8; ++d0) qr[d0] = load8(Q + (size_t)(wid * QBLK + r32) * QS + d0 * 16 + hi * 8);
    unsigned sel = 0u;
    {
        f32x16 g = {};
        const float* km = KM + (size_t)r32 * D + hi * 8;
#pragma unroll
        for (int d0 = 0; d0 < 8; ++d0) { const f32x4 a = *(const f32x4*)(km + d0 * 16), b = *(const f32x4*)(km + d0 * 16 + 4);
            u32x4 wh = {cvtpk(a[0], a[1]), cvtpk(a[2], a[3]), cvtpk(b[0], b[1]), cvtpk(b[2], b[3])};
            const f32x4 al = {a[0] - __uint_as_float(wh[0] << 16), a[1] - __uint_as_float(wh[0] & 0xffff0000u), a[2] - __uint_as_float(wh[1] << 16), a[3] - __uint_as_float(wh[1] & 0xffff0000u)};
            const f32x4 bl = {b[0] - __uint_as_float(wh[2] << 16), b[1] - __uint_as_float(wh[2] & 0xffff0000u), b[2] - __uint_as_float(wh[3] << 16), b[3] - __uint_as_float(wh[3] & 0xffff0000u)};
            u32x4 wl = {cvtpk(al[0], al[1]), cvtpk(al[2], al[3]), cvtpk(bl[0], bl[1]), cvtpk(bl[2], bl[3])};
            g = __builtin_amdgcn_mfma_f32_32x32x16_bf16(*reinterpret_cast<bf16x8*>(&wh), qr[d0], g, 0, 0, 0);
            g = __builtin_amdgcn_mfma_f32_32x32x16_bf16(*reinterpret_cast<bf16x8*>(&wl), qr[d0], g, 0, 0, 0); }
        const int IMIN = (int)0x80000000;
        int key[16];
#pragma unroll
        for (int r = 0; r < 16; ++r) { const int n = crow(r, hi); const int bits = (int)__float_as_uint(g[r]); const int s = bits ^ ((bits >> 31) & 0x7fffffff);
            key[r] = (n < qb) ? ((s & ~31) | (31 - n)) : IMIN; }
        int m1 = IMIN, m2 = IMIN, m3 = IMIN;
#pragma unroll
        for (int r = 0; r < 16; ++r) m1 = max(m1, key[r]);
#pragma unroll
        for (int r = 0; r < 16; ++r) m2 = max(m2, key[r] < m1 ? key[r] : IMIN);
#pragma unroll
        for (int r = 0; r < 16; ++r) m3 = max(m3, key[r] < m2 ? key[r] : IMIN);
        int c6[6];
        { auto r1 = __builtin_amdgcn_permlane32_swap((unsigned)m1, (unsigned)m1, false, false); c6[0] = (int)r1[0]; c6[1] = (int)r1[1];
          auto r2 = __builtin_amdgcn_permlane32_swap((unsigned)m2, (unsigned)m2, false, false); c6[2] = (int)r2[0]; c6[3] = (int)r2[1];
          auto r3 = __builtin_amdgcn_permlane32_swap((unsigned)m3, (unsigned)m3, false, false); c6[4] = (int)r3[0]; c6[5] = (int)r3[1]; }
        int t1 = IMIN, t2 = IMIN, t3 = IMIN;
#pragma unroll
        for (int r = 0; r < 6; ++r) t1 = max(t1, c6[r]);
#pragma unroll
        for (int r = 0; r < 6; ++r) t2 = max(t2, c6[r] < t1 ? c6[r] : IMIN);
#pragma unroll
        for (int r = 0; r < 6; ++r) t3 = max(t3, c6[r] < t2 ? c6[r] : IMIN);
        if (t1 != IMIN) sel |= 1u << (31 - (t1 & 31));
        if (t2 != IMIN) sel |= 1u << (31 - (t2 & 31));
        if (t3 != IMIN) sel |= 1u << (31 - (t3 & 31));
    }
    if (hi == 0) selw[wid * QBLK + r32] = sel;
}
struct Seam { bf16x8 qr[8]; bf16x8 st_v0, st_v1, st_k0, st_k1; };
#define ROWP(p, k0, rr, str) ((p) + (size_t)((k0) + (rr)) * (str) + sc)
#define VMW() asm volatile("s_waitcnt vmcnt(0)" ::: "memory")
#define VMWN(n) asm volatile("s_waitcnt vmcnt(%0)" :: "i"(n) : "memory")
#define SLOAD_H(Kp, Vp, k0, str) do { S.st_v0 = load8(ROWP(Vp, k0, sr, str)); S.st_v1 = load8(ROWP(Vp, k0, 32 + sr, str));              \
                         S.st_k0 = load8(ROWP(Kp, k0, sr, str)); S.st_k1 = load8(ROWP(Kp, k0, 32 + sr, str)); } while (0)
#define SWRITE_HK(bf) do { *(bf16x8*)(K_lds + (bf) * SHM_K + kws) = S.st_k0; *(bf16x8*)(K_lds + (bf) * SHM_K + kws + 32 * 256) = S.st_k1; } while (0)
#define SWRITE_HV(bf) do { *(bf16x8*)(V_lds + (bf) * SHM_V + vst0) = S.st_v0; *(bf16x8*)(V_lds + (bf) * SHM_V + vst1) = S.st_v1; } while (0)
#define SWRITE_H(bf) do { SWRITE_HV(bf); SWRITE_HK(bf); } while (0)
template <int QS, int KVS, long VOFF>
__device__ __forceinline__ void attn_prime(int tid, const bf16* curQ, const bf16* curK, char* lds, Seam& S) {
    const int wid = __builtin_amdgcn_readfirstlane(tid >> 6), lane = tid & 63, r32 = lane & 31, hi = lane >> 5;
    const int sr = tid >> 4, sc = (tid & 15) * 8, kws = KSWZ(sr, sc * 2); char* K_lds = lds + 2 * SHM_V;
    for (int d0 = 0; d0 < 8; ++d0) S.qr[d0] = load8(curQ + (size_t)(wid * QBLK + r32) * QS + d0 * 16 + hi * 8);
    SLOAD_H(curK, curK + VOFF, 0, KVS); VMW(); SWRITE_HK(0);
    __syncthreads();
}
template <bool MOBA, int QS, int KVS, long VOFF, int OS>
__device__ __forceinline__ void attn_block(int tid, const bf16* curK, bf16* curO, int NT, int selofs, const bf16* nxtQ, const bf16* nxtK, char* lds, Seam& S) {
    const int wid = __builtin_amdgcn_readfirstlane(tid >> 6), lane = tid & 63, r32 = lane & 31, hi = lane >> 5;
    const int qlo = wid * QBLK, qm = qlo + r32 - 4 * hi;
    char* V_lds = lds; char* K_lds = lds + 2 * SHM_V;
    float* ws = (float*)(lds + 2 * SHM_V + 2 * SHM_K) + wid * 64; float* li_l = ws, * al_l = ws + 32;
    const int sr = tid >> 4, sc = (tid & 15) * 8, vst0 = v_st(sr, sc), vst1 = v_st(32 + sr, sc), kws = KSWZ(sr, sc * 2);
    const int vb0 = (int)(uintptr_t)V_lds + v_rd_base(lane);
    const bf16* Kh = curK; const bf16* Vh = curK + VOFF; constexpr int kvs = KVS;
    unsigned sel = 0u;
    if (MOBA) sel = ((const unsigned*)(lds + LDS_SEL))[selofs + wid * QBLK + r32];
    float m_reg = -1e30f, l_reg = 0; f32x16 o[4] = {};
#define RESC(a) do { if (__any((a) < 1.f)) { if (hi == 0) al_l[r32] = (a); asm volatile("s_waitcnt lgkmcnt(0)" ::: "memory");              \
                     for (int d_ = 0; d_ < 4; ++d_) for (int r = 0; r < 16; ++r) o[d_][r] *= al_l[crow(r, hi)]; } } while (0)
#define KBASE(t) ((t) * KVBLK)
#define MASKT(P0_, P1_, t) do { if (MOBA) { const int kb_ = ((t) - (NT - 4)) * KVBLK; if (kb_ >= 0 && kb_ + KVBLK - 1 > qlo) mask_causal(P0_, P1_, qm - kb_); } } while (0)
#define RMT(t) (MOBA && ((t) < NT - 4) && !((sel >> ((t) >> 2)) & 1u))
    const int NQL = 8;
#define SEAM_K0() do { VMWN(8); SWRITE_HK(0); SBAR(); } while (0)
    f32x16 pA0, pA1, pB0, pB1; float mnA, mnB, alA, alB; bf16x8 pa0, pa1, pa2, pa3;
    (void)NQL;
    SWRITE_HV(0); SBAR();
    if (NT > 1) SLOAD_H(Kh, Vh, KBASE(1), kvs);
    SBAR(); qkt<0>(pA0, pA1, K_lds, r32, hi, S.qr);
    MASKT(pA0, pA1, 0); partialSM<MOBA>(pA0, pA1, m_reg, mnA, alA, RMT(0));
    if (NT > 1) { VMW(); SWRITE_H(1); }
    __syncthreads();
#define HALF_STEP(PX0, PX1, mnX, alX, PY0, PY1, alY, t, KB, VB, SB) do {                                                      \
        SBAR(); qkt<KB>(PX0, PX1, K_lds, r32, hi, S.qr);                                             \
        finishSM(PY0, PY1, alY, l_reg, pa0, pa1, pa2, pa3); SBAR();                                                           \
        if ((t) + 1 < NT) { SLOAD_H(Kh, Vh, KBASE((t) + 1), kvs); SBAR(); }                                               \
        pv_tile<VB>(o, vb0, pa0, pa1, pa2, pa3); MASKT(PX0, PX1, (t)); partialSM<MOBA>(PX0, PX1, m_reg, mnX, alX, RMT(t));                                        \
        __syncthreads();                                                                                                      \
        if ((t) + 1 < NT) { VMW(); SWRITE_H(SB); }                                                                          \
        RESC(alX); __syncthreads(); } while (0)
    for (int t = 1; t + 1 < NT; t += 2) {
        HALF_STEP(pB0, pB1, mnB, alB, pA0, pA1, alA, t, 1, 0, 0);
        HALF_STEP(pA0, pA1, mnA, alA, pB0, pB1, alB, t + 1, 0, 1, 1);
    }
    const bool even = (NT & 1) == 0;
    if (even) { SBAR(); qkt<1>(pB0, pB1, K_lds, r32, hi, S.qr); SBAR(); }
    SLOAD_H(nxtK, nxtK + VOFF, 0, KVS); SBAR();
#pragma unroll
    for (int d0 = 0; d0 < 8; ++d0) S.qr[d0] = load8(nxtQ + (size_t)(wid * QBLK + r32) * QS + d0 * 16 + hi * 8);
    SBAR();
    finishSM(pA0, pA1, alA, l_reg, pa0, pa1, pa2, pa3); SBAR();
    pv_tile<0>(o, vb0, pa0, pa1, pa2, pa3);
    if (even) { MASKT(pB0, pB1, NT - 1); partialSM<MOBA>(pB0, pB1, m_reg, mnB, alB, RMT(NT - 1)); __syncthreads(); RESC(alB);
        finishSM(pB0, pB1, alB, l_reg, pa0, pa1, pa2, pa3); SBAR(); pv_tile<1>(o, vb0, pa0, pa1, pa2, pa3); }
    SBAR(); SEAM_K0();
    if (hi == 0) li_l[r32] = l_reg; asm volatile("s_waitcnt lgkmcnt(0)" ::: "memory");
    float rli[16];
#pragma unroll
    for (int r = 0; r < 16; ++r) rli[r] = __builtin_amdgcn_rcpf(li_l[crow(r, hi)]);
    bf16* Ow = curO + (size_t)(wid * QBLK) * OS;
#pragma unroll
    for (int r = 0; r < 16; ++r) { const int orow = crow(r, hi);
#pragma unroll
        for (int d0 = 0; d0 < 4; ++d0) { const float v = o[d0][r] * rli[r];
            const float vn = __shfl_xor(v, 1);
            if ((r32 & 1) == 0) *(unsigned*)(Ow + (size_t)orow * OS + d0 * 32 + r32) = cvtpk(v, vn); } }
    __syncthreads();
#undef RESC
#undef KBASE
#undef MASKT
#undef RMT
#undef SEAM_K0
#undef HALF_STEP
}
#undef ROWP
#undef VMW
#undef VMWN
#undef SLOAD_H
#undef SWRITE_HK
#undef SWRITE_HV
#undef SWRITE_H
#undef KSWZ
#undef SBAR
}

constexpr int NWAVES = 8;
#ifndef MK_PER_PHASE
#define MK_PER_PHASE 0
#endif
constexpr int N_PHASES = 11;

constexpr int NB = 2, SEQ = 8192, DM = 2048, M = NB * SEQ;
constexpr int NH = 8, HD = 128, AW = NH * HD, CWID = 1024, NPROJ = 3 * AW + 3 * CWID + 2 * DM;
constexpr int NMEM = 256, XH = 4, XW = XH * HD, DFF = 4 * DM;
constexpr int MBLK = 256, NBLK = SEQ / MBLK, TOPK = 3;
constexpr float EPS = 1e-6f;
constexpr float ATT_SCALE = 0.08838834764831845f;

constexpr size_t MiB = 1u << 20;
constexpr size_t WS_CTL = 0, CTL_ZERO_BYTES = 1 * MiB;
constexpr size_t WS_ROPE = 2 * MiB;
constexpr size_t WS_KMEAN = 3 * MiB;
constexpr size_t WS_SS1 = 3 * MiB + 512 * 1024;
constexpr size_t WS_SS2 = WS_SS1 + 128 * 1024, WS_SS3 = WS_SS2 + 128 * 1024;
constexpr size_t WS_MEMN = 4 * MiB;
constexpr size_t WS_MKV = 6 * MiB;
constexpr size_t WS_WIN = 8 * MiB;
constexpr size_t WS_WAC = 48 * MiB;
constexpr size_t WS_WM = 56 * MiB;
constexpr size_t WS_WQ = 64 * MiB;
constexpr size_t WS_WKV = 66 * MiB;
constexpr size_t WS_WO = 70 * MiB;
constexpr size_t WS_WUP = 72 * MiB;
constexpr size_t WS_WD = 104 * MiB;
constexpr size_t WS_XB = 136 * MiB;
constexpr size_t WS_G = 200 * MiB;
constexpr size_t GRP = 32 * MiB;
constexpr size_t WS_RATIO = 360 * MiB, WS_SC = 424 * MiB;
constexpr size_t WS_MERGED = 200 * MiB;
constexpr size_t WS_HQ = 264 * MiB, WS_XO = 280 * MiB;
constexpr size_t WS_UP = 232 * MiB;
constexpr size_t WS_END = 488 * MiB;
constexpr int CW_TMO = 0, CW_CODE = 1, CW_BAR = 4096;

constexpr int RING_OFF = 0, RING_BYTES = 131072;
constexpr int LDSCTL_OFF = 155648, MISC_OFF = LDSCTL_OFF + 320;
constexpr int LDS_BYTES = 163840;

__device__ __forceinline__ float bf2f(unsigned short b) { return __uint_as_float((unsigned)b << 16); }
__device__ __forceinline__ float bflo(unsigned w) { return __uint_as_float(w << 16); }
__device__ __forceinline__ float bfhi(unsigned w) { return __uint_as_float(w & 0xffff0000u); }
__device__ __forceinline__ float wave_sum(float v) {
#pragma unroll
    for (int o = 1; o < 64; o <<= 1) v += __shfl_xor(v, o);
    return v;
}
__device__ __forceinline__ float wave_max(float v) {
#pragma unroll
    for (int o = 1; o < 64; o <<= 1) v = fmaxf(v, __shfl_xor(v, o));
    return v;
}

constexpr int TR_SCR = 64 * 65 * 4;
__device__ __forceinline__ void p0_transpose_item(const float* W, int K, int N, bf16* WT, int ldk, int koff, int row_off, const float* gk, LAS float* scr, int item, int lane) {
    const int nblk = N / 64, kb = item / nblk, nb = item % nblk, k0 = 64 * kb, n0 = 64 * nb;
    const int lr = lane >> 4, lc = (lane & 15) * 4;
    f32x4 v[16];
#pragma unroll
    for (int i = 0; i < 16; ++i) v[i] = *(const GAS f32x4*)(W + (size_t)(k0 + 4 * i + lr) * N + n0 + lc);
#pragma unroll
    for (int i = 0; i < 16; ++i) { const int kk = 4 * i + lr; f32x4 w = v[i]; if (gk) { const float g = gk[k0 + kk]; w = w * g; }
        LAS float* d = scr + kk * 65 + lc; d[0] = w.x; d[1] = w.y; d[2] = w.z; d[3] = w.w; }
    LDS_WAIT(); asm volatile("" ::: "memory");
    const int c = lane & 7;
#pragma unroll
    for (int j = 0; j < 8; ++j) { const int n = (lane >> 3) + 8 * j; const LAS float* s = scr + (8 * c) * 65 + n;
        v4u o; o.x = pk2(s[0 * 65], s[1 * 65]); o.y = pk2(s[2 * 65], s[3 * 65]); o.z = pk2(s[4 * 65], s[5 * 65]); o.w = pk2(s[6 * 65], s[7 * 65]);
        *(GAS v4u*)(WT + (size_t)(row_off + n0 + n) * ldk + koff + k0 + 8 * c) = o; }
    LDS_WAIT(); asm volatile("" ::: "memory");
}
__device__ __forceinline__ void rms_row_to_bf16(const float* xrow, const float* g, bf16* orow, int lane) {
    const GAS f32x4* xr = (const GAS f32x4*)xrow + lane; const GAS f32x4* gr = (const GAS f32x4*)g + lane;
    f32x4 v[8]; float s = 0.f;
#pragma unroll
    for (int j = 0; j < 8; ++j) { v[j] = xr[64 * j]; s += (v[j].x * v[j].x + v[j].y * v[j].y) + (v[j].z * v[j].z + v[j].w * v[j].w); }
    const float rstd = 1.f / sqrtf(wave_sum(s) * (1.f / DM) + EPS);
    GAS unsigned long long* o8 = (GAS unsigned long long*)orow + lane;
#pragma unroll
    for (int j = 0; j < 8; ++j) { const f32x4 gg = gr[64 * j];
        o8[64 * j] = (unsigned long long)pk2(v[j].x * rstd * gg.x, v[j].y * rstd * gg.y) | ((unsigned long long)pk2(v[j].z * rstd * gg.z, v[j].w * rstd * gg.w) << 32); }
}
__device__ __forceinline__ float row_rstd(const float* xrow, int lane) {
    const GAS f32x4* xr = (const GAS f32x4*)xrow + lane; float s = 0.f;
#pragma unroll
    for (int j = 0; j < 8; ++j) { const f32x4 v = xr[64 * j]; s += (v.x * v.x + v.y * v.y) + (v.z * v.z + v.w * v.w); }
    return 1.f / sqrtf(wave_sum(s) * (1.f / DM) + EPS);
}

__device__ const float ROPE_INV_FREQ[16] = {1.f, 0.440366596f, 0.193922743f, 0.0853971019f, 0.0376060307f, 0.016560439f, 0.00729266461f, 0.00321144587f, 0.00141421356f, 0.000622772379f, 0.000274248188f, 0.000120769735f, 5.3182961e-05f, 2.34199997e-05f, 1.03133862e-05f, 4.54167048e-06f};
struct Args { const float* in[17]; float* out; unsigned char* ws; int ph_lo, ph_hi, li, pad; };

__device__ __forceinline__ void naive_moba_item(int b, int h, int i, const bf16* QP, const bf16* KP, const bf16* VP, const float2* ROPE, const float* KMEAN, bf16* AO, int lane) {
    const size_t t = (size_t)b * SEQ + i; const int qb = i >> 8;
    float q[128];
    { const v4u* qp = (const v4u*)(QP + t * AW + h * HD);
#pragma unroll
      for (int c = 0; c < 16; ++c) { const v4u w = qp[c]; q[8 * c + 0] = bflo(w.x); q[8 * c + 1] = bfhi(w.x); q[8 * c + 2] = bflo(w.y); q[8 * c + 3] = bfhi(w.y); q[8 * c + 4] = bflo(w.z); q[8 * c + 5] = bfhi(w.z); q[8 * c + 6] = bflo(w.w); q[8 * c + 7] = bfhi(w.w); } }
#pragma unroll
    for (int d = 0; d < 16; ++d) { const float2 cs = ROPE[i * 16 + d]; const float q1 = q[d], q2 = q[d + 16]; q[d] = q1 * cs.x - q2 * cs.y; q[d + 16] = q2 * cs.x + q1 * cs.y; }
    float g = -INFINITY;
    if (lane < qb) { const f32x4* km = (const f32x4*)(KMEAN + ((size_t)(b * NH + h) * NBLK + lane) * HD); float a = 0.f;
#pragma unroll
        for (int c = 0; c < 32; ++c) { const f32x4 k4 = km[c]; a += q[4 * c] * k4.x + q[4 * c + 1] * k4.y + q[4 * c + 2] * k4.z + q[4 * c + 3] * k4.w; }
        g = a; }
    unsigned selmask = 0u;
#pragma unroll
    for (int k = 0; k < TOPK; ++k) { const float mx = wave_max(g);
        if (mx != -INFINITY) { const unsigned long long bal = __ballot(g == mx); const int idx = __ffsll((long long)bal) - 1; selmask |= 1u << idx; if (lane == idx) g = -INFINITY; } }
    selmask |= 1u << qb;
    float s[4][4]; int blk[4]; bool valid[4];
#pragma unroll
    for (int c = 0; c < 4; ++c) { valid[c] = selmask != 0u; blk[c] = valid[c] ? (__ffs((int)selmask) - 1) : 0; selmask &= selmask - 1u; }
    float mloc = -INFINITY;
#pragma unroll
    for (int c = 0; c < 4; ++c)
#pragma unroll
        for (int r = 0; r < 4; ++r) { const int key = blk[c] * MBLK + lane + 64 * r; float sc = -INFINITY;
            if (valid[c] && key <= i) { const v4u* kp = (const v4u*)(KP + ((size_t)b * SEQ + key) * AW + h * HD); float kk[32]; float a = 0.f;
#pragma unroll
                for (int cc = 0; cc < 4; ++cc) { const v4u w = kp[cc]; kk[8 * cc + 0] = bflo(w.x); kk[8 * cc + 1] = bfhi(w.x); kk[8 * cc + 2] = bflo(w.y); kk[8 * cc + 3] = bfhi(w.y); kk[8 * cc + 4] = bflo(w.z); kk[8 * cc + 5] = bfhi(w.z); kk[8 * cc + 6] = bflo(w.w); kk[8 * cc + 7] = bfhi(w.w); }
#pragma unroll
                for (int d = 0; d < 16; ++d) { const float2 cs = ROPE[key * 16 + d]; const float k1 = kk[d], k2 = kk[d + 16]; a += q[d] * (k1 * cs.x - k2 * cs.y) + q[d + 16] * (k2 * cs.x + k1 * cs.y); }
#pragma unroll
                for (int cc = 4; cc < 16; ++cc) { const v4u w = kp[cc]; a += q[8 * cc + 0] * bflo(w.x) + q[8 * cc + 1] * bfhi(w.x) + q[8 * cc + 2] * bflo(w.y) + q[8 * cc + 3] * bfhi(w.y) + q[8 * cc + 4] * bflo(w.z) + q[8 * cc + 5] * bfhi(w.z) + q[8 * cc + 6] * bflo(w.w) + q[8 * cc + 7] * bfhi(w.w); }
                sc = a * ATT_SCALE; }
            s[c][r] = sc; mloc = fmaxf(mloc, sc); }
    const float mx = wave_max(mloc); float lsum = 0.f;
#pragma unroll
    for (int c = 0; c < 4; ++c)
#pragma unroll
        for (int r = 0; r < 4; ++r) { s[c][r] = __expf(s[c][r] - mx); lsum += s[c][r]; }
    const float l = wave_sum(lsum);
    float o0 = 0.f, o1 = 0.f;
#pragma unroll
    for (int c = 0; c < 4; ++c) { if (!valid[c]) continue;
#pragma unroll
        for (int r = 0; r < 4; ++r) { const bf16* vp = VP + ((size_t)b * SEQ + blk[c] * MBLK + 64 * r) * AW + h * HD + 2 * lane;
            for (int src = 0; src < 64; ++src) { const float p = __shfl(s[c][r], src); const unsigned w = *(const unsigned*)(vp + (size_t)src * AW); o0 += p * bflo(w); o1 += p * bfhi(w); } } }
    const float rl = 1.f / l;
    *(unsigned*)(AO + t * AW + h * HD + 2 * lane) = pk2(o0 * rl, o1 * rl);
}
__device__ __forceinline__ void naive_xattn_item(int b, int h, int i, const bf16* HQ, const float* R2, const bf16* MKV, bf16* XO, int lane) {
    const size_t t = (size_t)b * SEQ + i; const float qs = R2[t] * ATT_SCALE;
    float q[128];
    { const v4u* qp = (const v4u*)(HQ + t * XW + h * HD);
#pragma unroll
      for (int c = 0; c < 16; ++c) { const v4u w = qp[c]; q[8 * c + 0] = bflo(w.x) * qs; q[8 * c + 1] = bfhi(w.x) * qs; q[8 * c + 2] = bflo(w.y) * qs; q[8 * c + 3] = bfhi(w.y) * qs; q[8 * c + 4] = bflo(w.z) * qs; q[8 * c + 5] = bfhi(w.z) * qs; q[8 * c + 6] = bflo(w.w) * qs; q[8 * c + 7] = bfhi(w.w) * qs; } }
    float s[4]; float mloc = -INFINITY;
#pragma unroll
    for (int r = 0; r < 4; ++r) { const int key = lane + 64 * r; const v4u* kp = (const v4u*)(MKV + ((size_t)b * NMEM + key) * (2 * XW) + h * HD); float a = 0.f;
#pragma unroll
        for (int cc = 0; cc < 16; ++cc) { const v4u w = kp[cc]; a += q[8 * cc + 0] * bflo(w.x) + q[8 * cc + 1] * bfhi(w.x) + q[8 * cc + 2] * bflo(w.y) + q[8 * cc + 3] * bfhi(w.y) + q[8 * cc + 4] * bflo(w.z) + q[8 * cc + 5] * bfhi(w.z) + q[8 * cc + 6] * bflo(w.w) + q[8 * cc + 7] * bfhi(w.w); }
        s[r] = a; mloc = fmaxf(mloc, a); }
    const float mx = wave_max(mloc); float lsum = 0.f;
#pragma unroll
    for (int r = 0; r < 4; ++r) { s[r] = __expf(s[r] - mx); lsum += s[r]; }
    const float l = wave_sum(lsum);
    float o0 = 0.f, o1 = 0.f;
#pragma unroll
    for (int r = 0; r < 4; ++r) { const bf16* vp = MKV + ((size_t)b * NMEM + 64 * r) * (2 * XW) + XW + h * HD + 2 * lane;
        for (int src = 0; src < 64; ++src) { const float p = __shfl(s[r], src); const unsigned w = *(const unsigned*)(vp + (size_t)src * (2 * XW)); o0 += p * bflo(w); o1 += p * bfhi(w); } }
    const float rl = 1.f / l;
    *(unsigned*)(XO + t * XW + h * HD + 2 * lane) = pk2(o0 * rl, o1 * rl);
}

__global__ void __launch_bounds__(NWAVES * 64, 2) mk_fwd(Args args) {
    extern __shared__ __attribute__((aligned(16))) unsigned char lds[];
    LAS unsigned char* const ldsp = (LAS unsigned char*)lds;
    volatile LAS unsigned* const MISC = (volatile LAS unsigned*)(ldsp + MISC_OFF);
    const int tid = threadIdx.x, wave = __builtin_amdgcn_readfirstlane(tid >> 6);
    const int G = gridDim.x; const int bx = blockIdx.x; const int vcu = (G % 8 == 0) ? (bx % 8) * (G / 8) + bx / 8 : bx;
    unsigned char* const ws = args.ws;
    gu32* const ctl = (gu32*)(ws + WS_CTL);
    for (int u = tid; u < (LDS_BYTES - LDSCTL_OFF) / 4; u += NWAVES * 64) ((LAS unsigned*)(ldsp + LDSCTL_OFF))[u] = 0u;
    __syncthreads();
    XcdBarrier bar; bar.bar = (unsigned*)(ctl + CW_BAR); bar.x = 0; bar.st = nullptr;
    if (!MK_PER_PHASE) bar = xcd_barrier_post((unsigned*)(ctl + CW_BAR), MISC + 8);
    const int lo = args.ph_lo, hi = args.ph_hi;
#define IN(k) (lo <= (k) && (k) < hi)
#define SEAM(k) do { if (IN(k) && IN((k) + 1)) xcd_barrier(bar); } while (0)
    const int NGW = G * NWAVES, NGT = G * NWAVES * 64;
#define PHASE_IDS() int tv_ = threadIdx.x; asm volatile("" : "+v"(tv_)); const int lane = tv_ & 63; const int gw = vcu * NWAVES + wave; const int gt = vcu * (NWAVES * 64) + tv_; (void)gw; (void)gt; (void)lane

#define x_in (args.in[0])
#define mem_in (args.in[1])
#define norm_mix (args.in[2])
#define w_in (args.in[3])
#define conv_w (args.in[4])
#define w_attn_out (args.in[5])
#define w_conv_out (args.in[6])
#define w_mix_out (args.in[7])
#define norm_xattn (args.in[8])
#define norm_mem (args.in[9])
#define wq_x (args.in[10])
#define wkv_x (args.in[11])
#define wo_x (args.in[12])
#define norm_mlp (args.in[13])
#define w_up (args.in[14])
#define w_down (args.in[15])
#define norm_final (args.in[16])
    float* const out = args.out; unsigned char* const outb = (unsigned char*)args.out;
#define ROPE ((float2*)(ws + WS_ROPE))
#define KSUM ((float*)(ws + WS_KMEAN))
#define SS1 ((unsigned long long*)(ws + WS_SS1))
#define SS2 ((unsigned long long*)(ws + WS_SS2))
#define SS3 ((unsigned long long*)(ws + WS_SS3))
#define MEMN ((bf16*)(ws + WS_MEMN))
#define MKV ((bf16*)(ws + WS_MKV))
#define WIN ((bf16*)(ws + WS_WIN))
#define WM ((bf16*)(ws + WS_WM))
#define WQ ((bf16*)(ws + WS_WQ))
#define WKV ((bf16*)(ws + WS_WKV))
#define WO ((bf16*)(ws + WS_WO))
#define WUP ((bf16*)(ws + WS_WUP))
#define WD ((bf16*)(ws + WS_WD))
#define XB ((bf16*)(ws + WS_XB))
#define QP ((bf16*)(ws + WS_G))
#define KP ((bf16*)(ws + WS_G + GRP))
#define VP ((bf16*)(ws + WS_G + 2 * GRP))
#define MERGED ((bf16*)(ws + WS_MERGED))
#define WAC ((bf16*)(ws + WS_WAC))
#define U_ ((bf16*)(ws + WS_G + 3 * GRP))
#define CB ((bf16*)(ws + WS_G + 4 * GRP))
#define RATIO ((bf16*)(ws + WS_RATIO))
#define SC ((bf16*)(ws + WS_SC))
#define AOCO ((bf16*)outb)
#define HQ ((bf16*)(ws + WS_HQ))
#define XO ((bf16*)(ws + WS_XO))
#define UP ((bf16*)(ws + WS_UP))
    if (IN(0)) { PHASE_IDS();
        LAS float* scr = (LAS float*)(ldsp + RING_OFF + wave * TR_SCR);
        constexpr int I_IN = (DM / 64) * (NPROJ / 64), I_A = (AW / 64) * (DM / 64), I_C = I_A, I_M = (DM / 64) * (DM / 64), I_Q = (DM / 64) * (XW / 64), I_KV = (DM / 64) * (2 * XW / 64),
                      I_O = (XW / 64) * (DM / 64), I_UP = (DM / 64) * (DFF / 64), I_D = (DFF / 64) * (DM / 64);
        static_assert(NWAVES * TR_SCR <= LDSCTL_OFF, "transposer scratch");
        constexpr int NITEMS = I_IN + I_A + I_C + I_M + I_Q + I_KV + I_O + I_UP + I_D;
        for (int it = gw; it < NITEMS; it += NGW) {
            int r = it;
            if (r < I_IN) { const int n0 = 64 * (r % (NPROJ / 64)); int d;
                if (n0 < 3072) d = n0;
                else if (n0 < 4096) { const int ch = n0 - 3072; d = 3072 + 256 * (ch >> 7) + (ch & 127); }
                else if (n0 < 5120) d = 5120 + (n0 - 4096);
                else if (n0 < 6144) { const int ch = n0 - 5120; d = 3072 + 256 * (ch >> 7) + 128 + (ch & 127); }
                else if (n0 < 8192) { const int ch = n0 - 6144; d = 6144 + 256 * (ch >> 7) + (ch & 127); }
                else { const int ch = n0 - 8192; d = 6144 + 256 * (ch >> 7) + 128 + (ch & 127); }
                p0_transpose_item(w_in, DM, NPROJ, WIN, DM, 0, d - n0, nullptr, scr, r, lane); continue; } r -= I_IN;
            if (r < I_A) { p0_transpose_item(w_attn_out, AW, DM, WAC, 2 * AW, 0, 0, nullptr, scr, r, lane); continue; } r -= I_A;
            if (r < I_C) { p0_transpose_item(w_conv_out, CWID, DM, WAC, 2 * AW, AW, 0, nullptr, scr, r, lane); continue; } r -= I_C;
            if (r < I_M) { p0_transpose_item(w_mix_out, DM, DM, WM, DM, 0, 0, nullptr, scr, r, lane); continue; } r -= I_M;
            if (r < I_Q) { p0_transpose_item(wq_x, DM, XW, WQ, DM, 0, 0, norm_xattn, scr, r, lane); continue; } r -= I_Q;
            if (r < I_KV) { p0_transpose_item(wkv_x, DM, 2 * XW, WKV, DM, 0, 0, nullptr, scr, r, lane); continue; } r -= I_KV;
            if (r < I_O) { p0_transpose_item(wo_x, XW, DM, WO, XW, 0, 0, nullptr, scr, r, lane); continue; } r -= I_O;
            if (r < I_UP) { p0_transpose_item(w_up, DM, DFF, WUP, DM, 0, 0, norm_mlp, scr, r, lane); continue; } r -= I_UP;
            p0_transpose_item(w_down, DFF, DM, WD, DFF, 0, 0, nullptr, scr, r, lane);
        }
        for (int m = gw; m < M; m += NGW) rms_row_to_bf16(x_in + (size_t)m * DM, norm_mix, XB + (size_t)m * DM, lane);
        for (int m = gw; m < NB * NMEM; m += NGW) rms_row_to_bf16(mem_in + (size_t)m * DM, norm_mem, MEMN + (size_t)m * DM, lane);
        for (int e = gt; e < 3 * M; e += NGT) SS1[e] = 0ull;
        for (int e = gt; e < NB * NH * NBLK * HD; e += NGT) KSUM[e] = 0.f;
        for (int e = gt; e < SEQ * 16; e += NGT) { const int pos = e >> 4, j = e & 15;
            const float inv_freq = ROPE_INV_FREQ[j]; const float ang = (float)pos * inv_freq;
            const double turns = (double)ang * 0.15915494309189535; const float fr = (float)(turns - rint(turns));
            ROPE[e] = make_float2(__builtin_amdgcn_cosf(fr), __builtin_amdgcn_sinf(fr)); }
    }
    SEAM(0);
    if (IN(1)) {
        { pg8::Gemm g{XB, WIN, M, NPROJ, DM}; pg8::StaticOrder S; S.init(M, NPROJ, G, bx);
          pg8::EpiProj E{QP, (size_t)(GRP / 2), U_, CB, RATIO, SC, (const float*)ROPE, KSUM};
          pg8::gemm_phase<pg8::EpiProj, pg8::StaticOrder, true, true>(ldsp + RING_OFF, g, S, E); }
    }
    SEAM(1);
    if (IN(2)) { PHASE_IDS();
        { att::Seam S; char* albase = (char*)lds + RING_OFF; unsigned* selw = (unsigned*)(albase + att::LDS_SEL); constexpr int NIT = NB * NH * 16; constexpr long VOFF = (long)(GRP / 2);
          for (int L = vcu; L < NIT; L += G) { int tv = threadIdx.x; asm volatile("" : "+v"(tv)); const int bh = L >> 4, b = bh >> 3, h = bh & 7, s = L & 15;
              const bf16* Kp = KP + (size_t)b * SEQ * AW + h * HD; const float* KM = KSUM + (size_t)bh * NBLK * HD;
              const bf16* Q0 = QP + ((size_t)b * SEQ + (size_t)s * 256) * AW + h * HD; const bf16* Q1 = QP + ((size_t)b * SEQ + (size_t)(31 - s) * 256) * AW + h * HD;
              att::moba_gate<AW>(tv, Q0, KM, s, selw); att::moba_gate<AW>(tv, Q1, KM, 31 - s, selw + 256);
              att::attn_prime<AW, AW, VOFF>(tv, Q0, Kp, albase, S);
              for (int pass = 0; pass < 2; ++pass) { const int qb = pass ? 31 - s : s;
                  bf16* Op = AOCO + ((size_t)b * SEQ + (size_t)qb * 256) * (2 * AW) + h * HD;
                  att::attn_block<true, AW, AW, VOFF, 2 * AW>(tv, Kp, Op, 4 * (qb + 1), pass * 256, Q1, Kp, albase, S); } } }
        for (int e = gt; e < M * (CWID / 8); e += NGT) { const int c = (e & 127) * 8; const int t = e >> 7; const int s = t & (SEQ - 1);
            const v4u u0 = *(const v4u*)(U_ + (size_t)t * CWID + c); v4u u1 = {0u, 0u, 0u, 0u}, u2 = {0u, 0u, 0u, 0u};
            if (s >= 1) u1 = *(const v4u*)(U_ + (size_t)(t - 1) * CWID + c);
            if (s >= 2) u2 = *(const v4u*)(U_ + (size_t)(t - 2) * CWID + c);
            const v4u cb = *(const v4u*)(CB + (size_t)t * CWID + c);
            const f32x4 w0a = *(const f32x4*)(conv_w + c), w0b = *(const f32x4*)(conv_w + c + 4), w1a = *(const f32x4*)(conv_w + CWID + c), w1b = *(const f32x4*)(conv_w + CWID + c + 4),
                        w2a = *(const f32x4*)(conv_w + 2 * CWID + c), w2b = *(const f32x4*)(conv_w + 2 * CWID + c + 4);
            float y[8];
            y[0] = w2a.x * bflo(u0.x) + w1a.x * bflo(u1.x) + w0a.x * bflo(u2.x); y[1] = w2a.y * bfhi(u0.x) + w1a.y * bfhi(u1.x) + w0a.y * bfhi(u2.x);
            y[2] = w2a.z * bflo(u0.y) + w1a.z * bflo(u1.y) + w0a.z * bflo(u2.y); y[3] = w2a.w * bfhi(u0.y) + w1a.w * bfhi(u1.y) + w0a.w * bfhi(u2.y);
            y[4] = w2b.x * bflo(u0.z) + w1b.x * bflo(u1.z) + w0b.x * bflo(u2.z); y[5] = w2b.y * bfhi(u0.z) + w1b.y * bfhi(u1.z) + w0b.y * bfhi(u2.z);
            y[6] = w2b.z * bflo(u0.w) + w1b.z * bflo(u1.w) + w0b.z * bflo(u2.w); y[7] = w2b.w * bfhi(u0.w) + w1b.w * bfhi(u1.w) + w0b.w * bfhi(u2.w);
            v4u o; o.x = pk2(bflo(cb.x) * y[0], bfhi(cb.x) * y[1]); o.y = pk2(bflo(cb.y) * y[2], bfhi(cb.y) * y[3]); o.z = pk2(bflo(cb.z) * y[4], bfhi(cb.z) * y[5]); o.w = pk2(bflo(cb.w) * y[6], bfhi(cb.w) * y[7]);
            *(v4u*)(AOCO + (size_t)t * (2 * AW) + AW + c) = o; }
    }
    SEAM(2);
    if (IN(3)) {
        pg8::Gemm g{AOCO, WAC, M, DM, 2 * AW}; pg8::StaticOrder S; S.init(M, DM, G, bx); pg8::EpiMerged E{MERGED, RATIO, SC, DM};
        pg8::gemm_phase<pg8::EpiMerged, pg8::StaticOrder, true, true>(ldsp + RING_OFF, g, S, E);
    }
    SEAM(3);
    if (IN(4)) {
        pg8::Gemm g{MERGED, WM, M, DM, DM}; pg8::StaticOrder S; S.init(M, DM, G, bx); pg8::EpiResid E{x_in, out, XB, DM, SS1};
        pg8::gemm_phase<pg8::EpiResid, pg8::StaticOrder, true, true>(ldsp + RING_OFF, g, S, E);
    }
    SEAM(4);
    if (IN(5)) {
        constexpr int NHQ = (M / 256) * (XW / 256);
        const bool kvwg = (G >= NHQ + 8) ? (bx >= NHQ) : true;
        { pg8::Gemm g{XB, WQ, M, XW, DM}; pg8::StaticOrder S; S.init(M, XW, G, bx); pg8::EpiBf16G E{HQ, HQ, 1 << 30, 0, 1 << 30, XW, SS1};
          pg8::gemm_phase<pg8::EpiBf16G, pg8::StaticOrder, true, true>(ldsp + RING_OFF, g, S, E); }
        if (kvwg) { pg8::Gemm g{MEMN, WKV, NB * NMEM, 2 * XW, DM}; pg8::StaticOrder S; S.init(NB * NMEM, 2 * XW, G, (G >= NHQ + 8) ? bx - NHQ : bx);
          pg8::EpiBf16G E{MKV, MKV, 1 << 30, 0, 1 << 30, 2 * XW, nullptr};
          pg8::gemm_phase<pg8::EpiBf16G, pg8::StaticOrder, true, true>(ldsp + RING_OFF, g, S, E); }
    }
    SEAM(5);
    if (IN(6)) {
        att::Seam S; char* albase = (char*)lds + RING_OFF; constexpr int NIT = NB * XH * 32;
        for (int L = vcu; L < NIT; L += G) { int tv = threadIdx.x; asm volatile("" : "+v"(tv)); const int bh = L >> 5, b = bh >> 2, h = bh & 3, qb = L & 31;
            const bf16* Qp = HQ + ((size_t)b * SEQ + (size_t)qb * 256) * XW + h * HD; const bf16* Kp = MKV + (size_t)b * NMEM * (2 * XW) + h * HD;
            bf16* Op = XO + ((size_t)b * SEQ + (size_t)qb * 256) * XW + h * HD;
            att::attn_prime<XW, 2 * XW, (long)XW>(tv, Qp, Kp, albase, S);
            att::attn_block<false, XW, 2 * XW, (long)XW, XW>(tv, Kp, Op, NMEM / 64, 0, Qp, Kp, albase, S); }
    }
    SEAM(6);
    if (IN(7)) {
        pg8::Gemm g{XO, WO, M, DM, XW}; pg8::StaticOrder S; S.init(M, DM, G, bx); pg8::EpiResid E{out, out, XB, DM, SS2};
        pg8::gemm_phase<pg8::EpiResid, pg8::StaticOrder, true, true>(ldsp + RING_OFF, g, S, E);
    }
    SEAM(7);
    if (IN(8)) {
        pg8::Gemm g{XB, WUP, M, DFF, DM}; pg8::StaticOrder S; S.init(M, DFF, G, bx); pg8::EpiUp E{UP, DFF, SS2};
        pg8::gemm_phase<pg8::EpiUp, pg8::StaticOrder, true, true>(ldsp + RING_OFF, g, S, E);
    }
    SEAM(8);
    if (IN(9)) {
        pg8::Gemm g{UP, WD, M, DM, DFF}; pg8::StaticOrder S; S.init(M, DM, G, bx); pg8::EpiResid E{out, out, nullptr, DM, SS3};
        pg8::gemm_phase<pg8::EpiResid, pg8::StaticOrder, true, true>(ldsp + RING_OFF, g, S, E);
    }
    SEAM(9);
    if (IN(10)) { PHASE_IDS();
        for (int m = gw; m < M; m += NGW) { GAS f32x4* xr = (GAS f32x4*)(out + (size_t)m * DM) + lane; const GAS f32x4* gr = (const GAS f32x4*)norm_final + lane;
            const float rstd = pg8::rstd_from_ss(SS3, m);
#pragma unroll
            for (int j = 0; j < 8; ++j) { const f32x4 v = xr[64 * j]; const f32x4 gg = gr[64 * j]; xr[64 * j] = (f32x4){v.x * rstd * gg.x, v.y * rstd * gg.y, v.z * rstd * gg.z, v.w * rstd * gg.w}; } }
    }
#undef IN
#undef SEAM
}
#undef x_in
#undef mem_in


extern "C" void kernel_launch(void* const* d_in, const int* in_sizes, int n_in, void* d_out, int out_size, void* d_ws, size_t ws_size, hipStream_t stream) {
    static int grid = 0;
    if (grid == 0) {
        if (n_in != 17 || in_sizes[0] != M * DM || out_size != M * DM || ws_size < WS_END) { fprintf(stderr, "kernel_launch: unexpected shapes: n_in %d in0 %d out %d ws %zu (need %zu)\n", n_in, n_in > 0 ? in_sizes[0] : -1, out_size, ws_size, (size_t)WS_END); grid = -1; return; }
        int dev = 0, cus = 0, per_cu = 0;
        if (hipGetDevice(&dev) != hipSuccess || hipDeviceGetAttribute(&cus, hipDeviceAttributeMultiprocessorCount, dev) != hipSuccess) { fprintf(stderr, "kernel_launch: device query failed\n"); grid = -1; return; }
        if (hipFuncSetAttribute((const void*)mk_fwd, hipFuncAttributeMaxDynamicSharedMemorySize, LDS_BYTES) != hipSuccess) { fprintf(stderr, "kernel_launch: hipFuncSetAttribute failed\n"); grid = -1; return; }
        if (hipOccupancyMaxActiveBlocksPerMultiprocessor(&per_cu, (const void*)mk_fwd, NWAVES * 64, LDS_BYTES) != hipSuccess || per_cu < 1) fprintf(stderr, "kernel_launch: note: occupancy query reports %d workgroups per CU\n", per_cu);
        (void)hipGetLastError();
        grid = cus;
    }
    if (grid < 0) return;
    if (hipMemsetAsync((char*)d_ws + WS_CTL, 0, CTL_ZERO_BYTES, stream) != hipSuccess) { fprintf(stderr, "kernel_launch: hipMemsetAsync failed\n"); return; }
    Args a{};
    for (int i = 0; i < 17; ++i) a.in[i] = (const float*)d_in[i];
    a.out = (float*)d_out; a.ws = (unsigned char*)d_ws;
#if MK_PER_PHASE
    for (int p = 0; p < N_PHASES; ++p) { a.ph_lo = p; a.ph_hi = p + 1; a.li = p; hipLaunchKernelGGL(mk_fwd, dim3(grid), dim3(NWAVES * 64), LDS_BYTES, stream, a); }
#else
    a.ph_lo = 0; a.ph_hi = N_PHASES; a.li = 0;
    hipLaunchKernelGGL(mk_fwd, dim3(grid), dim3(NWAVES * 64), LDS_BYTES, stream, a);
#endif
    const hipError_t le = hipPeekAtLastError();
    if (le != hipSuccess) fprintf(stderr, "kernel_launch: launch failed: %s\n", hipGetErrorName(le));
}
```

```cpp
#include <hip/hip_runtime.h>
#include <cstdio>
#include <cstdint>
namespace pg8 {
#define PG8_LAS __attribute__((address_space(3)))
typedef unsigned short bf16_t;
typedef short bf16x8 __attribute__((ext_vector_type(8)));
typedef float f32x4 __attribute__((ext_vector_type(4)));
typedef unsigned u32x4 __attribute__((ext_vector_type(4)));
constexpr int BM = 256, BK = 64, HALF = 128, HTB = HALF * BK * 2  , STAGE_BYTES = 8 * HTB, NXCD = 8, WGM = 8;

__host__ __device__ __forceinline__ int lds_byte(int r, int c) { const int st = (r >> 4) * 2 + (c >> 5), rr = r & 15, cc = c & 31, ob = rr * 64 + cc * 2; return st * 1024 + (ob ^ (((ob >> 9) & 1) << 5)); }
__host__ __device__ __forceinline__ void stage_rc(int b, int& R, int& C) { const int st = b / 1024, sb = b % 1024, swz = sb ^ (((sb >> 9) & 1) << 5); R = (st >> 1) * 16 + swz / 64; C = (st & 1) * 32 + (swz % 64) / 2; }
__host__ __device__ __forceinline__ int perm32(int rho) { const int n = rho >> 4, i = rho & 15; return 8 * (i >> 2) + 4 * n + (i & 3); }

struct Unit { int pm, pn; };
struct Gemm { const bf16_t* A; const bf16_t* Bt; int M, N, K; };

struct StaticOrder {
    int nM, nN, nwg, G, c;
    __host__ __device__ void init(int M, int N, int G_, int c_) { nM = M / BM; nN = N / BM; nwg = nM * nN; G = G_; c = c_; }
    __host__ __device__ bool next(int i, Unit& u) const {
        const long L = (long)i * G + c; if (L >= nwg) return false;
        int wgid = (int)L; { const int q = nwg / NXCD, r = nwg % NXCD, xcd = wgid % NXCD, off = wgid / NXCD; wgid = (xcd < r ? xcd * (q + 1) : r * (q + 1) + (xcd - r) * q) + off; }
        const int nig = WGM * nN, gid = wgid / nig, fm = gid * WGM, gsz = (nM - fm) < WGM ? (nM - fm) : WGM;
        u.pm = fm + ((wgid % nig) % gsz); u.pn = (wgid % nig) / gsz; return true;
    }
    __device__ __forceinline__ void a_ready(const Unit&) const {}
    __device__ __forceinline__ void done(const Unit&) const {}
};


__device__ __forceinline__ unsigned cvt_pk_bf16(float lo, float hi) { unsigned r; asm volatile("v_cvt_pk_bf16_f32 %0, %1, %2" : "=v"(r) : "v"(lo), "v"(hi)); return r; }
typedef unsigned u32x2 __attribute__((ext_vector_type(2)));

constexpr float SS_SCALE = 16777216.f, SS_INV = 1.f / (16777216.f * 2048.f), RMS_EPS = 1e-6f;
__device__ __forceinline__ float rstd_from_ss(const unsigned long long* ss, int row) { return 1.f / sqrtf((float)ss[row] * SS_INV + RMS_EPS); }
struct EpiBf16G {
    static constexpr bool PERM = true, AFTER_DRAIN = false, MIDK = false;
    bf16_t* g0; bf16_t* g1; int tsplit; size_t gstride; int gcols; int ldc; const unsigned long long* ss;
    __device__ __forceinline__ void operator()(const f32x4 (&acc)[2][2][4][2], const Unit& u, int wr, int wc, int fr, int fq) const {
        const int row0 = u.pm * BM + wr * 64 + fr; int colt = u.pn * BM; const int t = colt / gcols; colt -= t * gcols;
        bf16_t* base = (t < tsplit) ? g0 + (size_t)t * gstride : g1 + (size_t)(t - tsplit) * gstride;
        const int col0 = colt + wc * 32 + 8 * fq;
#pragma unroll
        for (int ai = 0; ai < 2; ++ai)
#pragma unroll
            for (int m = 0; m < 4; ++m) { bf16_t* rowp = base + (size_t)(row0 + ai * HALF + m * 16) * ldc + col0; const float s = ss ? rstd_from_ss(ss, row0 + ai * HALF + m * 16) : 1.f;
#pragma unroll
                for (int bj = 0; bj < 2; ++bj) { const f32x4 v0 = acc[ai][bj][m][0] * s, v1 = acc[ai][bj][m][1] * s;
                    u32x4 w; w.x = cvt_pk_bf16(v0[0], v0[1]); w.y = cvt_pk_bf16(v0[2], v0[3]); w.z = cvt_pk_bf16(v1[0], v1[1]); w.w = cvt_pk_bf16(v1[2], v1[3]);
                    *(u32x4*)(rowp + bj * HALF) = w; } }
    }
};
struct EpiResid {
    static constexpr bool PERM = false, AFTER_DRAIN = false, MIDK = false;
    const float* base; float* out; bf16_t* outb; int ldc; unsigned long long* ss;
    __device__ __forceinline__ void operator()(const f32x4 (&acc)[2][2][4][2], const Unit& u, int wr, int wc, int fr, int fq) const {
        const int row0 = u.pm * BM + wr * 64 + fr, col0 = u.pn * BM + wc * 32 + 4 * fq;
#pragma unroll
        for (int ai = 0; ai < 2; ++ai)
#pragma unroll
            for (int m = 0; m < 4; ++m) { const size_t off = (size_t)(row0 + ai * HALF + m * 16) * ldc + col0; float sq = 0.f;
#pragma unroll
                for (int bj = 0; bj < 2; ++bj)
#pragma unroll
                    for (int n = 0; n < 2; ++n) { const f32x4 o = *(const f32x4*)(base + off + bj * HALF + n * 16) + acc[ai][bj][m][n];
                        *(f32x4*)(out + off + bj * HALF + n * 16) = o; sq += (o[0] * o[0] + o[1] * o[1]) + (o[2] * o[2] + o[3] * o[3]);
                        if (outb) { u32x2 w; w.x = cvt_pk_bf16(o[0], o[1]); w.y = cvt_pk_bf16(o[2], o[3]); *(u32x2*)(outb + off + bj * HALF + n * 16) = w; } }
                if (ss) { sq += __shfl_xor(sq, 16); sq += __shfl_xor(sq, 32);
                    if (fq == 0) __hip_atomic_fetch_add(ss + row0 + ai * HALF + m * 16, (unsigned long long)__float2ull_rn(sq * SS_SCALE), __ATOMIC_RELAXED, __HIP_MEMORY_SCOPE_AGENT); }
                if (m & 1) asm volatile("" ::: "memory"); }
    }
};
struct EpiUp {
    static constexpr bool PERM = true, AFTER_DRAIN = false, MIDK = false;
    bf16_t* O; int ldc; const unsigned long long* ss;
    __device__ __forceinline__ void operator()(const f32x4 (&acc)[2][2][4][2], const Unit& u, int wr, int wc, int fr, int fq) const {
        const int row0 = u.pm * BM + wr * 64 + fr, col0 = u.pn * BM + wc * 32 + 8 * fq;
#pragma unroll
        for (int ai = 0; ai < 2; ++ai)
#pragma unroll
            for (int m = 0; m < 4; ++m) { const int r = row0 + ai * HALF + m * 16; const float s = rstd_from_ss(ss, r); bf16_t* rowp = O + (size_t)r * ldc + col0;
#pragma unroll
                for (int bj = 0; bj < 2; ++bj) { f32x4 v0 = acc[ai][bj][m][0] * s, v1 = acc[ai][bj][m][1] * s;
#pragma unroll
                    for (int e = 0; e < 4; ++e) { v0[e] = fmaxf(v0[e], 0.f); v1[e] = fmaxf(v1[e], 0.f); }
                    v0 = v0 * v0; v1 = v1 * v1;
                    u32x4 w; w.x = cvt_pk_bf16(v0[0], v0[1]); w.y = cvt_pk_bf16(v0[2], v0[3]); w.z = cvt_pk_bf16(v1[0], v1[1]); w.w = cvt_pk_bf16(v1[2], v1[3]);
                    *(u32x4*)(rowp + bj * HALF) = w; } }
    }
};


__device__ __forceinline__ float bf_lo(unsigned w) { return __uint_as_float(w << 16); }
__device__ __forceinline__ float bf_hi(unsigned w) { return __uint_as_float(w & 0xffff0000u); }
typedef float f32x2p __attribute__((ext_vector_type(2)));
struct EpiProj {
    static constexpr bool PERM = true, AFTER_DRAIN = false, MIDK = false;
    bf16_t* QKV; size_t gstr; bf16_t* U; bf16_t* CBo; bf16_t* RATIO; bf16_t* SC; const float* rope; float* ksum;
    __device__ __forceinline__ void operator()(const f32x4 (&acc)[2][2][4][2], const Unit& u, int wr, int wc, int fr, int fq) const {
        asm volatile("" : "+v"(fr), "+v"(fq));
        const int pn = u.pn; const int row0 = u.pm * BM + wr * 64 + fr;
        if (pn < 12) {
            const int grp = pn >> 2; bf16_t* base = QKV + (size_t)grp * gstr; const int col0 = (pn & 3) * BM + wc * 32 + 8 * fq;
            const bool rope_wave = (grp < 2) && (wc == 0);
            const float sg = (fq < 2) ? -1.f : 1.f;
            f32x4 ks[2][2];
#pragma unroll
            for (int bj = 0; bj < 2; ++bj)
#pragma unroll
                for (int n = 0; n < 2; ++n) ks[bj][n] = (f32x4){0.f, 0.f, 0.f, 0.f};
#pragma unroll
            for (int ai = 0; ai < 2; ++ai)
#pragma unroll
                for (int m = 0; m < 4; ++m) { const int r = row0 + ai * HALF + m * 16; bf16_t* rowp = base + (size_t)r * 1024 + col0;
                    f32x4 t0 = {1.f, 0.f, 1.f, 0.f}, t1 = t0, t2 = t0, t3 = t0;
                    if (rope_wave) { const f32x4* rp = (const f32x4*)(rope + ((size_t)(r & 8191) * 16 + 8 * (fq & 1)) * 2); t0 = rp[0]; t1 = rp[1]; t2 = rp[2]; t3 = rp[3]; }
#pragma unroll
                    for (int bj = 0; bj < 2; ++bj) { f32x4 v0 = acc[ai][bj][m][0], v1 = acc[ai][bj][m][1];
                        if (rope_wave) { f32x4 p0, p1;
#pragma unroll
                            for (int e2 = 0; e2 < 4; ++e2) { p0[e2] = __shfl_xor(v0[e2], 32); p1[e2] = __shfl_xor(v1[e2], 32); }
                            v0 = (f32x4){v0[0] * t0[0] + sg * p0[0] * t0[1], v0[1] * t0[2] + sg * p0[1] * t0[3], v0[2] * t1[0] + sg * p0[2] * t1[1], v0[3] * t1[2] + sg * p0[3] * t1[3]};
                            v1 = (f32x4){v1[0] * t2[0] + sg * p1[0] * t2[1], v1[1] * t2[2] + sg * p1[1] * t2[3], v1[2] * t3[0] + sg * p1[2] * t3[1], v1[3] * t3[2] + sg * p1[3] * t3[3]}; }
                        if (grp == 1) { ks[bj][0] += v0; ks[bj][1] += v1; }
                        u32x4 w; w.x = cvt_pk_bf16(v0[0], v0[1]); w.y = cvt_pk_bf16(v0[2], v0[3]); w.z = cvt_pk_bf16(v1[0], v1[1]); w.w = cvt_pk_bf16(v1[2], v1[3]);
                        *(u32x4*)(rowp + bj * HALF) = w; } }
            if (grp == 1) {
                float* kd = ksum + ((size_t)(((u.pm >> 5) * 8 + 2 * (pn - 4)) * 32 + (u.pm & 31))) * 128 + wc * 32 + 8 * fq;
#pragma unroll
                for (int bj = 0; bj < 2; ++bj)
#pragma unroll
                    for (int n = 0; n < 2; ++n)
#pragma unroll
                        for (int e2 = 0; e2 < 4; ++e2) { float s = ks[bj][n][e2]; s += __shfl_xor(s, 1); s += __shfl_xor(s, 2); s += __shfl_xor(s, 4); s += __shfl_xor(s, 8);
                            if (fr == 0) __hip_atomic_fetch_add(kd + (size_t)bj * 32 * 128 + 4 * n + e2, s, __ATOMIC_RELAXED, __HIP_MEMORY_SCOPE_AGENT); }
            }
        } else if (pn < 20) {
            const int col0 = (pn - 12) * HALF + wc * 32 + 8 * fq;
#pragma unroll
            for (int ai = 0; ai < 2; ++ai)
#pragma unroll
                for (int m = 0; m < 4; ++m) { const int r = row0 + ai * HALF + m * 16; const f32x4 v0 = acc[ai][0][m][0] * acc[ai][1][m][0], v1 = acc[ai][0][m][1] * acc[ai][1][m][1];
                    u32x4 w; w.x = cvt_pk_bf16(v0[0], v0[1]); w.y = cvt_pk_bf16(v0[2], v0[3]); w.z = cvt_pk_bf16(v1[0], v1[1]); w.w = cvt_pk_bf16(v1[2], v1[3]);
                    *(u32x4*)(U + (size_t)r * 1024 + col0) = w; }
        } else if (pn < 24) {
            const int col0 = (pn - 20) * BM + wc * 32 + 8 * fq;
#pragma unroll
            for (int ai = 0; ai < 2; ++ai)
#pragma unroll
                for (int m = 0; m < 4; ++m) { bf16_t* rowp = CBo + (size_t)(row0 + ai * HALF + m * 16) * 1024 + col0;
#pragma unroll
                    for (int bj = 0; bj < 2; ++bj) { const f32x4 v0 = acc[ai][bj][m][0], v1 = acc[ai][bj][m][1];
                        u32x4 w; w.x = cvt_pk_bf16(v0[0], v0[1]); w.y = cvt_pk_bf16(v0[2], v0[3]); w.z = cvt_pk_bf16(v1[0], v1[1]); w.w = cvt_pk_bf16(v1[2], v1[3]);
                        *(u32x4*)(rowp + bj * HALF) = w; } }
        } else {
            const int col0 = (pn - 24) * HALF + wc * 32 + 8 * fq;
#pragma unroll
            for (int ai = 0; ai < 2; ++ai)
#pragma unroll
                for (int m = 0; m < 4; ++m) { const size_t off = (size_t)(row0 + ai * HALF + m * 16) * 2048 + col0; f32x4 rt[2], sv[2];
#pragma unroll
                    for (int n = 0; n < 2; ++n)
#pragma unroll
                        for (int e2 = 0; e2 < 4; ++e2) { const float ea = __expf(fminf(-acc[ai][0][m][n][e2], 80.f)), ec = __expf(fminf(-acc[ai][1][m][n][e2], 80.f));
                            sv[n][e2] = __builtin_amdgcn_rcpf(1.f + ec); rt[n][e2] = (1.f + ec) * __builtin_amdgcn_rcpf(1.f + ea); }
                    u32x4 w; w.x = cvt_pk_bf16(rt[0][0], rt[0][1]); w.y = cvt_pk_bf16(rt[0][2], rt[0][3]); w.z = cvt_pk_bf16(rt[1][0], rt[1][1]); w.w = cvt_pk_bf16(rt[1][2], rt[1][3]);
                    *(u32x4*)(RATIO + off) = w;
                    u32x4 w2; w2.x = cvt_pk_bf16(sv[0][0], sv[0][1]); w2.y = cvt_pk_bf16(sv[0][2], sv[0][3]); w2.z = cvt_pk_bf16(sv[1][0], sv[1][1]); w2.w = cvt_pk_bf16(sv[1][2], sv[1][3]);
                    *(u32x4*)(SC + off) = w2; }
        }
    }
};
struct EpiMerged {
    static constexpr bool PERM = true, AFTER_DRAIN = false, MIDK = true;
    bf16_t* O; const bf16_t* ratio; const bf16_t* sc; int ldc;
    __device__ __forceinline__ void mid(f32x4 (&acc)[2][2][4][2], const Unit& u, int wr, int wc, int fr, int fq) const {
        asm volatile("" : "+v"(fr), "+v"(fq));
        const int row0 = u.pm * BM + wr * 64 + fr, col0 = u.pn * BM + wc * 32 + 8 * fq;
#pragma unroll
        for (int ai = 0; ai < 2; ++ai) {
#pragma unroll
            for (int m = 0; m < 4; ++m) { const bf16_t* rp = ratio + (size_t)(row0 + ai * HALF + m * 16) * ldc + col0;
#pragma unroll
                for (int bj = 0; bj < 2; ++bj) { const u32x4 w = *(const u32x4*)(rp + bj * HALF);
                    acc[ai][bj][m][0] *= (f32x4){bf_lo(w.x), bf_hi(w.x), bf_lo(w.y), bf_hi(w.y)}; acc[ai][bj][m][1] *= (f32x4){bf_lo(w.z), bf_hi(w.z), bf_lo(w.w), bf_hi(w.w)}; } }
            asm volatile("" ::: "memory"); }
    }
    __device__ __forceinline__ void operator()(const f32x4 (&acc)[2][2][4][2], const Unit& u, int wr, int wc, int fr, int fq) const {
        asm volatile("" : "+v"(fr), "+v"(fq));
        const int row0 = u.pm * BM + wr * 64 + fr, col0 = u.pn * BM + wc * 32 + 8 * fq;
#pragma unroll
        for (int ai = 0; ai < 2; ++ai) {
#pragma unroll
            for (int m = 0; m < 4; ++m) { const size_t off = (size_t)(row0 + ai * HALF + m * 16) * ldc + col0;
#pragma unroll
                for (int bj = 0; bj < 2; ++bj) { const u32x4 s = *(const u32x4*)(sc + off + bj * HALF);
                    const f32x4 v0 = acc[ai][bj][m][0] * (f32x4){bf_lo(s.x), bf_hi(s.x), bf_lo(s.y), bf_hi(s.y)}, v1 = acc[ai][bj][m][1] * (f32x4){bf_lo(s.z), bf_hi(s.z), bf_lo(s.w), bf_hi(s.w)};
                    u32x4 w; w.x = cvt_pk_bf16(v0[0], v0[1]); w.y = cvt_pk_bf16(v0[2], v0[3]); w.z = cvt_pk_bf16(v1[0], v1[1]); w.w = cvt_pk_bf16(v1[2], v1[3]);
                    *(u32x4*)(O + off + bj * HALF) = w; } }
            asm volatile("" ::: "memory"); }
    }
};
template <class Epi, class Sched, bool ALIGN_EPI = false, bool SP2 = false>
__device__ __forceinline__ void gemm_phase(PG8_LAS unsigned char* lds, const Gemm g, const Sched& S, const Epi& E) {
    const int tid = threadIdx.x, wid = __builtin_amdgcn_readfirstlane(tid >> 6), lane = tid & 63, wr = wid >> 2, wc = wid & 3, fr = lane & 15, fq = lane >> 4;
    const int K = g.K, nt = K / BK;
    unsigned voffA[2], voffB[2];
#pragma unroll
    for (int i = 0; i < 2; ++i) { int R, C; stage_rc(tid * 16 + i * 8192, R, C); const int Rb = Epi::PERM ? ((R & ~31) + perm32(R & 31)) : R;
        voffA[i] = (unsigned)(R * K + C) * 2u; voffB[i] = (unsigned)(Rb * K + C) * 2u; }
    const size_t kstep = (size_t)(BK * 2);
    const size_t hstep = (size_t)HALF * K * 2;
    const size_t tstep = 2 * hstep;
    const unsigned ldsw = (unsigned)wid * 1024u;
    const int aoff = lds_byte(wr * 64 + fr, fq * 8), boff = lds_byte(wc * 32 + fr, fq * 8);
#define PG8_SA(b, h) (((b) * 2 + (h)) * HTB)
#define PG8_SB(b, h) ((4 + (b) * 2 + (h)) * HTB)
#define PG8_STAGE(bufoff, gbase, voff) do { _Pragma("unroll") for (int _i = 0; _i < 2; ++_i) \
        __builtin_amdgcn_global_load_lds((const unsigned*)((const char*)(gbase) + (voff)[_i]), (PG8_LAS unsigned*)(lds + (bufoff) + ldsw + _i * 8192), 16, 0, 0); } while (0)
#define PG8_LDA(dst, b, h) do { _Pragma("unroll") for (int m = 0; m < 4; ++m) _Pragma("unroll") for (int k = 0; k < 2; ++k) dst[m][k] = *(const PG8_LAS bf16x8*)(lds + PG8_SA(b, h) + aoff + m * 2048 + k * 1024); } while (0)
#define PG8_LDB(dst, b, h) do { _Pragma("unroll") for (int n = 0; n < 2; ++n) _Pragma("unroll") for (int k = 0; k < 2; ++k) dst[n][k] = *(const PG8_LAS bf16x8*)(lds + PG8_SB(b, h) + boff + n * 2048 + k * 1024); } while (0)
#define PG8_MMA(ai, bj, At, Bt) do { __builtin_amdgcn_s_setprio(1); _Pragma("unroll") for (int m = 0; m < 4; ++m) _Pragma("unroll") for (int n = 0; n < 2; ++n) _Pragma("unroll") for (int k = 0; k < 2; ++k) \
        acc[ai][bj][m][n] = __builtin_amdgcn_mfma_f32_16x16x32_bf16(Bt[n][k], At[m][k], acc[ai][bj][m][n], 0, 0, 0); __builtin_amdgcn_s_setprio(0); } while (0)
#define PG8_WAIT_V(n) asm volatile("s_waitcnt vmcnt(" #n ")" ::: "memory")
#define PG8_WAIT_L(n) asm volatile("s_waitcnt lgkmcnt(" #n ")" ::: "memory")
#define PG8_BAR __builtin_amdgcn_s_barrier()
#define PG8_SCHED __builtin_amdgcn_sched_barrier(0)
    Unit cur, nxt; int ui = 0;
    if (!S.next(0, cur)) return;
    f32x4 acc[2][2][4][2];
#pragma unroll
    for (int a = 0; a < 2; ++a)
#pragma unroll
        for (int b = 0; b < 2; ++b)
#pragma unroll
            for (int m = 0; m < 4; ++m)
#pragma unroll
                for (int n = 0; n < 2; ++n) acc[a][b][m][n] = (f32x4){0.f, 0.f, 0.f, 0.f};
    bf16x8 At[4][2], B0[2][2], B1[2][2];
    const char* cA = (const char*)g.A + (size_t)cur.pm * tstep; const char* cB = (const char*)g.Bt + (size_t)cur.pn * tstep;
    S.a_ready(cur);
    if constexpr (SP2) {
        PG8_STAGE(PG8_SB(0, 0), cB, voffB); PG8_STAGE(PG8_SB(0, 1), cB + hstep, voffB); PG8_STAGE(PG8_SA(0, 0), cA, voffA); PG8_STAGE(PG8_SA(0, 1), cA + hstep, voffA);
        if (wr == 1) PG8_BAR;
        PG8_WAIT_V(2); PG8_BAR;
        PG8_STAGE(PG8_SB(1, 0), cB + kstep, voffB); PG8_STAGE(PG8_SA(1, 0), cA + kstep, voffA); PG8_STAGE(PG8_SB(1, 1), cB + hstep + kstep, voffB);
        PG8_WAIT_V(6); PG8_BAR;
    } else {
        PG8_STAGE(PG8_SB(0, 0), cB, voffB); PG8_STAGE(PG8_SA(0, 0), cA, voffA); PG8_STAGE(PG8_SB(0, 1), cB + hstep, voffB); PG8_STAGE(PG8_SA(0, 1), cA + hstep, voffA);
        if (wr == 1) PG8_BAR;
        PG8_WAIT_V(4); PG8_BAR;
        PG8_STAGE(PG8_SB(1, 0), cB + kstep, voffB); PG8_STAGE(PG8_SA(1, 0), cA + kstep, voffA); PG8_STAGE(PG8_SB(1, 1), cB + hstep + kstep, voffB);
        PG8_WAIT_V(6); PG8_BAR;
    }
    for (;;) {
        const bool has_next = S.next(ui + 1, nxt);
        const char* nA = has_next ? (const char*)g.A + (size_t)nxt.pm * tstep : cA; const char* nB = has_next ? (const char*)g.Bt + (size_t)nxt.pn * tstep : cB;
        for (int t = 0; t < nt; t += 2) {
            const bool last = (t == nt - 2);
            if constexpr (Epi::MIDK) { if (t == (nt >> 1)) E.mid(acc, cur, wr, wc, fr, fq); }
            const char* a1 = cA + (size_t)(t + 1) * kstep;
            const char* a2 = last ? nA : cA + (size_t)(t + 2) * kstep; const char* b2 = last ? nB : cB + (size_t)(t + 2) * kstep;
            const char* a3 = a2 + kstep; const char* b3 = b2 + kstep;
            if (last && has_next) S.a_ready(nxt);
            if constexpr (SP2) {
            PG8_LDB(B0, 0, 0); PG8_LDB(B1, 0, 1); PG8_SCHED; PG8_LDA(At, 0, 0); PG8_STAGE(PG8_SA(1, 1), a1 + hstep, voffA);
            PG8_WAIT_V(8); PG8_WAIT_L(0); PG8_BAR; PG8_MMA(0, 0, At, B0); PG8_MMA(0, 1, At, B1); PG8_BAR; PG8_SCHED;
            PG8_LDA(At, 0, 1); PG8_STAGE(PG8_SB(0, 0), b2, voffB); PG8_STAGE(PG8_SB(0, 1), b2 + hstep, voffB); PG8_STAGE(PG8_SA(0, 0), a2, voffA);
            PG8_WAIT_V(8); PG8_WAIT_L(0); PG8_BAR; PG8_MMA(1, 0, At, B0); PG8_MMA(1, 1, At, B1); PG8_BAR; PG8_SCHED;
            PG8_LDB(B0, 1, 0); PG8_LDB(B1, 1, 1); PG8_SCHED; PG8_LDA(At, 1, 0); PG8_STAGE(PG8_SA(0, 1), a2 + hstep, voffA);
            PG8_WAIT_V(8); PG8_WAIT_L(0); PG8_BAR; PG8_MMA(0, 0, At, B0); PG8_MMA(0, 1, At, B1); PG8_BAR; PG8_SCHED;
            PG8_LDA(At, 1, 1); PG8_STAGE(PG8_SB(1, 0), b3, voffB); PG8_STAGE(PG8_SB(1, 1), b3 + hstep, voffB); PG8_STAGE(PG8_SA(1, 0), a3, voffA);
            PG8_WAIT_V(8); PG8_WAIT_L(0); PG8_BAR; PG8_MMA(1, 0, At, B0); PG8_MMA(1, 1, At, B1); PG8_BAR; PG8_SCHED;
            } else {
            PG8_LDB(B0, 0, 0); PG8_SCHED; PG8_LDA(At, 0, 0); PG8_STAGE(PG8_SA(1, 1), a1 + hstep, voffA);
            PG8_WAIT_L(8); PG8_BAR; PG8_WAIT_L(0); PG8_MMA(0, 0, At, B0); PG8_BAR; PG8_SCHED;
            PG8_LDB(B1, 0, 1); PG8_STAGE(PG8_SB(0, 0), b2, voffB);
            PG8_BAR; PG8_WAIT_L(0); PG8_MMA(0, 1, At, B1); PG8_BAR;
            PG8_LDA(At, 0, 1); PG8_STAGE(PG8_SA(0, 0), a2, voffA);
            PG8_BAR; PG8_WAIT_L(0); PG8_MMA(1, 0, At, B0); PG8_BAR; PG8_SCHED;
            PG8_STAGE(PG8_SB(0, 1), b2 + hstep, voffB);
            PG8_WAIT_V(6); PG8_BAR; PG8_MMA(1, 1, At, B1); PG8_BAR;
            PG8_LDB(B0, 1, 0); PG8_SCHED; PG8_LDA(At, 1, 0); PG8_STAGE(PG8_SA(0, 1), a2 + hstep, voffA);
            PG8_WAIT_L(8); PG8_BAR; PG8_WAIT_L(0); PG8_MMA(0, 0, At, B0); PG8_BAR; PG8_SCHED;
            PG8_LDB(B1, 1, 1); PG8_STAGE(PG8_SB(1, 0), b3, voffB);
            PG8_BAR; PG8_WAIT_L(0); PG8_MMA(0, 1, At, B1); PG8_BAR;
            PG8_LDA(At, 1, 1); PG8_STAGE(PG8_SA(1, 0), a3, voffA);
            PG8_BAR; PG8_WAIT_L(0); PG8_MMA(1, 0, At, B0); PG8_BAR; PG8_SCHED;
            PG8_STAGE(PG8_SB(1, 1), b3 + hstep, voffB);
            PG8_WAIT_V(6); PG8_BAR; PG8_MMA(1, 1, At, B1); PG8_BAR;
            }
        }
        if constexpr (ALIGN_EPI) { if (wr == 0) PG8_BAR; }
        if constexpr (!Epi::AFTER_DRAIN) { E(acc, cur, wr, wc, fr, fq); S.done(cur); }
        if (!has_next) break;
#pragma unroll
        for (int a = 0; a < 2; ++a)
#pragma unroll
            for (int b = 0; b < 2; ++b)
#pragma unroll
                for (int m = 0; m < 4; ++m)
#pragma unroll
                    for (int n = 0; n < 2; ++n) acc[a][b][m][n] = (f32x4){0.f, 0.f, 0.f, 0.f};
        cur = nxt; cA = nA; cB = nB; ++ui;
        if constexpr (ALIGN_EPI) { if (wr == 1) PG8_BAR; }
    }
    PG8_WAIT_V(0);
    if constexpr (!ALIGN_EPI) { if (wr == 0) PG8_BAR; }
    PG8_BAR;
    if constexpr (Epi::AFTER_DRAIN) { E.fused(acc, cur, wr, wc, fr, fq, lds, wid, lane); S.done(cur); }
#undef PG8_SA
#undef PG8_SB
#undef PG8_STAGE
#undef PG8_LDA
#undef PG8_LDB
#undef PG8_MMA
#undef PG8_WAIT_V
#undef PG8_WAIT_L
#undef PG8_BAR
#undef PG8_SCHED
}
}
#define GAS __attribute__((address_space(1)))
#define LAS __attribute__((address_space(3)))
typedef unsigned short bf16;
typedef unsigned v4u __attribute__((ext_vector_type(4)));
typedef float f32x4 __attribute__((ext_vector_type(4)));
typedef short bf16x8 __attribute__((ext_vector_type(8)));
typedef GAS unsigned gu32;
typedef GAS unsigned long long gu64;
#define RLX_AGENT __ATOMIC_RELAXED, __HIP_MEMORY_SCOPE_AGENT
#define LDS_WAIT() asm volatile("s_waitcnt lgkmcnt(0)" ::: "memory")
#define VM_WAIT() asm volatile("s_waitcnt vmcnt(0)" ::: "memory")
__device__ __forceinline__ unsigned long long rt() { return __builtin_amdgcn_s_memrealtime(); }
__device__ __forceinline__ unsigned f2bf(float f) { unsigned u = __builtin_bit_cast(unsigned, f); return (u + 0x7fffu + ((u >> 16) & 1u)) >> 16; }
__device__ __forceinline__ unsigned pk2(float lo, float hi) { return f2bf(lo) | (f2bf(hi) << 16); }

#define XB_TMO      128
#define XB_XCNT(j)  (256  + 64 * (j))
#define XB_XSUB(j)  (1280 + 64 * (j))
#define XB_XGEN(j)  (2304 + 64 * (j))
#define XB_TOP      3328
#define XB_TOPGEN   3392
#define XCD_BAR_WORDS 3456
#define XB_SPIN_CAP (1u << 18)

__device__ __forceinline__ unsigned xb_ld(unsigned* p)              { return __hip_atomic_load(p, __ATOMIC_RELAXED, __HIP_MEMORY_SCOPE_AGENT); }
__device__ __forceinline__ unsigned xb_add(unsigned* p, unsigned v) { return __hip_atomic_fetch_add(p, v, __ATOMIC_RELAXED, __HIP_MEMORY_SCOPE_AGENT); }
__device__ __forceinline__ unsigned xb_xcc_id() { return (unsigned)__builtin_amdgcn_s_getreg((3 << 11) | 20) & 0xFu; }
#define XB_SPIN(cond, bar) do { unsigned _sp = 0; while (cond) { __builtin_amdgcn_s_sleep(1); \
    if ((++_sp & 255u) == 0u) { if (xb_ld(&(bar)[XB_TMO])) break; if (_sp > XB_SPIN_CAP) { atomicAdd(&(bar)[XB_TMO], 1u); break; } } } } while (0)

struct XcdBarrier {
    unsigned* bar; unsigned x;
    volatile LAS unsigned* st;
};

__device__ __forceinline__ XcdBarrier xcd_barrier_post(unsigned* bar, volatile LAS unsigned* st) {
    XcdBarrier b; b.bar = bar; b.x = xb_xcc_id(); b.st = st;
    if (threadIdx.x == 0) (void)xb_add(&bar[XB_XCNT(b.x)], 1u);
    return b;
}
__device__ __forceinline__ void xcd_barrier_complete(unsigned* bar, unsigned x, unsigned& nloc, unsigned& nx) {
    const unsigned G = gridDim.x * gridDim.y * gridDim.z;
    unsigned sum, cnt, mine, sp = 0u;
    for (;;) {
        sum = 0u; cnt = 0u; mine = 0u;
#pragma unroll
        for (unsigned j = 0; j < 16; ++j) { const unsigned c = xb_ld(&bar[XB_XCNT(j)]); sum += c; cnt += (c > 0u) ? 1u : 0u; mine = (j == x) ? c : mine; }
        if (sum == G) break;
        __builtin_amdgcn_s_sleep(1);
        if ((++sp & 255u) == 0u) { if (xb_ld(&bar[XB_TMO])) break; if (sp > XB_SPIN_CAP) { atomicAdd(&bar[XB_TMO], 1u); break; } }
    }
    nloc = mine > 0u ? mine : 1u; nx = cnt > 0u ? cnt : 1u;
}

__device__ __forceinline__ void xcd_barrier(const XcdBarrier& b) {
    asm volatile("s_waitcnt vmcnt(0)" ::: "memory");
    __syncthreads();
    if (threadIdx.x == 0) {
        unsigned* bar = b.bar;
        __builtin_amdgcn_s_waitcnt(0);
        unsigned nloc = b.st[0], nx = b.st[1];
        if (nloc == 0u) { xcd_barrier_complete(bar, b.x, nloc, nx); b.st[0] = nloc; b.st[1] = nx; }
        const unsigned old = xb_add(&bar[XB_XSUB(b.x)], 1u);
        const unsigned gen = old / nloc;
        if (old + 1u == (gen + 1u) * nloc) {
            __builtin_amdgcn_fence(__ATOMIC_RELEASE, "agent");
            asm volatile("s_waitcnt vmcnt(0)" ::: "memory");
            const unsigned og = xb_add(&bar[XB_TOP], 1u);
            const unsigned tg = og / nx;
            if (og + 1u == (tg + 1u) * nx) xb_add(&bar[XB_TOPGEN], 1u);
            else XB_SPIN(xb_ld(&bar[XB_TOPGEN]) == tg, bar);
            __builtin_amdgcn_fence(__ATOMIC_ACQUIRE, "agent");
            xb_add(&bar[XB_XGEN(b.x)], 1u);
            asm volatile("s_waitcnt vmcnt(0)" ::: "memory");
        } else {
            XB_SPIN(xb_ld(&bar[XB_XGEN(b.x)]) == gen, bar);
            __builtin_amdgcn_fence(__ATOMIC_ACQUIRE, "agent");
            asm volatile("s_waitcnt vmcnt(0)" ::: "memory");
        }
    }
    __syncthreads();
}

namespace att {
typedef short bf16x8 __attribute__((ext_vector_type(8)));
typedef short s16x4 __attribute__((ext_vector_type(4)));
typedef float f32x16 __attribute__((ext_vector_type(16)));
typedef float f32x4 __attribute__((ext_vector_type(4)));
typedef unsigned u32x4 __attribute__((ext_vector_type(4)));
typedef unsigned short bf16;
typedef float f32x2v __attribute__((ext_vector_type(2)));
constexpr int D = 128, NW = 8, QBLK = 32, KVBLK = 64, QB = NW * QBLK;
constexpr int SHM_V = KVBLK * D * 2, SHM_K = KVBLK * D * 2;
constexpr int LDS_SEL = 2 * SHM_V + 2 * SHM_K + NW * 64 * 4;
constexpr int LDS_BYTES = LDS_SEL + 2 * QB * 4;
constexpr float SCALE = 0.08838834764831845f, THR = 8.f;
#define KSWZ(row, colB) ((row) * 256 + ((colB) ^ (((row) & 7) << 4)))
#define SBAR() __builtin_amdgcn_sched_barrier(0)
__device__ __forceinline__ int v_st(int k, int c) { const int kk = (k & ~0xC) | ((k & 4) << 1) | ((k & 8) >> 1); return ((kk >> 3) * 4 + (c >> 5)) * 512 + ((kk & 7) * 32 + (c & 31)) * 2; }
__device__ __forceinline__ int v_rd_base(int lane) { return ((lane & 3) << 3) | (((lane >> 2) & 3) << 6) | (((lane >> 4) & 1) << 5) | (((lane >> 5) & 1) << 8); }
constexpr int v_rd_off(int d0, int ks, int half) { return d0 * 512 + ks * 4096 + half * 2048; }
__device__ __forceinline__ int crow(int r, int hi) { return (r & 3) + 8 * (r >> 2) + 4 * hi; }
__device__ __forceinline__ unsigned cvtpk(float lo, float hi) { unsigned r; asm volatile("v_cvt_pk_bf16_f32 %0, %1, %2" : "=v"(r) : "v"(lo), "v"(hi)); return r; }
__device__ __forceinline__ bf16x8 load8(const bf16* p) { return *reinterpret_cast<const bf16x8*>(p); }
__device__ __forceinline__ void mask_causal(f32x16& p0, f32x16& p1, int dq) {
    const float NEG = -__builtin_inff();
#pragma unroll
    for (int r = 0; r < 16; ++r) { const int c = (r & 3) + 8 * (r >> 2); if (dq - c < 0) p0[r] = NEG; if (dq - c - 32 < 0) p1[r] = NEG; }
}
template <bool MOBA>
__device__ __forceinline__ void partialSM(f32x16& p0, f32x16& p1, float& m_reg, float& mn, float& alpha, bool rm) {
    float pmax = p0[0]; for (int r = 1; r < 16; ++r) pmax = fmaxf(pmax, p0[r]); for (int r = 0; r < 16; ++r) pmax = fmaxf(pmax, p1[r]);
    { auto rr = __builtin_amdgcn_permlane32_swap(__float_as_uint(pmax), __float_as_uint(pmax), false, false);
      pmax = fmaxf(__uint_as_float(rr[0]), __uint_as_float(rr[1])); }
    if (MOBA && rm) pmax = -__builtin_inff();
    constexpr float C2 = 1.4426950408889634f * SCALE;
    if (__builtin_expect(__all((pmax - m_reg) * SCALE <= THR), 1)) { mn = m_reg; alpha = 1.f; }
    else { mn = fmaxf(m_reg, pmax); alpha = __builtin_amdgcn_exp2f((m_reg - mn) * C2); m_reg = mn; }
    float mnL = -mn * C2; if (MOBA && rm) mnL = -__builtin_inff();
    for (int r = 0; r < 16; ++r) p0[r] = fmaf(p0[r], C2, mnL); for (int r = 0; r < 16; ++r) p1[r] = fmaf(p1[r], C2, mnL);
    for (int r = 0; r < 16; ++r) p0[r] = __builtin_amdgcn_exp2f(p0[r]);
}
__device__ __forceinline__ void finishSM(f32x16& p0, f32x16& p1, float alpha, float& l_reg, bf16x8& pa0, bf16x8& pa1, bf16x8& pa2, bf16x8& pa3) {
    for (int r = 0; r < 16; ++r) p1[r] = __builtin_amdgcn_exp2f(p1[r]);
    float ps = 0; for (int r = 0; r < 16; ++r) ps += p0[r]; for (int r = 0; r < 16; ++r) ps += p1[r];
    { auto rr = __builtin_amdgcn_permlane32_swap(__float_as_uint(ps), __float_as_uint(ps), false, false);
      ps = __uint_as_float(rr[0]) + __uint_as_float(rr[1]); }
    l_reg = l_reg * alpha + ps;
#define PK4(P, B_, OUT) do { unsigned a0 = cvtpk(P[B_+0], P[B_+1]), a1 = cvtpk(P[B_+2], P[B_+3]);                          \
        unsigned b0 = cvtpk(P[B_+4], P[B_+5]), b1 = cvtpk(P[B_+6], P[B_+7]);                                             \
        auto r0 = __builtin_amdgcn_permlane32_swap(a0, b0, false, false); auto r1 = __builtin_amdgcn_permlane32_swap(a1, b1, false, false); \
        u32x4 w = {r0[0], r1[0], r0[1], r1[1]}; OUT = *reinterpret_cast<bf16x8*>(&w); } while (0)
    PK4(p0, 0, pa0); PK4(p0, 8, pa1); PK4(p1, 0, pa2); PK4(p1, 8, pa3);
#undef PK4
}
template <int KB>
__device__ __forceinline__ void qkt(f32x16& p0, f32x16& p1, const char* K_lds, int r32, int hi, const bf16x8* qr) {
    p0 = f32x16{}; p1 = f32x16{};
    const char* kb[4];
#pragma unroll
    for (int dd = 0; dd < 4; ++dd) kb[dd] = K_lds + KB * SHM_K + KSWZ(r32, (dd * 16 + hi * 8) * 2);
#pragma unroll
    for (int d0 = 0; d0 < 8; ++d0) { const char* a = kb[d0 & 3] + (d0 >> 2) * 128;
        bf16x8 b0 = *reinterpret_cast<const bf16x8*>(a);
        bf16x8 b1 = *reinterpret_cast<const bf16x8*>(a + 32 * 256);
        p0 = __builtin_amdgcn_mfma_f32_32x32x16_bf16(b0, qr[d0], p0, 0, 0, 0);
        p1 = __builtin_amdgcn_mfma_f32_32x32x16_bf16(b1, qr[d0], p1, 0, 0, 0); }
}
template <int VB>
__device__ __forceinline__ void pv_tile(f32x16* o, int vb0, bf16x8 pa0, bf16x8 pa1, bf16x8 pa2, bf16x8 pa3) {
#define TRRD(dst, off) asm volatile("ds_read_b64_tr_b16 %0, %1 offset:%2" : "=&v"(dst) : "v"(vb0), "i"(off) : "memory")
#define PV_D0(d0) do { s16x4 l0, l1, l2, l3, h0, h1, h2, h3; constexpr int b_ = VB * SHM_V + v_rd_off(d0, 0, 0); \
        TRRD(l0, b_); TRRD(h0, b_ + 2048); TRRD(l1, b_ + 4096); TRRD(h1, b_ + 6144); TRRD(l2, b_ + 8192); TRRD(h2, b_ + 10240); TRRD(l3, b_ + 12288); TRRD(h3, b_ + 14336); \
        asm volatile("s_waitcnt lgkmcnt(0)" ::: "memory"); SBAR();   \
        o[d0] = __builtin_amdgcn_mfma_f32_32x32x16_bf16(pa0, (bf16x8){l0[0], l0[1], l0[2], l0[3], h0[0], h0[1], h0[2], h0[3]}, o[d0], 0, 0, 0);   \
        o[d0] = __builtin_amdgcn_mfma_f32_32x32x16_bf16(pa1, (bf16x8){l1[0], l1[1], l1[2], l1[3], h1[0], h1[1], h1[2], h1[3]}, o[d0], 0, 0, 0);   \
        o[d0] = __builtin_amdgcn_mfma_f32_32x32x16_bf16(pa2, (bf16x8){l2[0], l2[1], l2[2], l2[3], h2[0], h2[1], h2[2], h2[3]}, o[d0], 0, 0, 0);   \
        o[d0] = __builtin_amdgcn_mfma_f32_32x32x16_bf16(pa3, (bf16x8){l3[0], l3[1], l3[2], l3[3], h3[0], h3[1], h3[2], h3[3]}, o[d0], 0, 0, 0); } while (0)
    PV_D0(0); PV_D0(1); PV_D0(2); PV_D0(3);
#undef PV_D0
#undef TRRD
}
template <int QS>
__device__ __forceinline__ void moba_gate(int tid, const bf16* Q, const float* KM, int qb, unsigned* selw) {
    const int wid = __builtin_amdgcn_readfirstlane(tid >> 6), lane = tid & 63, r32 = lane & 31, hi = lane >> 5;
    bf16x8 qr[8];
#pragma unroll
    for (int d0 = 0; d0 < 8; ++d0) qr[d0] = load8(Q + (size_t)(wid * QBLK + r32) * QS + d0 * 16 + hi * 8);
    unsigned sel = 0u;
    {
        f32x16 g = {};
        const float* km = KM + (size_t)r32 * D + hi * 8;
#pragma unroll
        for (int d0 = 0; d0 < 8; ++d0) { const f32x4 a = *(const f32x4*)(km + d0 * 16), b = *(const f32x4*)(km + d0 * 16 + 4);
            u32x4 wh = {cvtpk(a[0], a[1]), cvtpk(a[2], a[3]), cvtpk(b[0], b[1]), cvtpk(b[2], b[3])};
            const f32x4 al = {a[0] - __uint_as_float(wh[0] << 16), a[1] - __uint_as_float(wh[0] & 0xffff0000u), a[2] - __uint_as_float(wh[1] << 16), a[3] - __uint_as_float(wh[1] & 0xffff0000u)};
            const f32x4 bl = {b[0] - __uint_as_float(wh[2] << 16), b[1] - __uint_as_float(wh[2] & 0xffff0000u), b[2] - __uint_as_float(wh[3] << 16), b[3] - __uint_as_float(wh[3] & 0xffff0000u)};
            u32x4 wl = {cvtpk(al[0], al[1]), cvtpk(al[2], al[3]), cvtpk(bl[0], bl[1]), cvtpk(bl[2], bl[3])};
            g = __builtin_amdgcn_mfma_f32_32x32x16_bf16(*reinterpret_cast<bf16x8*>(&wh), qr[d0], g, 0, 0, 0);
            g = __builtin_amdgcn_mfma_f32_32x32x16_bf16(*reinterpret_cast<bf16x8*>(&wl), qr[d0], g, 0, 0, 0); }
        const int IMIN = (int)0x80000000;
        int key[16];
#pragma unroll
        for (int r = 0; r < 16; ++r) { const int n = crow(r, hi); const int bits = (int)__float_as_uint(g[r]); const int s = bits ^ ((bits >> 31) & 0x7fffffff);
            key[r] = (n < qb) ? ((s & ~31) | (31 - n)) : IMIN; }
        int m1 = IMIN, m2 = IMIN, m3 = IMIN;
#pragma unroll
        for (int r = 0; r < 16; ++r) m1 = max(m1, key[r]);
#pragma unroll
        for (int r = 0; r < 16; ++r) m2 = max(m2, key[r] < m1 ? key[r] : IMIN);
#pragma unroll
        for (int r = 0; r < 16; ++r) m3 = max(m3, key[r] < m2 ? key[r] : IMIN);
        int c6[6];
        { auto r1 = __builtin_amdgcn_permlane32_swap((unsigned)m1, (unsigned)m1, false, false); c6[0] = (int)r1[0]; c6[1] = (int)r1[1];
          auto r2 = __builtin_amdgcn_permlane32_swap((unsigned)m2, (unsigned)m2, false, false); c6[2] = (int)r2[0]; c6[3] = (int)r2[1];
          auto r3 = __builtin_amdgcn_permlane32_swap((unsigned)m3, (unsigned)m3, false, false); c6[4] = (int)r3[0]; c6[5] = (int)r3[1]; }
        int t1 = IMIN, t2 = IMIN, t3 = IMIN;
#pragma unroll
        for (int r = 0; r < 6; ++r) t1 = max(t1, c6[r]);
#pragma unroll
        for (int r = 0; r < 6; ++r) t2 = max(t2, c6[r] < t1 ? c6[r] : IMIN);
#pragma unroll
        for (int r = 0; r < 6; ++r) t3 = max(t3, c6[r] < t2 ? c6[r] : IMIN);
        if (t1 != IMIN) sel |= 1u << (31 - (t1 & 31));
        if (t2 != IMIN) sel |= 1u << (31 - (t2 & 31));
        if (t3 != IMIN) sel |= 1u << (31 - (t3 & 31));
    }
    if (hi == 0) selw[wid * QBLK + r32] = sel;
}
struct Seam { bf16x8 qr[8]; bf16x8 st_v0, st_v1, st_k0, st_k1; };
#define ROWP(p, k0, rr, str) ((p) + (size_t)((k0) + (rr)) * (str) + sc)
#define VMW() asm volatile("s_waitcnt vmcnt(0)" ::: "memory")
#define VMWN(n) asm volatile("s_waitcnt vmcnt(%0)" :: "i"(n) : "memory")
#define SLOAD_H(Kp, Vp, k0, str) do { S.st_v0 = load8(ROWP(Vp, k0, sr, str)); S.st_v1 = load8(ROWP(Vp, k0, 32 + sr, str));              \
                         S.st_k0 = load8(ROWP(Kp, k0, sr, str)); S.st_k1 = load8(ROWP(Kp, k0, 32 + sr, str)); } while (0)
#define SWRITE_HK(bf) do { *(bf16x8*)(K_lds + (bf) * SHM_K + kws) = S.st_k0; *(bf16x8*)(K_lds + (bf) * SHM_K + kws + 32 * 256) = S.st_k1; } while (0)
#define SWRITE_HV(bf) do { *(bf16x8*)(V_lds + (bf) * SHM_V + vst0) = S.st_v0; *(bf16x8*)(V_lds + (bf) * SHM_V + vst1) = S.st_v1; } while (0)
#define SWRITE_H(bf) do { SWRITE_HV(bf); SWRITE_HK(bf); } while (0)
template <int QS, int KVS, long VOFF>
__device__ __forceinline__ void attn_prime(int tid, const bf16* curQ, const bf16* curK, char* lds, Seam& S) {
    const int wid = __builtin_amdgcn_readfirstlane(tid >> 6), lane = tid & 63, r32 = lane & 31, hi = lane >> 5;
    const int sr = tid >> 4, sc = (tid & 15) * 8, kws = KSWZ(sr, sc * 2); char* K_lds = lds + 2 * SHM_V;
    for (int d0 = 0; d0 < 8; ++d0) S.qr[d0] = load8(curQ + (size_t)(wid * QBLK + r32) * QS + d0 * 16 + hi * 8);
    SLOAD_H(curK, curK + VOFF, 0, KVS); VMW(); SWRITE_HK(0);
    __syncthreads();
}
template <bool MOBA, int QS, int KVS, long VOFF, int OS>
__device__ __forceinline__ void attn_block(int tid, const bf16* curK, bf16* curO, int NT, int selofs, const bf16* nxtQ, const bf16* nxtK, char* lds, Seam& S) {
    const int wid = __builtin_amdgcn_readfirstlane(tid >> 6), lane = tid & 63, r32 = lane & 31, hi = lane >> 5;
    const int qlo = wid * QBLK, qm = qlo + r32 - 4 * hi;
    char* V_lds = lds; char* K_lds = lds + 2 * SHM_V;
    float* ws = (float*)(lds + 2 * SHM_V + 2 * SHM_K) + wid * 64; float* li_l = ws, * al_l = ws + 32;
    const int sr = tid >> 4, sc = (tid & 15) * 8, vst0 = v_st(sr, sc), vst1 = v_st(32 + sr, sc), kws = KSWZ(sr, sc * 2);
    const int vb0 = (int)(uintptr_t)V_lds + v_rd_base(lane);
    const bf16* Kh = curK; const bf16* Vh = curK + VOFF; constexpr int kvs = KVS;
    unsigned sel = 0u;
    if (MOBA) sel = ((const unsigned*)(lds + LDS_SEL))[selofs + wid * QBLK + r32];
    float m_reg = -1e30f, l_reg = 0; f32x16 o[4] = {};
#define RESC(a) do { if (__any((a) < 1.f)) { if (hi == 0) al_l[r32] = (a); asm volatile("s_waitcnt lgkmcnt(0)" ::: "memory");              \
                     for (int d_ = 0; d_ < 4; ++d_) for (int r = 0; r < 16; ++r) o[d_][r] *= al_l[crow(r, hi)]; } } while (0)
#define KBASE(t) ((t) * KVBLK)
#define MASKT(P0_, P1_, t) do { if (MOBA) { const int kb_ = ((t) - (NT - 4)) * KVBLK; if (kb_ >= 0 && kb_ + KVBLK - 1 > qlo) mask_causal(P0_, P1_, qm - kb_); } } while (0)
#define RMT(t) (MOBA && ((t) < NT - 4) && !((sel >> ((t) >> 2)) & 1u))
    const int NQL = 8;
#define SEAM_K0() do { VMWN(8); SWRITE_HK(0); SBAR(); } while (0)
    f32x16 pA0, pA1, pB0, pB1; float mnA, mnB, alA, alB; bf16x8 pa0, pa1, pa2, pa3;
    (void)NQL;
    SWRITE_HV(0); SBAR();
    if (NT > 1) SLOAD_H(Kh, Vh, KBASE(1), kvs);
    SBAR(); qkt<0>(pA0, pA1, K_lds, r32, hi, S.qr);
    MASKT(pA0, pA1, 0); partialSM<MOBA>(pA0, pA1, m_reg, mnA, alA, RMT(0));
    if (NT > 1) { VMW(); SWRITE_H(1); }
    __syncthreads();
#define HALF_STEP(PX0, PX1, mnX, alX, PY0, PY1, alY, t, KB, VB, SB) do {                                                      \
        SBAR(); qkt<KB>(PX0, PX1, K_lds, r32, hi, S.qr);                                             \
        finishSM(PY0, PY1, alY, l_reg, pa0, pa1, pa2, pa3); SBAR();                                                           \
        if ((t) + 1 < NT) { SLOAD_H(Kh, Vh, KBASE((t) + 1), kvs); SBAR(); }                                               \
        pv_tile<VB>(o, vb0, pa0, pa1, pa2, pa3); MASKT(PX0, PX1, (t)); partialSM<MOBA>(PX0, PX1, m_reg, mnX, alX, RMT(t));                                        \
        __syncthreads();                                                                                                      \
        if ((t) + 1 < NT) { VMW(); SWRITE_H(SB); }                                                                          \
        RESC(alX); __syncthreads(); } while (0)
    for (int t = 1; t + 1 < NT; t += 2) {
        HALF_STEP(pB0, pB1, mnB, alB, pA0, pA1, alA, t, 1, 0, 0);
        HALF_STEP(pA0, pA1, mnA, alA, pB0, pB1, alB, t + 1, 0, 1, 1);
    }
    const bool even = (NT & 1) == 0;
    if (even) { SBAR(); qkt<1>(pB0, pB1, K_lds, r32, hi, S.qr); SBAR(); }
    SLOAD_H(nxtK, nxtK + VOFF, 0, KVS); SBAR();
#pragma unroll
    for (int d0 = 0; d0 < 8; ++d0) S.qr[d0] = load8(nxtQ + (size_t)(wid * QBLK + r32) * QS + d0 * 16 + hi * 8);
    SBAR();
    finishSM(pA0, pA1, alA, l_reg, pa0, pa1, pa2, pa3); SBAR();
    pv_tile<0>(o, vb0, pa0, pa1, pa2, pa3);
    if (even) { MASKT(pB0, pB1, NT - 1); partialSM<MOBA>(pB0, pB1, m_reg, mnB, alB, RMT(NT - 1)); __syncthreads(); RESC(alB);
        finishSM(pB0, pB1, alB, l_reg, pa0, pa1, pa2, pa3); SBAR(); pv_tile<1>(o, vb0, pa0, pa1, pa2, pa3); }
    SBAR(); SEAM_K0();
    if (hi == 0) li_l[r32] = l_reg; asm volatile("s_waitcnt lgkmcnt(0)" ::: "memory");
    float rli[16];
#pragma unroll
    for (int r = 0; r < 16; ++r) rli[r] = __builtin_amdgcn_rcpf(li_l[crow(r, hi)]);
    bf16* Ow = curO + (size_t)(wid * QBLK) * OS;
#pragma unroll
    for (int r = 0; r < 16; ++r) { const int orow = crow(r, hi);
#pragma unroll
        for (int d0 = 0; d0 < 4; ++d0) { const float v = o[d0][r] * rli[r];
            const float vn = __shfl_xor(v, 1);
            if ((r32 & 1) == 0) *(unsigned*)(Ow + (size_t)orow * OS + d0 * 32 + r32) = cvtpk(v, vn); } }
    __syncthreads();
#undef RESC
#undef KBASE
#undef MASKT
#undef RMT
#undef SEAM_K0
#undef HALF_STEP
}

constexpr int SP_K = 0, SP_V = 4 * SHM_K, SP_LIST = 8 * SHM_K, SP_WS = SP_LIST + 16384, SP_CTRL = SP_WS + NW * 64 * 4, SP_BYTES = SP_CTRL + 64;
__device__ __forceinline__ void qkt_r(f32x16& p0, f32x16& p1, const char* Kt, int r32, int hi, const bf16x8* qr) {
    p0 = f32x16{}; p1 = f32x16{};
    const char* kb[4];
#pragma unroll
    for (int dd = 0; dd < 4; ++dd) kb[dd] = Kt + KSWZ(r32, (dd * 16 + hi * 8) * 2);
#pragma unroll
    for (int d0 = 0; d0 < 8; ++d0) { const char* a = kb[d0 & 3] + (d0 >> 2) * 128;
        bf16x8 b0 = *reinterpret_cast<const bf16x8*>(a);
        bf16x8 b1 = *reinterpret_cast<const bf16x8*>(a + 32 * 256);
        p0 = __builtin_amdgcn_mfma_f32_32x32x16_bf16(b0, qr[d0], p0, 0, 0, 0);
        p1 = __builtin_amdgcn_mfma_f32_32x32x16_bf16(b1, qr[d0], p1, 0, 0, 0); }
}
__device__ __forceinline__ void pv_r(f32x16* o, int vbt, bf16x8 pa0, bf16x8 pa1, bf16x8 pa2, bf16x8 pa3) {
#define TRRD(dst, off) asm volatile("ds_read_b64_tr_b16 %0, %1 offset:%2" : "=&v"(dst) : "v"(vbt), "i"(off) : "memory")
#define PV_D0(d0) do { s16x4 l0, l1, l2, l3, h0, h1, h2, h3; constexpr int b_ = v_rd_off(d0, 0, 0); \
        TRRD(l0, b_); TRRD(h0, b_ + 2048); TRRD(l1, b_ + 4096); TRRD(h1, b_ + 6144); TRRD(l2, b_ + 8192); TRRD(h2, b_ + 10240); TRRD(l3, b_ + 12288); TRRD(h3, b_ + 14336); \
        asm volatile("s_waitcnt lgkmcnt(0)" ::: "memory"); SBAR();   \
        o[d0] = __builtin_amdgcn_mfma_f32_32x32x16_bf16(pa0, (bf16x8){l0[0], l0[1], l0[2], l0[3], h0[0], h0[1], h0[2], h0[3]}, o[d0], 0, 0, 0);   \
        o[d0] = __builtin_amdgcn_mfma_f32_32x32x16_bf16(pa1, (bf16x8){l1[0], l1[1], l1[2], l1[3], h1[0], h1[1], h1[2], h1[3]}, o[d0], 0, 0, 0);   \
        o[d0] = __builtin_amdgcn_mfma_f32_32x32x16_bf16(pa2, (bf16x8){l2[0], l2[1], l2[2], l2[3], h2[0], h2[1], h2[2], h2[3]}, o[d0], 0, 0, 0);   \
        o[d0] = __builtin_amdgcn_mfma_f32_32x32x16_bf16(pa3, (bf16x8){l3[0], l3[1], l3[2], l3[3], h3[0], h3[1], h3[2], h3[3]}, o[d0], 0, 0, 0); } while (0)
    PV_D0(0); PV_D0(1); PV_D0(2); PV_D0(3);
#undef PV_D0
#undef TRRD
}
__device__ __forceinline__ unsigned sp_rowslot(int it, int nown, int n, int cnt, const unsigned short* list, int r32) {
    if (it < nown) return (unsigned)(n * 256 + it * 32 + r32) | (3u << 13) | 0x8000u;
    const int idx = (it - nown) * 32 + r32; const bool ok = idx < cnt;
    return (unsigned)list[ok ? idx : cnt - 1] | (ok ? 0x8000u : 0u);
}
template <int QS, int KVS, long VOFF>
__device__ __forceinline__ void moba_sparse_unit(int tid, int b, int h, int n, int qlo, int qhi, const bf16* QP, const bf16* KP, const unsigned* SEL, bf16* Pb, float* ML, char* lds) {
    const int wid = __builtin_amdgcn_readfirstlane(tid >> 6), lane = tid & 63, r32 = lane & 31, hi = lane >> 5;
    char* K_lds = lds + SP_K; char* V_lds = lds + SP_V; unsigned short* list = (unsigned short*)(lds + SP_LIST); unsigned* ctrl = (unsigned*)(lds + SP_CTRL);
    float* ws = (float*)(lds + SP_WS) + wid * 64; float* li_l = ws, * al_l = ws + 32;
    { const int sr = tid >> 4, sc = (tid & 15) * 8, vst0 = v_st(sr, sc), vst1 = v_st(32 + sr, sc), kws = KSWZ(sr, sc * 2);
      const bf16* Kb = KP + ((size_t)b * 8192 + (size_t)n * 256 + sr) * KVS + h * D + sc; const bf16* Vb = Kb + VOFF;
      bf16x8 kk[8], vv[8];
#pragma unroll
      for (int kt = 0; kt < 4; ++kt) { kk[2 * kt] = load8(Kb + (size_t)(kt * 64) * KVS); kk[2 * kt + 1] = load8(Kb + (size_t)(kt * 64 + 32) * KVS);
                                       vv[2 * kt] = load8(Vb + (size_t)(kt * 64) * KVS); vv[2 * kt + 1] = load8(Vb + (size_t)(kt * 64 + 32) * KVS); }
      if (tid == 0) ctrl[0] = 0u;
#pragma unroll
      for (int kt = 0; kt < 4; ++kt) { *(bf16x8*)(K_lds + kt * SHM_K + kws) = kk[2 * kt]; *(bf16x8*)(K_lds + kt * SHM_K + kws + 32 * 256) = kk[2 * kt + 1];
                                       *(bf16x8*)(V_lds + kt * SHM_V + vst0) = vv[2 * kt]; *(bf16x8*)(V_lds + kt * SHM_V + vst1) = vv[2 * kt + 1]; } }
    __syncthreads();
    { const unsigned* selp = SEL + (size_t)(b * 8 + h) * 8192; const int r0 = (qlo > n ? qlo : n + 1) * 256, r1 = qhi * 256;
      for (int base = r0 + wid * 64; base < r1; base += NW * 64) { const int row = base + lane; const unsigned s = selp[row]; const bool bit = (s >> n) & 1u;
          const unsigned long long bal = __ballot(bit);
          if (bal) { unsigned off = 0u; if (lane == 0) off = atomicAdd(&ctrl[0], (unsigned)__popcll(bal)); off = (unsigned)__builtin_amdgcn_readfirstlane((int)off);
              if (bit) list[off + __popcll(bal & ((1ull << lane) - 1ull))] = (unsigned short)(row | (__popc(s & ((1u << n) - 1u)) << 13)); } } }
    __syncthreads();
    const int cnt = (int)ctrl[0], nown = (qlo == n) ? 8 : 0, nitems = nown + ((cnt + 31) >> 5);
    const int vb0 = (int)(uintptr_t)V_lds + v_rd_base(lane);
    const bf16* Qh = QP + (size_t)b * 8192 * QS + h * D + hi * 8;
    if (wid < nitems) {
        bf16x8 qr[8];
        { const unsigned rs = sp_rowslot(wid, nown, n, cnt, list, r32);
#pragma unroll
          for (int d0 = 0; d0 < 8; ++d0) qr[d0] = load8(Qh + (size_t)(rs & 8191u) * QS + d0 * 16); }
        for (int it = wid; it < nitems; it += NW) {
            const bool own = it < nown; const int NT = own ? (((32 * it + 31) >> 6) + 1) : 4;
            const int qlo_r = 32 * it, qm = qlo_r + r32 - 4 * hi;
            float m_reg = -1e30f, l_reg = 0; f32x16 o[4] = {};
#define RESC(a) do { if (__any((a) < 1.f)) { if (hi == 0) al_l[r32] = (a); asm volatile("s_waitcnt lgkmcnt(0)" ::: "memory");              \
                     for (int d_ = 0; d_ < 4; ++d_) for (int r = 0; r < 16; ++r) o[d_][r] *= al_l[crow(r, hi)]; } } while (0)
#define MASKT(P0_, P1_, t) do { if (own) { const int kb_ = (t) * KVBLK; if (kb_ + KVBLK - 1 > qlo_r) mask_causal(P0_, P1_, qm - kb_); } } while (0)
            f32x16 p0, p1; float mn, al; bf16x8 pa0, pa1, pa2, pa3;
            for (int t = 0; t < NT; ++t) {
                SBAR(); qkt_r(p0, p1, K_lds + t * SHM_K, r32, hi, qr);
                if (t == NT - 1) {
                    const int itn = (it + NW < nitems) ? it + NW : it; const unsigned rs = sp_rowslot(itn, nown, n, cnt, list, r32);
#pragma unroll
                    for (int d0 = 0; d0 < 8; ++d0) qr[d0] = load8(Qh + (size_t)(rs & 8191u) * QS + d0 * 16);
                    SBAR(); }
                MASKT(p0, p1, t); partialSM<false>(p0, p1, m_reg, mn, al, false);
                if (t > 0) RESC(al);
                finishSM(p0, p1, al, l_reg, pa0, pa1, pa2, pa3); SBAR();
                pv_r(o, vb0 + t * SHM_V, pa0, pa1, pa2, pa3);
            }
            SBAR();
            const unsigned rs_cur = sp_rowslot(it, nown, n, cnt, list, r32);
            if (hi == 0) li_l[r32] = l_reg; asm volatile("s_waitcnt lgkmcnt(0)" ::: "memory");
            float rli[16];
#pragma unroll
            for (int r = 0; r < 16; ++r) rli[r] = __builtin_amdgcn_rcpf(li_l[crow(r, hi)]);
            asm volatile("s_waitcnt lgkmcnt(0)" ::: "memory");
            if (hi == 0 && (rs_cur & 0x8000u)) { float* mp = ML + (((size_t)(b * 8 + h) * 8192 + (rs_cur & 8191u)) * 4 + ((rs_cur >> 13) & 3u)) * 2; *(f32x2v*)mp = (f32x2v){m_reg, l_reg}; }
#pragma unroll
            for (int r = 0; r < 16; ++r) { const unsigned rv = (unsigned)__shfl((int)rs_cur, crow(r, hi));
                bf16* dst = Pb + (((size_t)h * 8192 + (rv & 8191u)) * 4 + ((rv >> 13) & 3u)) * D; const bool st = (rv & 0x8000u) && ((r32 & 1) == 0);
#pragma unroll
                for (int d0 = 0; d0 < 4; ++d0) { const float v = o[d0][r] * rli[r];
                    const float vn = __shfl_xor(v, 1);
                    if (st) *(unsigned*)(dst + d0 * 32 + r32) = cvtpk(v, vn); } }
#undef RESC
#undef MASKT
        }
    }
    __syncthreads();
}
#undef ROWP
#undef VMW
#undef VMWN
#undef SLOAD_H
#undef SWRITE_HK
#undef SWRITE_HV
#undef SWRITE_H
#undef KSWZ
#undef SBAR
}

constexpr int NWAVES = 8;
#ifndef MK_PER_PHASE
#define MK_PER_PHASE 0
#endif
constexpr int N_PHASES = 13;

constexpr int NB = 2, SEQ = 8192, DM = 2048, M = NB * SEQ;
constexpr int NH = 8, HD = 128, AW = NH * HD, CWID = 1024, NPROJ = 3 * AW + 3 * CWID + 2 * DM;
constexpr int NMEM = 256, XH = 4, XW = XH * HD, DFF = 4 * DM;
constexpr int MBLK = 256, NBLK = SEQ / MBLK, TOPK = 3;
constexpr float EPS = 1e-6f;
constexpr float ATT_SCALE = 0.08838834764831845f;

constexpr size_t MiB = 1u << 20;
constexpr size_t WS_CTL = 0, CTL_ZERO_BYTES = 1 * MiB;
constexpr size_t WS_ROPE = 2 * MiB;
constexpr size_t WS_KMEAN = 3 * MiB;
constexpr size_t WS_SS1 = 3 * MiB + 512 * 1024;
constexpr size_t WS_SS2 = WS_SS1 + 128 * 1024, WS_SS3 = WS_SS2 + 128 * 1024;
constexpr size_t WS_MEMN = 4 * MiB;
constexpr size_t WS_MKV = 6 * MiB;
constexpr size_t WS_WIN = 8 * MiB;
constexpr size_t WS_WAC = 48 * MiB;
constexpr size_t WS_WM = 56 * MiB;
constexpr size_t WS_WQ = 64 * MiB;
constexpr size_t WS_WKV = 66 * MiB;
constexpr size_t WS_WO = 70 * MiB;
constexpr size_t WS_WUP = 72 * MiB;
constexpr size_t WS_WD = 104 * MiB;
constexpr size_t WS_XB = 136 * MiB;
constexpr size_t WS_G = 200 * MiB;
constexpr size_t GRP = 32 * MiB;
constexpr size_t WS_RATIO = 360 * MiB, WS_SC = 424 * MiB;
constexpr size_t WS_MERGED = 200 * MiB;
constexpr size_t WS_HQ = 264 * MiB, WS_XO = 280 * MiB;
constexpr size_t WS_UP = 232 * MiB;
constexpr size_t WS_ML = 488 * MiB;
constexpr size_t WS_SEL = 492 * MiB;
constexpr size_t WS_END = 493 * MiB;
constexpr int CW_TMO = 0, CW_CODE = 1, CW_QUEUE = 64, CW_BAR = 4096;

constexpr int RING_OFF = 0, RING_BYTES = 131072;
constexpr int LDSCTL_OFF = 155648, MISC_OFF = LDSCTL_OFF + 320;
constexpr int LDS_BYTES = 163840;

__device__ __forceinline__ float bf2f(unsigned short b) { return __uint_as_float((unsigned)b << 16); }
__device__ __forceinline__ float bflo(unsigned w) { return __uint_as_float(w << 16); }
__device__ __forceinline__ float bfhi(unsigned w) { return __uint_as_float(w & 0xffff0000u); }
__device__ __forceinline__ float wave_sum(float v) {
#pragma unroll
    for (int o = 1; o < 64; o <<= 1) v += __shfl_xor(v, o);
    return v;
}
__device__ __forceinline__ float wave_max(float v) {
#pragma unroll
    for (int o = 1; o < 64; o <<= 1) v = fmaxf(v, __shfl_xor(v, o));
    return v;
}

constexpr int TR_SCR = 64 * 65 * 4;
__device__ __forceinline__ void p0_transpose_item(const float* W, int K, int N, bf16* WT, int ldk, int koff, int row_off, const float* gk, LAS float* scr, int item, int lane) {
    const int nblk = N / 64, kb = item / nblk, nb = item % nblk, k0 = 64 * kb, n0 = 64 * nb;
    const int lr = lane >> 4, lc = (lane & 15) * 4;
    f32x4 v[16];
#pragma unroll
    for (int i = 0; i < 16; ++i) v[i] = *(const GAS f32x4*)(W + (size_t)(k0 + 4 * i + lr) * N + n0 + lc);
#pragma unroll
    for (int i = 0; i < 16; ++i) { const int kk = 4 * i + lr; f32x4 w = v[i]; if (gk) { const float g = gk[k0 + kk]; w = w * g; }
        LAS float* d = scr + kk * 65 + lc; d[0] = w.x; d[1] = w.y; d[2] = w.z; d[3] = w.w; }
    LDS_WAIT(); asm volatile("" ::: "memory");
    const int c = lane & 7;
#pragma unroll
    for (int j = 0; j < 8; ++j) { const int n = (lane >> 3) + 8 * j; const LAS float* s = scr + (8 * c) * 65 + n;
        v4u o; o.x = pk2(s[0 * 65], s[1 * 65]); o.y = pk2(s[2 * 65], s[3 * 65]); o.z = pk2(s[4 * 65], s[5 * 65]); o.w = pk2(s[6 * 65], s[7 * 65]);
        *(GAS v4u*)(WT + (size_t)(row_off + n0 + n) * ldk + koff + k0 + 8 * c) = o; }
    LDS_WAIT(); asm volatile("" ::: "memory");
}
__device__ __forceinline__ void rms_row_to_bf16(const float* xrow, const float* g, bf16* orow, int lane) {
    const GAS f32x4* xr = (const GAS f32x4*)xrow + lane; const GAS f32x4* gr = (const GAS f32x4*)g + lane;
    f32x4 v[8]; float s = 0.f;
#pragma unroll
    for (int j = 0; j < 8; ++j) { v[j] = xr[64 * j]; s += (v[j].x * v[j].x + v[j].y * v[j].y) + (v[j].z * v[j].z + v[j].w * v[j].w); }
    const float rstd = 1.f / sqrtf(wave_sum(s) * (1.f / DM) + EPS);
    GAS unsigned long long* o8 = (GAS unsigned long long*)orow + lane;
#pragma unroll
    for (int j = 0; j < 8; ++j) { const f32x4 gg = gr[64 * j];
        o8[64 * j] = (unsigned long long)pk2(v[j].x * rstd * gg.x, v[j].y * rstd * gg.y) | ((unsigned long long)pk2(v[j].z * rstd * gg.z, v[j].w * rstd * gg.w) << 32); }
}
__device__ __forceinline__ float row_rstd(const float* xrow, int lane) {
    const GAS f32x4* xr = (const GAS f32x4*)xrow + lane; float s = 0.f;
#pragma unroll
    for (int j = 0; j < 8; ++j) { const f32x4 v = xr[64 * j]; s += (v.x * v.x + v.y * v.y) + (v.z * v.z + v.w * v.w); }
    return 1.f / sqrtf(wave_sum(s) * (1.f / DM) + EPS);
}

__device__ const float ROPE_INV_FREQ[16] = {1.f, 0.440366596f, 0.193922743f, 0.0853971019f, 0.0376060307f, 0.016560439f, 0.00729266461f, 0.00321144587f, 0.00141421356f, 0.000622772379f, 0.000274248188f, 0.000120769735f, 5.3182961e-05f, 2.34199997e-05f, 1.03133862e-05f, 4.54167048e-06f};
constexpr int MOBA_NUNITS = 56;
__device__ const unsigned short MOBA_UNITS[56] = {5186, 2048, 3105, 12486, 32272, 14530, 6240, 6243, 16608, 32166, 32305, 13543, 8321, 15587, 14600, 32338, 32199, 7300, 19745, 15657, 32371, 16644, 32226, 32232, 8357, 32404, 15690, 17701, 32437, 32259, 32265, 32266, 16747, 32470, 17804, 32288, 32292, 32299, 32503, 17837, 32325, 32332, 32333, 32536, 18894, 19951, 32569, 32366, 32602, 32385, 32399, 32635, 32668, 32701, 32734, 32767};
struct Args { const float* in[17]; float* out; unsigned char* ws; int ph_lo, ph_hi, li, pad; };

__device__ __forceinline__ void naive_moba_item(int b, int h, int i, const bf16* QP, const bf16* KP, const bf16* VP, const float2* ROPE, const float* KMEAN, bf16* AO, int lane) {
    const size_t t = (size_t)b * SEQ + i; const int qb = i >> 8;
    float q[128];
    { const v4u* qp = (const v4u*)(QP + t * AW + h * HD);
#pragma unroll
      for (int c = 0; c < 16; ++c) { const v4u w = qp[c]; q[8 * c + 0] = bflo(w.x); q[8 * c + 1] = bfhi(w.x); q[8 * c + 2] = bflo(w.y); q[8 * c + 3] = bfhi(w.y); q[8 * c + 4] = bflo(w.z); q[8 * c + 5] = bfhi(w.z); q[8 * c + 6] = bflo(w.w); q[8 * c + 7] = bfhi(w.w); } }
#pragma unroll
    for (int d = 0; d < 16; ++d) { const float2 cs = ROPE[i * 16 + d]; const float q1 = q[d], q2 = q[d + 16]; q[d] = q1 * cs.x - q2 * cs.y; q[d + 16] = q2 * cs.x + q1 * cs.y; }
    float g = -INFINITY;
    if (lane < qb) { const f32x4* km = (const f32x4*)(KMEAN + ((size_t)(b * NH + h) * NBLK + lane) * HD); float a = 0.f;
#pragma unroll
        for (int c = 0; c < 32; ++c) { const f32x4 k4 = km[c]; a += q[4 * c] * k4.x + q[4 * c + 1] * k4.y + q[4 * c + 2] * k4.z + q[4 * c + 3] * k4.w; }
        g = a; }
    unsigned selmask = 0u;
#pragma unroll
    for (int k = 0; k < TOPK; ++k) { const float mx = wave_max(g);
        if (mx != -INFINITY) { const unsigned long long bal = __ballot(g == mx); const int idx = __ffsll((long long)bal) - 1; selmask |= 1u << idx; if (lane == idx) g = -INFINITY; } }
    selmask |= 1u << qb;
    float s[4][4]; int blk[4]; bool valid[4];
#pragma unroll
    for (int c = 0; c < 4; ++c) { valid[c] = selmask != 0u; blk[c] = valid[c] ? (__ffs((int)selmask) - 1) : 0; selmask &= selmask - 1u; }
    float mloc = -INFINITY;
#pragma unroll
    for (int c = 0; c < 4; ++c)
#pragma unroll
        for (int r = 0; r < 4; ++r) { const int key = blk[c] * MBLK + lane + 64 * r; float sc = -INFINITY;
            if (valid[c] && key <= i) { const v4u* kp = (const v4u*)(KP + ((size_t)b * SEQ + key) * AW + h * HD); float kk[32]; float a = 0.f;
#pragma unroll
                for (int cc = 0; cc < 4; ++cc) { const v4u w = kp[cc]; kk[8 * cc + 0] = bflo(w.x); kk[8 * cc + 1] = bfhi(w.x); kk[8 * cc + 2] = bflo(w.y); kk[8 * cc + 3] = bfhi(w.y); kk[8 * cc + 4] = bflo(w.z); kk[8 * cc + 5] = bfhi(w.z); kk[8 * cc + 6] = bflo(w.w); kk[8 * cc + 7] = bfhi(w.w); }
#pragma unroll
                for (int d = 0; d < 16; ++d) { const float2 cs = ROPE[key * 16 + d]; const float k1 = kk[d], k2 = kk[d + 16]; a += q[d] * (k1 * cs.x - k2 * cs.y) + q[d + 16] * (k2 * cs.x + k1 * cs.y); }
#pragma unroll
                for (int cc = 4; cc < 16; ++cc) { const v4u w = kp[cc]; a += q[8 * cc + 0] * bflo(w.x) + q[8 * cc + 1] * bfhi(w.x) + q[8 * cc + 2] * bflo(w.y) + q[8 * cc + 3] * bfhi(w.y) + q[8 * cc + 4] * bflo(w.z) + q[8 * cc + 5] * bfhi(w.z) + q[8 * cc + 6] * bflo(w.w) + q[8 * cc + 7] * bfhi(w.w); }
                sc = a * ATT_SCALE; }
            s[c][r] = sc; mloc = fmaxf(mloc, sc); }
    const float mx = wave_max(mloc); float lsum = 0.f;
#pragma unroll
    for (int c = 0; c < 4; ++c)
#pragma unroll
        for (int r = 0; r < 4; ++r) { s[c][r] = __expf(s[c][r] - mx); lsum += s[c][r]; }
    const float l = wave_sum(lsum);
    float o0 = 0.f, o1 = 0.f;
#pragma unroll
    for (int c = 0; c < 4; ++c) { if (!valid[c]) continue;
#pragma unroll
        for (int r = 0; r < 4; ++r) { const bf16* vp = VP + ((size_t)b * SEQ + blk[c] * MBLK + 64 * r) * AW + h * HD + 2 * lane;
            for (int src = 0; src < 64; ++src) { const float p = __shfl(s[c][r], src); const unsigned w = *(const unsigned*)(vp + (size_t)src * AW); o0 += p * bflo(w); o1 += p * bfhi(w); } } }
    const float rl = 1.f / l;
    *(unsigned*)(AO + t * AW + h * HD + 2 * lane) = pk2(o0 * rl, o1 * rl);
}
__device__ __forceinline__ void naive_xattn_item(int b, int h, int i, const bf16* HQ, const float* R2, const bf16* MKV, bf16* XO, int lane) {
    const size_t t = (size_t)b * SEQ + i; const float qs = R2[t] * ATT_SCALE;
    float q[128];
    { const v4u* qp = (const v4u*)(HQ + t * XW + h * HD);
#pragma unroll
      for (int c = 0; c < 16; ++c) { const v4u w = qp[c]; q[8 * c + 0] = bflo(w.x) * qs; q[8 * c + 1] = bfhi(w.x) * qs; q[8 * c + 2] = bflo(w.y) * qs; q[8 * c + 3] = bfhi(w.y) * qs; q[8 * c + 4] = bflo(w.z) * qs; q[8 * c + 5] = bfhi(w.z) * qs; q[8 * c + 6] = bflo(w.w) * qs; q[8 * c + 7] = bfhi(w.w) * qs; } }
    float s[4]; float mloc = -INFINITY;
#pragma unroll
    for (int r = 0; r < 4; ++r) { const int key = lane + 64 * r; const v4u* kp = (const v4u*)(MKV + ((size_t)b * NMEM + key) * (2 * XW) + h * HD); float a = 0.f;
#pragma unroll
        for (int cc = 0; cc < 16; ++cc) { const v4u w = kp[cc]; a += q[8 * cc + 0] * bflo(w.x) + q[8 * cc + 1] * bfhi(w.x) + q[8 * cc + 2] * bflo(w.y) + q[8 * cc + 3] * bfhi(w.y) + q[8 * cc + 4] * bflo(w.z) + q[8 * cc + 5] * bfhi(w.z) + q[8 * cc + 6] * bflo(w.w) + q[8 * cc + 7] * bfhi(w.w); }
        s[r] = a; mloc = fmaxf(mloc, a); }
    const float mx = wave_max(mloc); float lsum = 0.f;
#pragma unroll
    for (int r = 0; r < 4; ++r) { s[r] = __expf(s[r] - mx); lsum += s[r]; }
    const float l = wave_sum(lsum);
    float o0 = 0.f, o1 = 0.f;
#pragma unroll
    for (int r = 0; r < 4; ++r) { const bf16* vp = MKV + ((size_t)b * NMEM + 64 * r) * (2 * XW) + XW + h * HD + 2 * lane;
        for (int src = 0; src < 64; ++src) { const float p = __shfl(s[r], src); const unsigned w = *(const unsigned*)(vp + (size_t)src * (2 * XW)); o0 += p * bflo(w); o1 += p * bfhi(w); } }
    const float rl = 1.f / l;
    *(unsigned*)(XO + t * XW + h * HD + 2 * lane) = pk2(o0 * rl, o1 * rl);
}

__global__ void __launch_bounds__(NWAVES * 64, 2) mk_fwd(Args args) {
    extern __shared__ __attribute__((aligned(16))) unsigned char lds[];
    LAS unsigned char* const ldsp = (LAS unsigned char*)lds;
    volatile LAS unsigned* const MISC = (volatile LAS unsigned*)(ldsp + MISC_OFF);
    const int tid = threadIdx.x, wave = __builtin_amdgcn_readfirstlane(tid >> 6);
    const int G = gridDim.x; const int bx = blockIdx.x; const int vcu = (G % 8 == 0) ? (bx % 8) * (G / 8) + bx / 8 : bx;
    unsigned char* const ws = args.ws;
    gu32* const ctl = (gu32*)(ws + WS_CTL);
    for (int u = tid; u < (LDS_BYTES - LDSCTL_OFF) / 4; u += NWAVES * 64) ((LAS unsigned*)(ldsp + LDSCTL_OFF))[u] = 0u;
    __syncthreads();
    XcdBarrier bar; bar.bar = (unsigned*)(ctl + CW_BAR); bar.x = 0; bar.st = nullptr;
    if (!MK_PER_PHASE) bar = xcd_barrier_post((unsigned*)(ctl + CW_BAR), MISC + 8);
    const int lo = args.ph_lo, hi = args.ph_hi;
#define IN(k) (lo <= (k) && (k) < hi)
#define SEAM(k) do { if (IN(k) && IN((k) + 1)) xcd_barrier(bar); } while (0)
    const int NGW = G * NWAVES, NGT = G * NWAVES * 64;
#define PHASE_IDS() int tv_ = threadIdx.x; asm volatile("" : "+v"(tv_)); const int lane = tv_ & 63; const int gw = vcu * NWAVES + wave; const int gt = vcu * (NWAVES * 64) + tv_; (void)gw; (void)gt; (void)lane

#define x_in (args.in[0])
#define mem_in (args.in[1])
#define norm_mix (args.in[2])
#define w_in (args.in[3])
#define conv_w (args.in[4])
#define w_attn_out (args.in[5])
#define w_conv_out (args.in[6])
#define w_mix_out (args.in[7])
#define norm_xattn (args.in[8])
#define norm_mem (args.in[9])
#define wq_x (args.in[10])
#define wkv_x (args.in[11])
#define wo_x (args.in[12])
#define norm_mlp (args.in[13])
#define w_up (args.in[14])
#define w_down (args.in[15])
#define norm_final (args.in[16])
    float* const out = args.out; unsigned char* const outb = (unsigned char*)args.out;
#define ROPE ((float2*)(ws + WS_ROPE))
#define KSUM ((float*)(ws + WS_KMEAN))
#define SS1 ((unsigned long long*)(ws + WS_SS1))
#define SS2 ((unsigned long long*)(ws + WS_SS2))
#define SS3 ((unsigned long long*)(ws + WS_SS3))
#define MEMN ((bf16*)(ws + WS_MEMN))
#define MKV ((bf16*)(ws + WS_MKV))
#define WIN ((bf16*)(ws + WS_WIN))
#define WM ((bf16*)(ws + WS_WM))
#define WQ ((bf16*)(ws + WS_WQ))
#define WKV ((bf16*)(ws + WS_WKV))
#define WO ((bf16*)(ws + WS_WO))
#define WUP ((bf16*)(ws + WS_WUP))
#define WD ((bf16*)(ws + WS_WD))
#define XB ((bf16*)(ws + WS_XB))
#define QP ((bf16*)(ws + WS_G))
#define KP ((bf16*)(ws + WS_G + GRP))
#define VP ((bf16*)(ws + WS_G + 2 * GRP))
#define MERGED ((bf16*)(ws + WS_MERGED))
#define WAC ((bf16*)(ws + WS_WAC))
#define U_ ((bf16*)(ws + WS_G + 3 * GRP))
#define CB ((bf16*)(ws + WS_G + 4 * GRP))
#define RATIO ((bf16*)(ws + WS_RATIO))
#define SC ((bf16*)(ws + WS_SC))
#define AOCO ((bf16*)outb)
#define MLB ((float*)(ws + WS_ML))
#define SEL ((unsigned*)(ws + WS_SEL))
#define PART0 ((bf16*)(ws + WS_XB))
#define PART1 ((bf16*)(outb + 64 * MiB))
#define HQ ((bf16*)(ws + WS_HQ))
#define XO ((bf16*)(ws + WS_XO))
#define UP ((bf16*)(ws + WS_UP))
    if (IN(0)) { PHASE_IDS();
        LAS float* scr = (LAS float*)(ldsp + RING_OFF + wave * TR_SCR);
        constexpr int I_IN = (DM / 64) * (NPROJ / 64), I_A = (AW / 64) * (DM / 64), I_C = I_A, I_M = (DM / 64) * (DM / 64), I_Q = (DM / 64) * (XW / 64), I_KV = (DM / 64) * (2 * XW / 64),
                      I_O = (XW / 64) * (DM / 64), I_UP = (DM / 64) * (DFF / 64), I_D = (DFF / 64) * (DM / 64);
        static_assert(NWAVES * TR_SCR <= LDSCTL_OFF, "transposer scratch");
        constexpr int NITEMS = I_IN + I_A + I_C + I_M + I_Q + I_KV + I_O + I_UP + I_D;
        for (int it = gw; it < NITEMS; it += NGW) {
            int r = it;
            if (r < I_IN) { const int n0 = 64 * (r % (NPROJ / 64)); int d;
                if (n0 < 3072) d = n0;
                else if (n0 < 4096) { const int ch = n0 - 3072; d = 3072 + 256 * (ch >> 7) + (ch & 127); }
                else if (n0 < 5120) d = 5120 + (n0 - 4096);
                else if (n0 < 6144) { const int ch = n0 - 5120; d = 3072 + 256 * (ch >> 7) + 128 + (ch & 127); }
                else if (n0 < 8192) { const int ch = n0 - 6144; d = 6144 + 256 * (ch >> 7) + (ch & 127); }
                else { const int ch = n0 - 8192; d = 6144 + 256 * (ch >> 7) + 128 + (ch & 127); }
                p0_transpose_item(w_in, DM, NPROJ, WIN, DM, 0, d - n0, nullptr, scr, r, lane); continue; } r -= I_IN;
            if (r < I_A) { p0_transpose_item(w_attn_out, AW, DM, WAC, 2 * AW, 0, 0, nullptr, scr, r, lane); continue; } r -= I_A;
            if (r < I_C) { p0_transpose_item(w_conv_out, CWID, DM, WAC, 2 * AW, AW, 0, nullptr, scr, r, lane); continue; } r -= I_C;
            if (r < I_M) { p0_transpose_item(w_mix_out, DM, DM, WM, DM, 0, 0, nullptr, scr, r, lane); continue; } r -= I_M;
            if (r < I_Q) { p0_transpose_item(wq_x, DM, XW, WQ, DM, 0, 0, norm_xattn, scr, r, lane); continue; } r -= I_Q;
            if (r < I_KV) { p0_transpose_item(wkv_x, DM, 2 * XW, WKV, DM, 0, 0, nullptr, scr, r, lane); continue; } r -= I_KV;
            if (r < I_O) { p0_transpose_item(wo_x, XW, DM, WO, XW, 0, 0, nullptr, scr, r, lane); continue; } r -= I_O;
            if (r < I_UP) { p0_transpose_item(w_up, DM, DFF, WUP, DM, 0, 0, norm_mlp, scr, r, lane); continue; } r -= I_UP;
            p0_transpose_item(w_down, DFF, DM, WD, DFF, 0, 0, nullptr, scr, r, lane);
        }
        for (int m = gw; m < M; m += NGW) rms_row_to_bf16(x_in + (size_t)m * DM, norm_mix, XB + (size_t)m * DM, lane);
        for (int m = gw; m < NB * NMEM; m += NGW) rms_row_to_bf16(mem_in + (size_t)m * DM, norm_mem, MEMN + (size_t)m * DM, lane);
        for (int e = gt; e < 3 * M; e += NGT) SS1[e] = 0ull;
        for (int e = gt; e < NB * NH * NBLK * HD; e += NGT) KSUM[e] = 0.f;
        for (int e = gt; e < NB * NH * SEQ * 4; e += NGT) ((float2*)MLB)[e] = make_float2(-1e30f, 0.f);
        for (int e = gt; e < SEQ * 16; e += NGT) { const int pos = e >> 4, j = e & 15;
            const float inv_freq = ROPE_INV_FREQ[j]; const float ang = (float)pos * inv_freq;
            const double turns = (double)ang * 0.15915494309189535; const float fr = (float)(turns - rint(turns));
            ROPE[e] = make_float2(__builtin_amdgcn_cosf(fr), __builtin_amdgcn_sinf(fr)); }
    }
    SEAM(0);
    if (IN(1)) {
        { pg8::Gemm g{XB, WIN, M, NPROJ, DM}; pg8::StaticOrder S; S.init(M, NPROJ, G, bx);
          pg8::EpiProj E{QP, (size_t)(GRP / 2), U_, CB, RATIO, SC, (const float*)ROPE, KSUM};
          pg8::gemm_phase<pg8::EpiProj, pg8::StaticOrder, true, true>(ldsp + RING_OFF, g, S, E); }
    }
    SEAM(1);
    if (IN(2)) {
        for (int u = vcu; u < NB * NH * NBLK; u += G) { int tv = threadIdx.x; asm volatile("" : "+v"(tv)); const int bh = u >> 5, b = bh >> 3, h = bh & 7, qb = u & 31;
            att::moba_gate<AW>(tv, QP + ((size_t)b * SEQ + (size_t)qb * 256) * AW + h * HD, KSUM + (size_t)bh * NBLK * HD, qb, SEL + (size_t)bh * SEQ + qb * 256); }
    }
    SEAM(2);
    if (IN(3)) {
        static_assert(att::SP_BYTES <= LDSCTL_OFF, "sparse attention LDS");
        char* albase = (char*)lds + RING_OFF; constexpr long VOFF = (long)(GRP / 2);
        for (;;) { int tv = threadIdx.x; asm volatile("" : "+v"(tv)); char* al = albase; asm volatile("" : "+s"(al)); unsigned* qctl = (unsigned*)(al + att::SP_CTRL) + 1;
            if (tv == 0) *qctl = atomicAdd((unsigned*)(ctl + CW_QUEUE), 1u);
            __syncthreads();
            const int u = (int)*qctl;
            if (u >= MOBA_NUNITS * NB * NH) break;
            const int k = u >> 4, bh = u & 15, b = bh >> 3, h = bh & 7; const unsigned uw = MOBA_UNITS[k]; const int n = uw & 31, qlo = (uw >> 5) & 31, qhi = (int)(uw >> 10) + 1;
            att::moba_sparse_unit<AW, AW, VOFF>(tv, b, h, n, qlo, qhi, QP, KP, SEL, b ? PART1 : PART0, MLB, al); }
    }
    SEAM(3);
    if (IN(4)) { PHASE_IDS();
        for (int e = gt; e < NB * NH * SEQ * 16; e += NGT) { const int c = e & 15, row = (e >> 4) & (SEQ - 1), bh = e >> 17, b = bh >> 3, h = bh & 7;
            const f32x4* mlp = (const f32x4*)(MLB + ((size_t)bh * SEQ + row) * 8); const f32x4 ml0 = mlp[0], ml1 = mlp[1];
            const float m0 = ml0.x, l0 = ml0.y, m1 = ml0.z, l1 = ml0.w, m2 = ml1.x, l2 = ml1.y, m3 = ml1.z, l3 = ml1.w;
            float mx = m3; if (l0 > 0.f) mx = fmaxf(mx, m0); if (l1 > 0.f) mx = fmaxf(mx, m1); if (l2 > 0.f) mx = fmaxf(mx, m2);
            constexpr float C2 = 1.4426950408889634f * ATT_SCALE;
            const float w0 = l0 > 0.f ? l0 * __builtin_amdgcn_exp2f((m0 - mx) * C2) : 0.f, w1 = l1 > 0.f ? l1 * __builtin_amdgcn_exp2f((m1 - mx) * C2) : 0.f,
                        w2 = l2 > 0.f ? l2 * __builtin_amdgcn_exp2f((m2 - mx) * C2) : 0.f, w3 = l3 * __builtin_amdgcn_exp2f((m3 - mx) * C2);
            const float rw = 1.f / (w0 + w1 + w2 + w3);
            const bf16* pp = (b ? PART1 : PART0) + (((size_t)h * SEQ + row) * 4) * HD + c * 8;
            float acc8[8];
            { const v4u p = *(const v4u*)(pp + 3 * HD); const float w = w3 * rw; acc8[0] = w * bflo(p.x); acc8[1] = w * bfhi(p.x); acc8[2] = w * bflo(p.y); acc8[3] = w * bfhi(p.y); acc8[4] = w * bflo(p.z); acc8[5] = w * bfhi(p.z); acc8[6] = w * bflo(p.w); acc8[7] = w * bfhi(p.w); }
            if (l0 > 0.f) { const v4u p = *(const v4u*)(pp); const float w = w0 * rw; acc8[0] += w * bflo(p.x); acc8[1] += w * bfhi(p.x); acc8[2] += w * bflo(p.y); acc8[3] += w * bfhi(p.y); acc8[4] += w * bflo(p.z); acc8[5] += w * bfhi(p.z); acc8[6] += w * bflo(p.w); acc8[7] += w * bfhi(p.w); }
            if (l1 > 0.f) { const v4u p = *(const v4u*)(pp + HD); const float w = w1 * rw; acc8[0] += w * bflo(p.x); acc8[1] += w * bfhi(p.x); acc8[2] += w * bflo(p.y); acc8[3] += w * bfhi(p.y); acc8[4] += w * bflo(p.z); acc8[5] += w * bfhi(p.z); acc8[6] += w * bflo(p.w); acc8[7] += w * bfhi(p.w); }
            if (l2 > 0.f) { const v4u p = *(const v4u*)(pp + 2 * HD); const float w = w2 * rw; acc8[0] += w * bflo(p.x); acc8[1] += w * bfhi(p.x); acc8[2] += w * bflo(p.y); acc8[3] += w * bfhi(p.y); acc8[4] += w * bflo(p.z); acc8[5] += w * bfhi(p.z); acc8[6] += w * bflo(p.w); acc8[7] += w * bfhi(p.w); }
            v4u o; o.x = pk2(acc8[0], acc8[1]); o.y = pk2(acc8[2], acc8[3]); o.z = pk2(acc8[4], acc8[5]); o.w = pk2(acc8[6], acc8[7]);
            *(v4u*)(AOCO + ((size_t)b * SEQ + row) * (2 * AW) + h * HD + c * 8) = o; }
        for (int e = gt; e < M * (CWID / 8); e += NGT) { const int c = (e & 127) * 8; const int t = e >> 7; const int s = t & (SEQ - 1);
            const v4u u0 = *(const v4u*)(U_ + (size_t)t * CWID + c); v4u u1 = {0u, 0u, 0u, 0u}, u2 = {0u, 0u, 0u, 0u};
            if (s >= 1) u1 = *(const v4u*)(U_ + (size_t)(t - 1) * CWID + c);
            if (s >= 2) u2 = *(const v4u*)(U_ + (size_t)(t - 2) * CWID + c);
            const v4u cb = *(const v4u*)(CB + (size_t)t * CWID + c);
            const f32x4 w0a = *(const f32x4*)(conv_w + c), w0b = *(const f32x4*)(conv_w + c + 4), w1a = *(const f32x4*)(conv_w + CWID + c), w1b = *(const f32x4*)(conv_w + CWID + c + 4),
                        w2a = *(const f32x4*)(conv_w + 2 * CWID + c), w2b = *(const f32x4*)(conv_w + 2 * CWID + c + 4);
            float y[8];
            y[0] = w2a.x * bflo(u0.x) + w1a.x * bflo(u1.x) + w0a.x * bflo(u2.x); y[1] = w2a.y * bfhi(u0.x) + w1a.y * bfhi(u1.x) + w0a.y * bfhi(u2.x);
            y[2] = w2a.z * bflo(u0.y) + w1a.z * bflo(u1.y) + w0a.z * bflo(u2.y); y[3] = w2a.w * bfhi(u0.y) + w1a.w * bfhi(u1.y) + w0a.w * bfhi(u2.y);
            y[4] = w2b.x * bflo(u0.z) + w1b.x * bflo(u1.z) + w0b.x * bflo(u2.z); y[5] = w2b.y * bfhi(u0.z) + w1b.y * bfhi(u1.z) + w0b.y * bfhi(u2.z);
            y[6] = w2b.z * bflo(u0.w) + w1b.z * bflo(u1.w) + w0b.z * bflo(u2.w); y[7] = w2b.w * bfhi(u0.w) + w1b.w * bfhi(u1.w) + w0b.w * bfhi(u2.w);
            v4u o; o.x = pk2(bflo(cb.x) * y[0], bfhi(cb.x) * y[1]); o.y = pk2(bflo(cb.y) * y[2], bfhi(cb.y) * y[3]); o.z = pk2(bflo(cb.z) * y[4], bfhi(cb.z) * y[5]); o.w = pk2(bflo(cb.w) * y[6], bfhi(cb.w) * y[7]);
            *(v4u*)(AOCO + (size_t)t * (2 * AW) + AW + c) = o; }
    }
    SEAM(4);
    if (IN(5)) {
        pg8::Gemm g{AOCO, WAC, M, DM, 2 * AW}; pg8::StaticOrder S; S.init(M, DM, G, bx); pg8::EpiMerged E{MERGED, RATIO, SC, DM};
        pg8::gemm_phase<pg8::EpiMerged, pg8::StaticOrder, true, true>(ldsp + RING_OFF, g, S, E);
    }
    SEAM(5);
    if (IN(6)) {
        pg8::Gemm g{MERGED, WM, M, DM, DM}; pg8::StaticOrder S; S.init(M, DM, G, bx); pg8::EpiResid E{x_in, out, XB, DM, SS1};
        pg8::gemm_phase<pg8::EpiResid, pg8::StaticOrder, true, true>(ldsp + RING_OFF, g, S, E);
    }
    SEAM(6);
    if (IN(7)) {
        constexpr int NHQ = (M / 256) * (XW / 256);
        const bool kvwg = (G >= NHQ + 8) ? (bx >= NHQ) : true;
        { pg8::Gemm g{XB, WQ, M, XW, DM}; pg8::StaticOrder S; S.init(M, XW, G, bx); pg8::EpiBf16G E{HQ, HQ, 1 << 30, 0, 1 << 30, XW, SS1};
          pg8::gemm_phase<pg8::EpiBf16G, pg8::StaticOrder, true, true>(ldsp + RING_OFF, g, S, E); }
        if (kvwg) { pg8::Gemm g{MEMN, WKV, NB * NMEM, 2 * XW, DM}; pg8::StaticOrder S; S.init(NB * NMEM, 2 * XW, G, (G >= NHQ + 8) ? bx - NHQ : bx);
          pg8::EpiBf16G E{MKV, MKV, 1 << 30, 0, 1 << 30, 2 * XW, nullptr};
          pg8::gemm_phase<pg8::EpiBf16G, pg8::StaticOrder, true, true>(ldsp + RING_OFF, g, S, E); }
    }
    SEAM(7);
    if (IN(8)) {
        att::Seam S; char* albase = (char*)lds + RING_OFF; constexpr int NIT = NB * XH * 32;
        for (int L = vcu; L < NIT; L += G) { int tv = threadIdx.x; asm volatile("" : "+v"(tv)); const int bh = L >> 5, b = bh >> 2, h = bh & 3, qb = L & 31;
            const bf16* Qp = HQ + ((size_t)b * SEQ + (size_t)qb * 256) * XW + h * HD; const bf16* Kp = MKV + (size_t)b * NMEM * (2 * XW) + h * HD;
            bf16* Op = XO + ((size_t)b * SEQ + (size_t)qb * 256) * XW + h * HD;
            att::attn_prime<XW, 2 * XW, (long)XW>(tv, Qp, Kp, albase, S);
            att::attn_block<false, XW, 2 * XW, (long)XW, XW>(tv, Kp, Op, NMEM / 64, 0, Qp, Kp, albase, S); }
    }
    SEAM(8);
    if (IN(9)) {
        pg8::Gemm g{XO, WO, M, DM, XW}; pg8::StaticOrder S; S.init(M, DM, G, bx); pg8::EpiResid E{out, out, XB, DM, SS2};
        pg8::gemm_phase<pg8::EpiResid, pg8::StaticOrder, true, true>(ldsp + RING_OFF, g, S, E);
    }
    SEAM(9);
    if (IN(10)) {
        pg8::Gemm g{XB, WUP, M, DFF, DM}; pg8::StaticOrder S; S.init(M, DFF, G, bx); pg8::EpiUp E{UP, DFF, SS2};
        pg8::gemm_phase<pg8::EpiUp, pg8::StaticOrder, true, true>(ldsp + RING_OFF, g, S, E);
    }
    SEAM(10);
    if (IN(11)) {
        pg8::Gemm g{UP, WD, M, DM, DFF}; pg8::StaticOrder S; S.init(M, DM, G, bx); pg8::EpiResid E{out, out, nullptr, DM, SS3};
        pg8::gemm_phase<pg8::EpiResid, pg8::StaticOrder, true, true>(ldsp + RING_OFF, g, S, E);
    }
    SEAM(11);
    if (IN(12)) { PHASE_IDS();
        for (int m = gw; m < M; m += NGW) { GAS f32x4* xr = (GAS f32x4*)(out + (size_t)m * DM) + lane; const GAS f32x4* gr = (const GAS f32x4*)norm_final + lane;
            const float rstd = pg8::rstd_from_ss(SS3, m);
#pragma unroll
            for (int j = 0; j < 8; ++j) { const f32x4 v = xr[64 * j]; const f32x4 gg = gr[64 * j]; xr[64 * j] = (f32x4){v.x * rstd * gg.x, v.y * rstd * gg.y, v.z * rstd * gg.z, v.w * rstd * gg.w}; } }
    }
#undef IN
#undef SEAM
}
#undef x_in
#undef mem_in


extern "C" void kernel_launch(void* const* d_in, const int* in_sizes, int n_in, void* d_out, int out_size, void* d_ws, size_t ws_size, hipStream_t stream) {
    static int grid = 0;
    if (grid == 0) {
        if (n_in != 17 || in_sizes[0] != M * DM || out_size != M * DM || ws_size < WS_END) { fprintf(stderr, "kernel_launch: unexpected shapes: n_in %d in0 %d out %d ws %zu (need %zu)\n", n_in, n_in > 0 ? in_sizes[0] : -1, out_size, ws_size, (size_t)WS_END); grid = -1; return; }
        int dev = 0, cus = 0, per_cu = 0;
        if (hipGetDevice(&dev) != hipSuccess || hipDeviceGetAttribute(&cus, hipDeviceAttributeMultiprocessorCount, dev) != hipSuccess) { fprintf(stderr, "kernel_launch: device query failed\n"); grid = -1; return; }
        if (hipFuncSetAttribute((const void*)mk_fwd, hipFuncAttributeMaxDynamicSharedMemorySize, LDS_BYTES) != hipSuccess) { fprintf(stderr, "kernel_launch: hipFuncSetAttribute failed\n"); grid = -1; return; }
        if (hipOccupancyMaxActiveBlocksPerMultiprocessor(&per_cu, (const void*)mk_fwd, NWAVES * 64, LDS_BYTES) != hipSuccess || per_cu < 1) fprintf(stderr, "kernel_launch: note: occupancy query reports %d workgroups per CU\n", per_cu);
        (void)hipGetLastError();
        grid = cus;
    }
    if (grid < 0) return;
    if (hipMemsetAsync((char*)d_ws + WS_CTL, 0, CTL_ZERO_BYTES, stream) != hipSuccess) { fprintf(stderr, "kernel_launch: hipMemsetAsync failed\n"); return; }
    Args a{};
    for (int i = 0; i < 17; ++i) a.in[i] = (const float*)d_in[i];
    a.out = (float*)d_out; a.ws = (unsigned char*)d_ws;
#if MK_PER_PHASE
    for (int p = 0; p < N_PHASES; ++p) { a.ph_lo = p; a.ph_hi = p + 1; a.li = p; hipLaunchKernelGGL(mk_fwd, dim3(grid), dim3(NWAVES * 64), LDS_BYTES, stream, a); }
#else
    a.ph_lo = 0; a.ph_hi = N_PHASES; a.li = 0;
    hipLaunchKernelGGL(mk_fwd, dim3(grid), dim3(NWAVES * 64), LDS_BYTES, stream, a);
#endif
    const hipError_t le = hipPeekAtLastError();
    if (le != hipSuccess) fprintf(stderr, "kernel_launch: launch failed: %s\n", hipGetErrorName(le));
}
```
